# Optimizing an MI355X kernel written in HIP

```python
import math
import jax, jax.numpy as jnp
from jax import lax
import numpy as np

D_MODEL = 1024
BATCH = 4
SEQ = 4096
DEPTH = 4
DEC_BATCH = 8
DEC_SEQ = 16
PAST_LEN = 2048

CHUNK = 64
Q_BLOCK = 128
EPS = 1e-6
NEG_INF = -1e30

MLA_HEADS = 8
MLA_Q_RANK = 256
MLA_KV_RANK = 128
MLA_NOPE = 64
MLA_ROPE = 32
MLA_V = 64
MLA_WIDTH = MLA_HEADS * MLA_V
ROPE_BASE = 10000.0

DIFF_HEADS = 8
DIFF_D = 32
DIFF_V = 2 * DIFF_D
DIFF_WIDTH = DIFF_HEADS * DIFF_V

LRU_WIDTH = 512
LRU_BLOCKS = 8
LRU_BW = LRU_WIDTH // LRU_BLOCKS
CONV_W = 4
LRU_C = 8.0

N_BRANCH = 3
SPLITS = (MLA_Q_RANK, MLA_KV_RANK, MLA_ROPE, MLA_WIDTH,
          DIFF_WIDTH, DIFF_WIDTH, DIFF_WIDTH, DIFF_WIDTH,
          LRU_WIDTH, LRU_WIDTH, N_BRANCH * D_MODEL)
N_IN = sum(SPLITS)

kernel_name = 'hybrid_mla_diff_rglru_stream_step'


def rms_norm(x, g):
    xf = x.astype(jnp.float32)
    y = xf * lax.rsqrt(jnp.mean(xf * xf, axis=-1, keepdims=True) + EPS)
    return (y * g.astype(jnp.float32)).astype(x.dtype)


def rope(x, pos):
    half = x.shape[-1] // 2
    inv = ROPE_BASE ** (-jnp.arange(half, dtype=jnp.float32) / half)
    ang = pos.astype(jnp.float32)[:, None] * inv[None, :]
    cos = jnp.cos(ang)[:, None, :]
    sin = jnp.sin(ang)[:, None, :]
    x1 = x[..., :half].astype(jnp.float32)
    x2 = x[..., half:].astype(jnp.float32)
    return jnp.concatenate([x1 * cos - x2 * sin, x2 * cos + x1 * sin], axis=-1).astype(x.dtype)


def alibi_slopes(n):
    return 2.0 ** (-8.0 * jnp.arange(1, n + 1, dtype=jnp.float32) / n)


def chunk_visible(q_pos, k_pos):
    return (k_pos[None, :] // CHUNK) <= (q_pos[:, None] // CHUNK)


def map_query_blocks(fn, q_arrays, q_pos):
    T = q_pos.shape[0]
    if T <= Q_BLOCK:
        return fn(q_arrays, q_pos)
    nb = T // Q_BLOCK
    blocks = tuple(jnp.moveaxis(a.reshape(a.shape[0], nb, Q_BLOCK, *a.shape[2:]), 1, 0) for a in q_arrays)
    out = lax.map(lambda args: fn(args[0], args[1]), (blocks, q_pos.reshape(nb, Q_BLOCK)))
    out = jnp.moveaxis(out, 0, 1)
    return out.reshape(out.shape[0], T, *out.shape[3:])


def rg_lru(xb, z, q_pos, conv0, h0, lp):
    B, T, W = xb.shape
    conv_in = jnp.concatenate([conv0, xb], axis=1)
    conv_new = conv_in[:, -(CONV_W - 1):]
    xc = lp['lru_conv_b'] + sum(conv_in[:, k:k + T] * lp['lru_conv_w'][k] for k in range(CONV_W))
    xcb = xc.reshape(B, T, LRU_BLOCKS, LRU_BW)
    r = jax.nn.sigmoid(jnp.einsum('btni,nio->btno', xcb, lp['lru_w_a']).reshape(B, T, W).astype(jnp.float32)
                       + lp['lru_b_a'].astype(jnp.float32))
    i = jax.nn.sigmoid(jnp.einsum('btni,nio->btno', xcb, lp['lru_w_x']).reshape(B, T, W).astype(jnp.float32)
                       + lp['lru_b_x'].astype(jnp.float32))
    log_a = -LRU_C * r * jax.nn.softplus(-lp['lru_lambda'].astype(jnp.float32))
    a = jnp.exp(log_a)
    mult = jnp.where((q_pos == 0)[None, :, None], 1.0, jnp.sqrt(-jnp.expm1(2.0 * log_a)))
    b = mult * i * xc.astype(jnp.float32)

    def combine(left, right):
        a1, b1 = left
        a2, b2 = right
        return a1 * a2, a2 * b1 + b2

    a_cum, b_cum = lax.associative_scan(combine, (a, b), axis=1)
    h = a_cum * h0.astype(jnp.float32)[:, None, :] + b_cum
    out = h.astype(xb.dtype) * jax.nn.silu(z)
    return out, h[:, -1].astype(xb.dtype), conv_new


def _layer(x, past, lp, layer_idx):
    ckv_past, krope_past, dk_past, dv_past, h0, conv0 = past
    B, T, _ = x.shape
    P = ckv_past.shape[1]
    q_pos = P + jnp.arange(T, dtype=jnp.int32)
    k_pos = jnp.arange(P + T, dtype=jnp.int32)

    xn = rms_norm(x, lp['norm'])
    proj = jnp.einsum('btd,dn->btn', xn, lp['w_in'])
    pieces = []
    off = 0
    for w in SPLITS:
        pieces.append(proj[..., off:off + w])
        off += w
    c_q, c_kv, k_r, z_mla, q_d, k_d, v_d, z_diff, x_lru, z_lru, gate_logits = pieces

    c_q = rms_norm(c_q, lp['mla_q_norm'])
    q = jnp.einsum('btr,rn->btn', c_q, lp['mla_w_uq']).reshape(B, T, MLA_HEADS, MLA_NOPE + MLA_ROPE)
    q_nope = q[..., :MLA_NOPE]
    q_rope = rope(q[..., MLA_NOPE:], q_pos)
    c_kv = rms_norm(c_kv, lp['mla_kv_norm'])
    k_r = rope(k_r[:, :, None, :], q_pos)[:, :, 0, :]
    ckv_all = jnp.concatenate([ckv_past, c_kv], axis=1)
    krope_all = jnp.concatenate([krope_past, k_r], axis=1)
    q_lat = jnp.einsum('bthd,chd->bthc', q_nope, lp['mla_w_uk'])
    mla_scale = (MLA_NOPE + MLA_ROPE) ** -0.5

    def mla_block(qs, qp):
        ql, qr = qs
        s = jnp.einsum('bthc,bsc->bhts', ql, ckv_all) + jnp.einsum('bthr,bsr->bhts', qr, krope_all)
        s = jnp.where(chunk_visible(qp, k_pos)[None, None], s.astype(jnp.float32) * mla_scale, NEG_INF)
        p = jax.nn.softmax(s, axis=-1).astype(ckv_all.dtype)
        return jnp.einsum('bhts,bsc->bthc', p, ckv_all)

    o_lat = map_query_blocks(mla_block, (q_lat, q_rope), q_pos)
    o_mla = jnp.einsum('bthc,chv->bthv', o_lat, lp['mla_w_uv']).reshape(B, T, MLA_WIDTH) * jax.nn.silu(z_mla)

    qd = q_d.reshape(B, T, DIFF_HEADS, 2, DIFF_D)
    kd = k_d.reshape(B, T, DIFF_HEADS, DIFF_V)
    vd = v_d.reshape(B, T, DIFF_HEADS, DIFF_V)
    kd_all = jnp.concatenate([dk_past, kd], axis=1).reshape(B, P + T, DIFF_HEADS, 2, DIFF_D)
    vd_all = jnp.concatenate([dv_past, vd], axis=1)
    lam_init = 0.8 - 0.6 * math.exp(-0.3 * layer_idx)
    lam = (jnp.exp(jnp.sum(lp['diff_lq1'].astype(jnp.float32) * lp['diff_lk1'].astype(jnp.float32)))
           - jnp.exp(jnp.sum(lp['diff_lq2'].astype(jnp.float32) * lp['diff_lk2'].astype(jnp.float32)))
           + lam_init)
    slopes = alibi_slopes(DIFF_HEADS)

    def diff_block(qs, qp):
        (qb,) = qs
        s = jnp.einsum('bthcd,bshcd->bchts', qb, kd_all).astype(jnp.float32) * DIFF_D ** -0.5
        dist = jnp.abs(qp[:, None] - k_pos[None, :]).astype(jnp.float32)
        s = s - slopes[:, None, None] * dist[None]
        s = jnp.where(chunk_visible(qp, k_pos)[None, None, None], s, NEG_INF)
        p = jax.nn.softmax(s, axis=-1)
        a = (p[:, 0] - lam * p[:, 1]).astype(vd_all.dtype)
        return jnp.einsum('bhts,bshv->bthv', a, vd_all)

    o_d = map_query_blocks(diff_block, (qd,), q_pos)
    o_d = rms_norm(o_d, lp['diff_subln']) * (1.0 - lam_init)
    o_diff = o_d.reshape(B, T, DIFF_WIDTH) * jax.nn.silu(z_diff)

    o_lru, h_last, conv_new = rg_lru(x_lru, z_lru, q_pos, conv0, h0, lp)

    g = jax.nn.sigmoid(gate_logits.astype(jnp.float32)).astype(x.dtype).reshape(B, T, N_BRANCH, D_MODEL)
    merged = (g[:, :, 0] * jnp.einsum('btw,wd->btd', o_mla, lp['w_o_mla'])
              + g[:, :, 1] * jnp.einsum('btw,wd->btd', o_diff, lp['w_o_diff'])
              + g[:, :, 2] * jnp.einsum('btw,wd->btd', o_lru, lp['w_o_lru']))
    y = jnp.einsum('btd,de->bte', merged, lp['w_out'])
    return x + y, (c_kv, k_r, kd, vd, h_last, conv_new)


def setup_inputs(seed: int = 0) -> dict:
    key = jax.random.key(seed)
    ks = jax.random.split(key, 32)

    def nrm(i, shape, scale):
        return jax.random.normal(ks[i], shape, jnp.float32) * scale

    def gain(i, shape):
        return 1.0 + nrm(i, shape, 0.02)

    a0 = jax.random.uniform(ks[30], (DEPTH, LRU_WIDTH), jnp.float32, 0.9, 0.999)
    return {
        'x_prompt': nrm(0, (BATCH, SEQ, D_MODEL), 1.0),
        'x_sample': nrm(1, (DEC_BATCH, DEC_SEQ, D_MODEL), 1.0),
        'cache_mla_ckv': nrm(2, (DEPTH, DEC_BATCH, PAST_LEN, MLA_KV_RANK), 1.0),
        'cache_mla_krope': nrm(3, (DEPTH, DEC_BATCH, PAST_LEN, MLA_ROPE), 1.0),
        'cache_diff_k': nrm(4, (DEPTH, DEC_BATCH, PAST_LEN, DIFF_HEADS, DIFF_V), 1.0),
        'cache_diff_v': nrm(5, (DEPTH, DEC_BATCH, PAST_LEN, DIFF_HEADS, DIFF_V), 1.0),
        'state_lru_h': nrm(6, (DEPTH, DEC_BATCH, LRU_WIDTH), 0.5),
        'state_lru_conv': nrm(7, (DEPTH, DEC_BATCH, CONV_W - 1, LRU_WIDTH), 1.0),
        'norm_g': gain(8, (DEPTH, D_MODEL)),
        'w_in': nrm(9, (DEPTH, D_MODEL, N_IN), D_MODEL ** -0.5),
        'mla_q_norm': gain(10, (DEPTH, MLA_Q_RANK)),
        'mla_kv_norm': gain(11, (DEPTH, MLA_KV_RANK)),
        'mla_w_uq': nrm(12, (DEPTH, MLA_Q_RANK, MLA_HEADS * (MLA_NOPE + MLA_ROPE)), MLA_Q_RANK ** -0.5),
        'mla_w_uk': nrm(13, (DEPTH, MLA_KV_RANK, MLA_HEADS, MLA_NOPE), MLA_KV_RANK ** -0.5),
        'mla_w_uv': nrm(14, (DEPTH, MLA_KV_RANK, MLA_HEADS, MLA_V), MLA_KV_RANK ** -0.5),
        'diff_lq1': nrm(15, (DEPTH, DIFF_D), 0.1),
        'diff_lk1': nrm(16, (DEPTH, DIFF_D), 0.1),
        'diff_lq2': nrm(17, (DEPTH, DIFF_D), 0.1),
        'diff_lk2': nrm(18, (DEPTH, DIFF_D), 0.1),
        'diff_subln': gain(19, (DEPTH, DIFF_V)),
        'lru_conv_w': nrm(20, (DEPTH, CONV_W, LRU_WIDTH), CONV_W ** -0.5),
        'lru_conv_b': nrm(21, (DEPTH, LRU_WIDTH), 0.01),
        'lru_w_a': nrm(22, (DEPTH, LRU_BLOCKS, LRU_BW, LRU_BW), LRU_BW ** -0.5),
        'lru_b_a': nrm(23, (DEPTH, LRU_WIDTH), 0.01),
        'lru_w_x': nrm(24, (DEPTH, LRU_BLOCKS, LRU_BW, LRU_BW), LRU_BW ** -0.5),
        'lru_b_x': nrm(25, (DEPTH, LRU_WIDTH), 0.01),
        'lru_lambda': jnp.log(a0) - jnp.log1p(-a0),
        'w_o_mla': nrm(26, (DEPTH, MLA_WIDTH, D_MODEL), MLA_WIDTH ** -0.5),
        'w_o_diff': nrm(27, (DEPTH, DIFF_WIDTH, D_MODEL), DIFF_WIDTH ** -0.5),
        'w_o_lru': nrm(28, (DEPTH, LRU_WIDTH, D_MODEL), LRU_WIDTH ** -0.5),
        'w_out': nrm(29, (DEPTH, D_MODEL, D_MODEL), D_MODEL ** -0.5),
        'final_norm': gain(31, (D_MODEL,)),
    }


def _stacked(states, i):
    return jnp.stack([s[i] for s in states], axis=0)


def reference(x_prompt, x_sample, cache_mla_ckv, cache_mla_krope, cache_diff_k, cache_diff_v,
              state_lru_h, state_lru_conv, norm_g, w_in, mla_q_norm, mla_kv_norm, mla_w_uq, mla_w_uk,
              mla_w_uv, diff_lq1, diff_lk1, diff_lq2, diff_lk2, diff_subln, lru_conv_w, lru_conv_b,
              lru_w_a, lru_b_a, lru_w_x, lru_b_x, lru_lambda, w_o_mla, w_o_diff, w_o_lru, w_out,
              final_norm):
    bp = x_prompt.shape[0]
    dt = x_prompt.dtype
    empty_past = (jnp.zeros((bp, 0, MLA_KV_RANK), dt), jnp.zeros((bp, 0, MLA_ROPE), dt),
                  jnp.zeros((bp, 0, DIFF_HEADS, DIFF_V), dt), jnp.zeros((bp, 0, DIFF_HEADS, DIFF_V), dt),
                  jnp.zeros((bp, LRU_WIDTH), dt), jnp.zeros((bp, CONV_W - 1, LRU_WIDTH), dt))
    prompt_states = []
    sample_states = []
    xp = x_prompt
    xs = x_sample
    for l in range(DEPTH):
        lp = {
            'norm': norm_g[l], 'w_in': w_in[l],
            'mla_q_norm': mla_q_norm[l], 'mla_kv_norm': mla_kv_norm[l],
            'mla_w_uq': mla_w_uq[l], 'mla_w_uk': mla_w_uk[l], 'mla_w_uv': mla_w_uv[l],
            'diff_lq1': diff_lq1[l], 'diff_lk1': diff_lk1[l], 'diff_lq2': diff_lq2[l], 'diff_lk2': diff_lk2[l],
            'diff_subln': diff_subln[l],
            'lru_conv_w': lru_conv_w[l], 'lru_conv_b': lru_conv_b[l],
            'lru_w_a': lru_w_a[l], 'lru_b_a': lru_b_a[l], 'lru_w_x': lru_w_x[l], 'lru_b_x': lru_b_x[l],
            'lru_lambda': lru_lambda[l],
            'w_o_mla': w_o_mla[l], 'w_o_diff': w_o_diff[l], 'w_o_lru': w_o_lru[l], 'w_out': w_out[l],
        }
        xp, st_p = _layer(xp, empty_past, lp, l)
        past = (cache_mla_ckv[l], cache_mla_krope[l], cache_diff_k[l], cache_diff_v[l],
                state_lru_h[l], state_lru_conv[l])
        xs, st_s = _layer(xs, past, lp, l)
        prompt_states.append(st_p)
        sample_states.append(st_s)
    y_prompt = rms_norm(xp, final_norm)
    y_sample = rms_norm(xs, final_norm)
    return (y_prompt, y_sample,
            _stacked(prompt_states, 0), _stacked(prompt_states, 1), _stacked(prompt_states, 2),
            _stacked(prompt_states, 3), _stacked(prompt_states, 4), _stacked(prompt_states, 5),
            _stacked(sample_states, 0), _stacked(sample_states, 1), _stacked(sample_states, 2),
            _stacked(sample_states, 3), _stacked(sample_states, 4), _stacked(sample_states, 5))
```

```cpp
#include <hip/hip_runtime.h>
#include <hip/hip_cooperative_groups.h>
#include <cstdio>
namespace cg = cooperative_groups;

#ifndef ONE_LAUNCH
#define ONE_LAUNCH 1
#endif
#define REP_PREP 1
#define REP_INPROJ 1
#define REP_QLRU 1
#define REP_ATTN 1
#define REP_OPROJ 1
#define REP_UVSCAN 1
#define TAIL_PHASE -1
#define TAIL_REPS 4
#define REP_MLA 1
#define REP_DIFF 1
#define EXTRA_SYNC 0

typedef unsigned short u16;
typedef unsigned int u32;
using bf16x8 = __attribute__((ext_vector_type(8))) short;
using s16x4  = __attribute__((ext_vector_type(4))) short;
using f32x4  = __attribute__((ext_vector_type(4))) float;
using f32x16 = __attribute__((ext_vector_type(16))) float;
typedef float f32x2 __attribute__((ext_vector_type(2)));
typedef __bf16 bf16x2 __attribute__((ext_vector_type(2)));
#define DI __device__ __forceinline__

constexpr int D = 1024, TP = 4096, MP = 16384, TS = 16, MS = 128, M = MP + MS, MT = 65, MPAD = MT * 256;
constexpr int PAST = 2048, SK = PAST + TS, SKP = 2112;
constexpr int NIN = 7072, NPJ = 7168, DEPTH = 4;
constexpr float EPS = 1e-6f;
constexpr float LOG2E = 1.4426950408889634f;
constexpr float QM_SCALE = 0.10206207261596575f * LOG2E;
constexpr float QD_SCALE = 0.17677669529663687f * LOG2E;
constexpr int PC_CQ = 0, PC_CKV = 256, PC_KR = 384, PC_ZMLA = 512, PC_QD = 1024, PC_KD = 1536, PC_VD = 2048, PC_ZD = 2560,
              PC_XL = 3072, PC_ZL = 3584, PC_G = 4096;
constexpr long O_YP = 0, O_YS = O_YP + (long)MP * D, O_PCKV = O_YS + (long)MS * D, O_PKR = O_PCKV + 4L * MP * 128,
               O_PDK = O_PKR + 4L * MP * 32, O_PDV = O_PDK + 4L * MP * 512, O_PH = O_PDV + 4L * MP * 512, O_PCV = O_PH + 4L * 4 * 512,
               O_SCKV = O_PCV + 4L * 4 * 3 * 512, O_SKR = O_SCKV + 4L * MS * 128, O_SDK = O_SKR + 4L * MS * 32, O_SDV = O_SDK + 4L * MS * 512,
               O_SH = O_SDV + 4L * MS * 512, O_SCV = O_SH + 4L * 8 * 512, O_END = O_SCV + 4L * 8 * 3 * 512;
constexpr size_t al(size_t x) { return (x + 255) & ~(size_t)255; }
constexpr size_t WS_CTL = 0, WS_BAR = 4096, WS_ROPE = 20480, WS_WIN = WS_ROPE + al(4096 * 16 * 8), WS_WQ = WS_WIN + al((size_t)NPJ * 1024 * 2),
                 WS_WUV = WS_WQ + al(1280 * 256 * 2), WS_WO = WS_WUV + al(512 * 512 * 2), WS_WOUT = WS_WO + al(3 * 1024 * 512 * 2),
                 WS_WLRU = WS_WOUT + al(1024 * 1024 * 2), WS_XN = WS_WLRU + al(1024 * 256 * 2), WS_PROJ = WS_XN + al((size_t)MPAD * 1024 * 2),
                 WS_QMLA = WS_PROJ + al((size_t)MPAD * NPJ * 2), WS_XC = WS_QMLA + al((size_t)MPAD * 1280 * 2), WS_A = WS_XC + al((size_t)MPAD * 512 * 2),
                 WS_B = WS_A + al((size_t)M * 512 * 4), WS_SCAN = WS_B + al((size_t)M * 512 * 4), WS_CKVP = WS_SCAN + al(4 * 64 * 512 * 8),
                 WS_CKVTP = WS_CKVP + al((size_t)MP * 128 * 2), WS_KRP = WS_CKVTP + al((size_t)MP * 128 * 2), WS_VDTP = WS_KRP + al((size_t)MP * 32 * 2),
                 WS_CKVS = WS_VDTP + al((size_t)MP * 512 * 2), WS_CKVTS = WS_CKVS + al(8 * SKP * 128 * 2), WS_KRS = WS_CKVTS + al(8 * SKP * 128 * 2),
                 WS_KDS = WS_KRS + al(8 * SKP * 32 * 2), WS_VDTS = WS_KDS + al((size_t)8 * SKP * 512 * 2), WS_END = WS_VDTS + al((size_t)8 * SKP * 512 * 2);
constexpr int EP_LD = 260;
constexpr int LDS_BYTES = 147456 + 256;
constexpr int TASK_OFF = 147456;
constexpr int NPH = 33;

struct Params { const float* in[32]; float* out; unsigned char* ws; int ph_lo, ph_hi; };
typedef const Params __attribute__((address_space(4)))* KP;

extern __shared__ __attribute__((aligned(16))) unsigned char smem[];

DI float bf2f(u16 v) { return __uint_as_float((u32)v << 16); }
DI u32 pk2(float a, float b) { f32x2 v = {a, b}; bf16x2 r = __builtin_convertvector(v, bf16x2); return __builtin_bit_cast(u32, r); }
DI u16 f2bf(float a) { return (u16)(pk2(a, 0.f) & 0xffffu); }
DI float lo2f(u32 v) { return __uint_as_float(v << 16); }
DI float hi2f(u32 v) { return __uint_as_float(v & 0xffff0000u); }
DI float sigm(float x) { return 1.f / (1.f + __expf(-x)); }
DI float silu(float x) { return x / (1.f + __expf(-x)); }
DI float softplus_f(float x) { return fmaxf(x, 0.f) + __logf(1.f + __expf(-fabsf(x))); }
DI float neg_expm1(float x) { const float t = x * (1.f + x * (0.5f + x * (0.16666667f + x * 0.041666668f))); return (x > -0.1f) ? -t : 1.f - __expf(x); }
DI float wsum(float v) { for (int o = 32; o; o >>= 1) v += __shfl_xor(v, o); return v; }
DI int kperm(int k) { int q = (k >> 2) & 3; q = (q == 1) ? 2 : (q == 2) ? 1 : q; return (k & ~15) | (q << 2) | (k & 3); }
DI int crow(int reg, int h) { return (reg & 3) + 8 * (reg >> 2) + 4 * h; }
DI int row_pos(int row) { return row < MP ? (row & (TP - 1)) : PAST + ((row - MP) & 15); }

struct TaskTab { int n; u32 t[1408]; };
constexpr TaskTab make_tab() {
  TaskTab x{}; int n = 0;
  for (int i = 0; i < 64; ++i) x.t[n++] = (2u << 16) | i;
  for (int i = 0; i < 8; ++i) x.t[n++] = (3u << 16) | i;
  for (int L = 144; L >= 1; --L) {
    for (int j = 0; j < 16; ++j) if (9 * (j + 1) == L) for (int i = 0; i < 32; ++i) x.t[n++] = (0u << 16) | (j * 32 + i);
    for (int q = 0; q < 128; ++q) if (q / 2 + 1 == L) for (int b = 0; b < 4; ++b) x.t[n++] = (1u << 16) | (q * 4 + b);
  }
  for (int i = 0; i < 256; ++i) x.t[n++] = (4u << 16) | i;
  x.n = n; return x;
}
__device__ const TaskTab g_tab = make_tab();
__device__ const float g_invf[16] = {1.0f, 0.5623413251903491f, 0.31622776601683794f, 0.1778279410038923f, 0.1f, 0.05623413251903491f,
  0.031622776601683794f, 0.01778279410038923f, 0.01f, 0.005623413251903491f, 0.0031622776601683794f, 0.001778279410038923f, 0.001f,
  0.0005623413251903491f, 0.00031622776601683794f, 0.0001778279410038923f};

DI int lds_byte(int r, int c) { int st = (r >> 4) * 2 + (c >> 5), rr = r & 15, cc = c & 31, ob = rr * 64 + cc * 2; return st * 1024 + (ob ^ (((ob >> 9) & 1) << 5)); }
DI void stage_rc(int b, int& R, int& C) { int st = b >> 10, sb = b & 1023, swz = sb ^ (((sb >> 9) & 1) << 5); R = (st >> 1) * 16 + (swz >> 6); C = (st & 1) * 32 + ((swz & 63) >> 1); }

#define SA(b, h) (smem + ((b) * 2 + (h)) * 16384)
#define SB(b, h) (smem + (4 + (b) * 2 + (h)) * 16384)
#define STAGE_A(P, half, kt) do { const u16* _g = A + (long)(half) * 128 * lda + (long)(kt) * 64; \
    __builtin_amdgcn_global_load_lds((const unsigned*)(_g + offA0), (unsigned*)((P) + wbase), 16, 0, 0); \
    __builtin_amdgcn_global_load_lds((const unsigned*)(_g + 64 * lda + offA0), (unsigned*)((P) + wbase + 8192), 16, 0, 0); } while (0)
#define STAGE_B(P, half, kt) do { const u16* _g = Bt + (long)(half) * 128 * ldb + (long)(kt) * 64; \
    __builtin_amdgcn_global_load_lds((const unsigned*)(_g + offB0), (unsigned*)((P) + wbase), 16, 0, 0); \
    __builtin_amdgcn_global_load_lds((const unsigned*)(_g + 64 * ldb + offB0), (unsigned*)((P) + wbase + 8192), 16, 0, 0); } while (0)
#define LDA(dst, b, h) _Pragma("unroll") for (int m = 0; m < 4; ++m) _Pragma("unroll") for (int k = 0; k < 2; ++k) \
    dst[m][k] = *reinterpret_cast<const bf16x8*>(SA(b, h) + lds_byte(wr * 64 + m * 16 + fr, k * 32 + fq * 8))
#define LDB(dst, b, h) _Pragma("unroll") for (int n = 0; n < 2; ++n) _Pragma("unroll") for (int k = 0; k < 2; ++k) \
    dst[n][k] = *reinterpret_cast<const bf16x8*>(SB(b, h) + lds_byte(wc * 32 + n * 16 + fr, k * 32 + fq * 8))
#define MMA(ai, bj, At, Bx) do { __builtin_amdgcn_s_setprio(1); \
    _Pragma("unroll") for (int m = 0; m < 4; ++m) _Pragma("unroll") for (int n = 0; n < 2; ++n) _Pragma("unroll") for (int k = 0; k < 2; ++k) \
      acc[ai][bj][m][n] = __builtin_amdgcn_mfma_f32_16x16x32_bf16(At[m][k], Bx[n][k], acc[ai][bj][m][n], 0, 0, 0); \
    __builtin_amdgcn_s_setprio(0); } while (0)
#define WAIT_V(n) asm volatile("s_waitcnt vmcnt(" #n ")" ::: "memory")
#define WAIT_L(n) asm volatile("s_waitcnt lgkmcnt(" #n ")" ::: "memory")
#define BAR __builtin_amdgcn_s_barrier()
#define SCHED __builtin_amdgcn_sched_barrier(0)

template <int NA> DI void gemm_kloop(const int TID, const u16* __restrict__ A, int lda, const u16* __restrict__ Bt, int ldb, int nt, f32x4 (&acc)[NA][2][4][2]) {
  const int tid = TID, wid = tid >> 6, lane = tid & 63, wr = wid >> 2, wc = wid & 3, fr = lane & 15, fq = lane >> 4;
  unsigned offA0, offB0;
  { int r, c; stage_rc(tid * 16, r, c); offA0 = r * lda + c; offB0 = r * ldb + c; }
  const int wbase = __builtin_amdgcn_readfirstlane(wid) * 1024;
#pragma unroll
  for (int a = 0; a < NA; ++a)
#pragma unroll
    for (int b = 0; b < 2; ++b)
#pragma unroll
      for (int m = 0; m < 4; ++m)
#pragma unroll
        for (int n = 0; n < 2; ++n) acc[a][b][m][n] = f32x4{0.f, 0.f, 0.f, 0.f};
  STAGE_B(SB(0, 0), 0, 0); STAGE_A(SA(0, 0), 0, 0); STAGE_B(SB(0, 1), 1, 0); if (NA == 2) STAGE_A(SA(0, 1), 1, 0);
  WAIT_V(0); __syncthreads();
#pragma unroll 1
  for (int t = 0; t < nt; ++t) {
    const int cb = t & 1, nb = cb ^ 1;
    if (t + 1 < nt) { STAGE_B(SB(nb, 0), 0, t + 1); STAGE_A(SA(nb, 0), 0, t + 1); STAGE_B(SB(nb, 1), 1, t + 1); if (NA == 2) STAGE_A(SA(nb, 1), 1, t + 1); }
#pragma unroll 1
    for (int k = 0; k < 2; ++k) {
      bf16x8 Bf[2][2];
#pragma unroll
      for (int bj = 0; bj < 2; ++bj)
#pragma unroll
        for (int n = 0; n < 2; ++n) Bf[bj][n] = *reinterpret_cast<const bf16x8*>(SB(cb, bj) + lds_byte(wc * 32 + n * 16 + fr, k * 32 + fq * 8));
#pragma unroll
      for (int ai = 0; ai < NA; ++ai) {
        bf16x8 Af[4];
#pragma unroll
        for (int m = 0; m < 4; ++m) Af[m] = *reinterpret_cast<const bf16x8*>(SA(cb, ai) + lds_byte(wr * 64 + m * 16 + fr, k * 32 + fq * 8));
#pragma unroll
        for (int bj = 0; bj < 2; ++bj)
#pragma unroll
          for (int m = 0; m < 4; ++m)
#pragma unroll
            for (int n = 0; n < 2; ++n) acc[ai][bj][m][n] = __builtin_amdgcn_mfma_f32_16x16x32_bf16(Af[m], Bf[bj][n], acc[ai][bj][m][n], 0, 0, 0);
      }
    }
    WAIT_V(0); __syncthreads();
  }
}

#define LDA8(dst, b, h) _Pragma("unroll") for (int m = 0; m < 4; ++m) _Pragma("unroll") for (int k = 0; k < 2; ++k) \
    dst[m][k] = *reinterpret_cast<const bf16x8*>(SA(b, h) + lds_byte(wr * 64 + m * 16 + fr, k * 32 + fq * 8))
#define LDB8(dst, b, h) _Pragma("unroll") for (int n = 0; n < 2; ++n) _Pragma("unroll") for (int k = 0; k < 2; ++k) \
    dst[n][k] = *reinterpret_cast<const bf16x8*>(SB(b, h) + lds_byte(wc * 32 + n * 16 + fr, k * 32 + fq * 8))
#define MMA8(ai, bj, At, Bx) do { __builtin_amdgcn_s_setprio(1); \
    _Pragma("unroll") for (int m = 0; m < 4; ++m) _Pragma("unroll") for (int n = 0; n < 2; ++n) _Pragma("unroll") for (int k = 0; k < 2; ++k) \
      acc[ai][bj][m][n] = __builtin_amdgcn_mfma_f32_16x16x32_bf16(At[m][k], Bx[n][k], acc[ai][bj][m][n], 0, 0, 0); \
    __builtin_amdgcn_s_setprio(0); } while (0)
DI void gemm_kloop8(const int TID, const u16* __restrict__ A, int lda, const u16* __restrict__ Bt, int ldb, int nt, f32x4 (&acc)[2][2][4][2]) {
  const int tid = TID, wid = tid >> 6, lane = tid & 63, wr = wid >> 2, wc = wid & 3, fr = lane & 15, fq = lane >> 4;
  unsigned offA0, offB0;
  { int r, c; stage_rc(tid * 16, r, c); offA0 = r * lda + c; offB0 = r * ldb + c; }
  const int wbase = __builtin_amdgcn_readfirstlane(wid) * 1024;
#pragma unroll
  for (int a = 0; a < 2; ++a)
#pragma unroll
    for (int b = 0; b < 2; ++b)
#pragma unroll
      for (int m = 0; m < 4; ++m)
#pragma unroll
        for (int n = 0; n < 2; ++n) acc[a][b][m][n] = f32x4{0.f, 0.f, 0.f, 0.f};
  bf16x8 At[4][2], B0[2][2], B1[2][2];
  STAGE_B(SB(0, 0), 0, 0); STAGE_A(SA(0, 0), 0, 0);
  STAGE_B(SB(0, 1), 1, 0); STAGE_A(SA(0, 1), 1, 0);
  if (wr == 1) BAR;
  WAIT_V(4); BAR;
  STAGE_B(SB(1, 0), 0, 1); STAGE_A(SA(1, 0), 0, 1); STAGE_B(SB(1, 1), 1, 1);
  WAIT_V(6); BAR;
#pragma unroll 1
  for (int t = 0; t < nt - 2; t += 2) {
    LDB8(B0, 0, 0); SCHED; LDA8(At, 0, 0); STAGE_A(SA(1, 1), 1, t + 1);
    WAIT_L(8); BAR; WAIT_L(0); MMA8(0, 0, At, B0); BAR; SCHED;
    LDB8(B1, 0, 1); STAGE_B(SB(0, 0), 0, t + 2);
    BAR; WAIT_L(0); MMA8(0, 1, At, B1); BAR;
    LDA8(At, 0, 1); STAGE_A(SA(0, 0), 0, t + 2);
    BAR; WAIT_L(0); MMA8(1, 0, At, B0); BAR; SCHED;
    STAGE_B(SB(0, 1), 1, t + 2);
    WAIT_V(6); BAR; MMA8(1, 1, At, B1); BAR;
    LDB8(B0, 1, 0); SCHED; LDA8(At, 1, 0); STAGE_A(SA(0, 1), 1, t + 2);
    WAIT_L(8); BAR; WAIT_L(0); MMA8(0, 0, At, B0); BAR; SCHED;
    LDB8(B1, 1, 1); STAGE_B(SB(1, 0), 0, t + 3);
    BAR; WAIT_L(0); MMA8(0, 1, At, B1); BAR;
    LDA8(At, 1, 1); STAGE_A(SA(1, 0), 0, t + 3);
    BAR; WAIT_L(0); MMA8(1, 0, At, B0); BAR; SCHED;
    STAGE_B(SB(1, 1), 1, t + 3);
    WAIT_V(6); BAR; MMA8(1, 1, At, B1); BAR;
  }
  { LDB8(B0, 0, 0); LDA8(At, 0, 0); STAGE_A(SA(1, 1), 1, nt - 1);
    BAR; WAIT_L(0); MMA8(0, 0, At, B0); BAR;
    LDB8(B1, 0, 1); BAR; WAIT_L(0); MMA8(0, 1, At, B1); BAR;
    LDA8(At, 0, 1); WAIT_V(4); BAR; WAIT_L(0); MMA8(1, 0, At, B0); MMA8(1, 1, At, B1); BAR; }
  { LDB8(B0, 1, 0); LDA8(At, 1, 0); WAIT_V(2); BAR; WAIT_L(0); MMA8(0, 0, At, B0); BAR;
    LDB8(B1, 1, 1); WAIT_V(0); BAR; WAIT_L(0); MMA8(0, 1, At, B1); BAR;
    LDA8(At, 1, 1); BAR; WAIT_L(0); MMA8(1, 0, At, B0); MMA8(1, 1, At, B1); BAR; }
  if (wr == 0) BAR;
  __syncthreads();
}

DI void gemm_kloop_r3(const int TID, const u16* __restrict__ A, int lda, const u16* __restrict__ Bt, int ldb, int nt, f32x4 (&acc)[1][2][4][2]) {
  const int tid = TID, wid = tid >> 6, lane = tid & 63, wr = wid >> 2, wc = wid & 3, fr = lane & 15, fq = lane >> 4;
  unsigned offA0, offB0;
  { int r, c; stage_rc(tid * 16, r, c); offA0 = r * lda + c; offB0 = r * ldb + c; }
  const int wbase = __builtin_amdgcn_readfirstlane(wid) * 1024;
#pragma unroll
  for (int b = 0; b < 2; ++b)
#pragma unroll
    for (int m = 0; m < 4; ++m)
#pragma unroll
      for (int n = 0; n < 2; ++n) acc[0][b][m][n] = f32x4{0.f, 0.f, 0.f, 0.f};
#define R3A(i) (smem + (i) * 49152)
#define R3B(i, h) (smem + (i) * 49152 + 16384 + (h) * 16384)
#define R3_STAGE(i, kt) do { STAGE_B(R3B(i, 0), 0, kt); STAGE_A(R3A(i), 0, kt); STAGE_B(R3B(i, 1), 1, kt); } while (0)
  R3_STAGE(0, 0); R3_STAGE(1, 1);
  WAIT_V(6); BAR;
  int cur = 0;
#pragma unroll 1
  for (int t = 0; t < nt; ++t) {
    const int nx1 = (cur == 2) ? 0 : cur + 1, nx2 = (cur == 0) ? 2 : cur - 1;
    if (t + 2 < nt) R3_STAGE(nx2, t + 2);
#pragma unroll
    for (int k = 0; k < 2; ++k) {
      bf16x8 Bf[2][2], Af[4];
#pragma unroll
      for (int bj = 0; bj < 2; ++bj)
#pragma unroll
        for (int n = 0; n < 2; ++n) Bf[bj][n] = *reinterpret_cast<const bf16x8*>(R3B(cur, bj) + lds_byte(wc * 32 + n * 16 + fr, k * 32 + fq * 8));
#pragma unroll
      for (int m = 0; m < 4; ++m) Af[m] = *reinterpret_cast<const bf16x8*>(R3A(cur) + lds_byte(wr * 64 + m * 16 + fr, k * 32 + fq * 8));
#pragma unroll
      for (int bj = 0; bj < 2; ++bj)
#pragma unroll
        for (int m = 0; m < 4; ++m)
#pragma unroll
          for (int n = 0; n < 2; ++n) acc[0][bj][m][n] = __builtin_amdgcn_mfma_f32_16x16x32_bf16(Af[m], Bf[bj][n], acc[0][bj][m][n], 0, 0, 0);
    }
    if (t + 2 < nt) WAIT_V(6); else WAIT_V(0);
    WAIT_L(0); BAR;
    cur = nx1;
  }
}

DI void tile_coords(int tile, int nM, int nN, int& pm, int& pn) {
  int nig = 8 * nN, gid = tile / nig, fm = gid * 8, gsz = min(nM - fm, 8), loc = tile % nig;
  pm = fm + loc % gsz; pn = loc / gsz;
}

#define GEMM_IDS const int tid = TID, wid = tid >> 6, lane = tid & 63, wr = wid >> 2, wc = wid & 3, fr = lane & 15, fq = lane >> 4; (void)tid; (void)wr; (void)wc; (void)fr; (void)fq; (void)lane;
DI int fresh_tid(int wv) { int l; asm volatile("v_mbcnt_lo_u32_b32 %0, -1, 0\n\tv_mbcnt_hi_u32_b32 %0, -1, %0" : "=v"(l)); return wv * 64 + l; }
DI int opaque_zero() { int z; asm volatile("s_mov_b32 %0, 0" : "=s"(z)); return z; }
#define ACC_TO_LDS(ai) do { float* _e = (float*)smem; \
  _Pragma("unroll") for (int bj = 0; bj < 2; ++bj) _Pragma("unroll") for (int m = 0; m < 4; ++m) _Pragma("unroll") for (int n = 0; n < 2; ++n) _Pragma("unroll") for (int j = 0; j < 4; ++j) \
    _e[(wr * 64 + m * 16 + fq * 4 + j) * EP_LD + bj * 128 + wc * 32 + n * 16 + fr] = acc[ai][bj][m][n][j]; } while (0)
#define EPI_ROWS_BEGIN(ai) _Pragma("unroll 4") for (int _it = 0; _it < 16; ++_it) { const int _idx = _it * 512 + tid; const int rl = _idx >> 6, cl = (_idx & 63) * 4; \
    const float4 v = *(const float4*)((const float*)smem + rl * EP_LD + cl); const int row = browz + (ai) * 128 + rl; const int col = bcol + cl; (void)row; (void)col;
#define EPI_ROWS_END }
DI uint2 pk4(float a, float b, float c, float d) { uint2 o; o.x = pk2(a, b); o.y = pk2(c, d); return o; }

DI void sgemm16(const int lane, const u16* __restrict__ A, int lda, const u16* __restrict__ Bt, int ldb, int K, int bc0, int bc1, f32x4& c0, f32x4& c1) {
  const int fr = lane & 15, fq = lane >> 4;
  const u16* ap = A + (long)fr * lda + fq * 8;
  const u16* b0 = Bt + (long)(bc0 + fr) * ldb + fq * 8; const u16* b1 = Bt + (long)(bc1 + fr) * ldb + fq * 8;
  c0 = f32x4{0.f, 0.f, 0.f, 0.f}; c1 = c0;
#pragma unroll 8
  for (int k = 0; k < K; k += 32) { const bf16x8 a = *(const bf16x8*)(ap + k), x = *(const bf16x8*)(b0 + k), y = *(const bf16x8*)(b1 + k);
    c0 = __builtin_amdgcn_mfma_f32_16x16x32_bf16(a, x, c0, 0, 0, 0); c1 = __builtin_amdgcn_mfma_f32_16x16x32_bf16(a, y, c1, 0, 0, 0); }
}
DI void inproj_store_s(KP p, int l, int row, int col, float v) {
  unsigned char* ws = p->ws; u16* proj = (u16*)(ws + WS_PROJ);
  const int rs = row - MP;
  if (col >= PC_G) proj[(long)row * NPJ + col] = f2bf(sigm(v));
  else if (col >= PC_QD && col < PC_KD) proj[(long)row * NPJ + col] = f2bf(v * QD_SCALE);
  else if (col >= PC_KD && col < PC_VD) { const int hv = col - PC_KD; p->out[O_SDK + (long)l * MS * 512 + rs * 512 + hv] = v;
    ((u16*)(ws + WS_KDS))[((long)(rs >> 4) * SKP + PAST + (rs & 15)) * 512 + hv] = f2bf(v); }
  else if (col >= PC_VD && col < PC_ZD) { const int hv = col - PC_VD; p->out[O_SDV + (long)l * MS * 512 + rs * 512 + hv] = v;
    ((u16*)(ws + WS_VDTS))[((long)(rs >> 4) * 512 + hv) * SKP + kperm(PAST + (rs & 15))] = f2bf(v); }
  else proj[(long)row * NPJ + col] = f2bf(v);
}

template <bool PERM> DI void transpose_tile(const int TID, const float* __restrict__ src, long ld_s, u16* __restrict__ dst, long ld_d, int r0, int c0, int drow0) {
  u16* tl = (u16*)smem;
  const int tid = TID;
  { int rr = tid >> 3, cc = (tid & 7) * 4; float4 v = *(const float4*)(src + (long)(r0 + rr) * ld_s + c0 + cc);
    tl[(cc + 0) * 72 + rr] = f2bf(v.x); tl[(cc + 1) * 72 + rr] = f2bf(v.y); tl[(cc + 2) * 72 + rr] = f2bf(v.z); tl[(cc + 3) * 72 + rr] = f2bf(v.w); }
  __syncthreads();
  if (tid < 256) { int cc = tid >> 3, rr = (tid & 7) * 8; uint4 v = *(const uint4*)(tl + cc * 72 + rr);
    if (PERM) { u16* d = dst + (long)(drow0 + cc) * ld_d; *(uint2*)(d + kperm(r0 + rr)) = uint2{v.x, v.y}; *(uint2*)(d + kperm(r0 + rr + 4)) = uint2{v.z, v.w}; }
    else *(uint4*)(dst + (long)(drow0 + cc) * ld_d + r0 + rr) = v; }
  __syncthreads();
}

DI void rmsnorm_rows_to_bf16(const int TID, KP p, int l) {
  const int lane = TID & 63, wid = TID >> 6;
  const float* g = p->in[8] + l * D;
  u16* xn = (u16*)(p->ws + WS_XN);
  for (int row = blockIdx.x * 8 + wid; row < M; row += gridDim.x * 8) {
    const float* src = (l == 0) ? (row < MP ? p->in[0] + (long)row * D : p->in[1] + (long)(row - MP) * D) : p->out + (long)row * D;
    float4 v[4]; float ss = 0.f;
#pragma unroll
    for (int i = 0; i < 4; ++i) { v[i] = *(const float4*)(src + i * 256 + lane * 4); ss += v[i].x * v[i].x + v[i].y * v[i].y + v[i].z * v[i].z + v[i].w * v[i].w; }
    ss = wsum(ss); const float rs = rsqrtf(ss * (1.f / D) + EPS);
#pragma unroll
    for (int i = 0; i < 4; ++i) { float4 gg = *(const float4*)(g + i * 256 + lane * 4);
      uint2 o; o.x = pk2(v[i].x * rs * gg.x, v[i].y * rs * gg.y); o.y = pk2(v[i].z * rs * gg.z, v[i].w * rs * gg.w);
      *(uint2*)(xn + (long)row * D + i * 256 + lane * 4) = o; }
  }
}

DI void prep_phase(const int TID, KP p, int l) {
  const int tid = TID, G = gridDim.x, bx = blockIdx.x;
  const long gtid = (long)bx * 512 + tid, gn = (long)G * 512;
  unsigned char* ws = p->ws;
  rmsnorm_rows_to_bf16(TID, p, l);
  { const float* w = p->in[9] + (long)l * 1024 * NIN; u16* d = (u16*)(ws + WS_WIN);
    for (int i = bx; i < 16 * 221; i += G) { int kt = i & 15, ct = i >> 4, c0 = ct * 32; transpose_tile<false>(TID, w, NIN, d, 1024, kt * 64, c0, c0 < 416 ? c0 : c0 + 96); }
    for (long i = gtid; i < 96 * 1024 / 8; i += gn) { const unsigned z = (unsigned)TID >> 31; ((uint4*)(d + 416 * 1024))[i] = uint4{z, z, z, z}; } }
  for (int b = 0; b < 3; ++b) { const float* w = p->in[27 + b] + (long)l * 512 * 1024; u16* d = (u16*)(ws + WS_WO) + (long)b * 1024 * 512;
    for (int i = bx; i < 8 * 32; i += G) { int rt = i & 7, ct = i >> 3; transpose_tile<false>(TID, w, 1024, d, 512, rt * 64, ct * 32, ct * 32); } }
  { const float* w = p->in[30] + (long)l * 1024 * 1024; u16* d = (u16*)(ws + WS_WOUT);
    for (int i = bx; i < 16 * 32; i += G) { int rt = i & 15, ct = i >> 4; transpose_tile<false>(TID, w, 1024, d, 1024, rt * 64, ct * 32, ct * 32); } }
  { const float* c = p->in[2] + (long)l * 8 * PAST * 128; u16* d = (u16*)(ws + WS_CKVTS);
    for (int i = bx; i < 8 * 32 * 4; i += G) { int sb = i >> 7, r = i & 127, rt = r & 31, ct = r >> 5;
      transpose_tile<true>(TID, c + (long)sb * PAST * 128, 128, d + (long)sb * 128 * SKP, SKP, rt * 64, ct * 32, ct * 32); } }
  { const float* c = p->in[5] + (long)l * 8 * PAST * 512; u16* d = (u16*)(ws + WS_VDTS);
    for (int i = bx; i < 8 * 32 * 16; i += G) { int sb = i >> 9, r = i & 511, rt = r & 31, ct = r >> 5;
      transpose_tile<true>(TID, c + (long)sb * PAST * 512, 512, d + (long)sb * 512 * SKP, SKP, rt * 64, ct * 32, ct * 32); } }
  { const float* c = p->in[2] + (long)l * 8 * PAST * 128; u16* d = (u16*)(ws + WS_CKVS);
    for (long i = gtid; i < 8L * PAST * 128 / 4; i += gn) { long e = i * 4; int sb = (int)(e / (PAST * 128)); long r = e - (long)sb * PAST * 128;
      float4 v = *(const float4*)(c + e); uint2 o; o.x = pk2(v.x, v.y); o.y = pk2(v.z, v.w); *(uint2*)(d + (long)sb * SKP * 128 + r) = o; } }
  { const float* c = p->in[3] + (long)l * 8 * PAST * 32; u16* d = (u16*)(ws + WS_KRS);
    for (long i = gtid; i < 8L * PAST * 32 / 4; i += gn) { long e = i * 4; int sb = (int)(e / (PAST * 32)); long r = e - (long)sb * PAST * 32;
      float4 v = *(const float4*)(c + e); uint2 o; o.x = pk2(v.x, v.y); o.y = pk2(v.z, v.w); *(uint2*)(d + (long)sb * SKP * 32 + r) = o; } }
  { const float* c = p->in[4] + (long)l * 8 * PAST * 512; u16* d = (u16*)(ws + WS_KDS);
    for (long i = gtid; i < 8L * PAST * 512 / 4; i += gn) { long e = i * 4; int sb = (int)(e / (PAST * 512)); long r = e - (long)sb * PAST * 512;
      float4 v = *(const float4*)(c + e); uint2 o; o.x = pk2(v.x, v.y); o.y = pk2(v.z, v.w); *(uint2*)(d + (long)sb * SKP * 512 + r) = o; } }
  for (long i = gtid; i < 8L * 48 * 128; i += gn) { int sb = (int)(i / (48 * 128)); int r = (int)(i % (48 * 128)); ((u16*)(ws + WS_CKVS))[((long)sb * SKP + SK) * 128 + r] = 0; }
  for (long i = gtid; i < 8L * 48 * 32; i += gn) { int sb = (int)(i / (48 * 32)); int r = (int)(i % (48 * 32)); ((u16*)(ws + WS_KRS))[((long)sb * SKP + SK) * 32 + r] = 0; }
  for (long i = gtid; i < 8L * 48 * 512; i += gn) { int sb = (int)(i / (48 * 512)); int r = (int)(i % (48 * 512)); ((u16*)(ws + WS_KDS))[((long)sb * SKP + SK) * 512 + r] = 0; }
  for (long i = gtid; i < 8L * 128 * 48; i += gn) { int rw = (int)(i / 48), k = (int)(i % 48); ((u16*)(ws + WS_CKVTS))[(long)rw * SKP + SK + k] = 0; }
  for (long i = gtid; i < 8L * 512 * 48; i += gn) { int rw = (int)(i / 48), k = (int)(i % 48); ((u16*)(ws + WS_VDTS))[(long)rw * SKP + SK + k] = 0; }
  { const float* uq = p->in[12] + (long)l * 256 * 768; const float* uk = p->in[13] + (long)l * 128 * 512; u16* d = (u16*)(ws + WS_WQ);
    for (long i = gtid; i < 1280L * 256; i += gn) { int n = (int)(i >> 8), r = (int)(i & 255); float s;
      if (n < 1024) { int hd = n >> 7, c = n & 127; const float* a = uq + r * 768 + hd * 96; const float* b = uk + c * 512 + hd * 64; s = 0.f;
        for (int dd = 0; dd < 64; dd += 4) { float4 x = *(const float4*)(a + dd), y = *(const float4*)(b + dd); s += x.x * y.x + x.y * y.y + x.z * y.z + x.w * y.w; } }
      else { int hd = (n - 1024) >> 5, j = (n - 1024) & 31; s = uq[r * 768 + hd * 96 + 64 + j]; }
      d[i] = f2bf(s); } }
  { const float* uv = p->in[14] + (long)l * 128 * 512; u16* d = (u16*)(ws + WS_WUV);
    for (long i = gtid; i < 512L * 512; i += gn) { int n = (int)(i >> 9), kk = (int)(i & 511); int hd = n >> 6, v = n & 63, hk = (n >> 8) * 4 + (kk >> 7), c = kk & 127;
      d[i] = (hk == hd) ? f2bf(uv[c * 512 + hd * 64 + v]) : (u16)0; } }
  { const float* wa = p->in[22] + (long)l * 8 * 4096; const float* wx = p->in[24] + (long)l * 8 * 4096; u16* d = (u16*)(ws + WS_WLRU);
    for (long i = gtid; i < 1024L * 256; i += gn) { int nn = (int)(i >> 8), kk = (int)(i & 255); int pn = nn >> 8, nl = nn & 255; int f = pn * 128 + (nl & 127);
      int blk = f >> 6, o = f & 63, bk = (pn >> 1) * 4 + (kk >> 6), ii = kk & 63; const float* w = (nl < 128) ? wa : wx;
      d[i] = (bk == blk) ? f2bf(w[blk * 4096 + ii * 64 + o]) : (u16)0; } }
  if (bx == 0 && tid == 0) {
    float s1 = 0.f, s2 = 0.f;
    for (int i = 0; i < 32; ++i) { s1 += p->in[15][l * 32 + i] * p->in[16][l * 32 + i]; s2 += p->in[17][l * 32 + i] * p->in[18][l * 32 + i]; }
    const float lam_init = 0.8f - 0.6f * expf(-0.3f * (float)l);
    float* sc = (float*)(ws + WS_CTL + 1024);
    sc[l * 2 + 0] = expf(s1) - expf(s2) + lam_init; sc[l * 2 + 1] = lam_init;
  }
  if (l == 0) {
    float2* tab = (float2*)(ws + WS_ROPE);
    for (long i = gtid; i < 4096 * 16; i += gn) { int pos = (int)(i >> 4), j = (int)(i & 15);
      const float a = (float)pos * g_invf[j];
      const float k = rintf(a * 0.63661977236758134f);
      float y = fmaf(-k, 1.5707963109016418f, a); y = fmaf(-k, 1.5893254712295857e-08f, y); y = fmaf(-k, 6.0770999344e-16f, y);
      const float y2 = y * y;
      const float sn = y * (1.f + y2 * (-1.6666667163e-01f + y2 * (8.3333337680e-03f + y2 * (-1.9841270114e-04f + y2 * 2.7557314297e-06f))));
      const float cs = 1.f + y2 * (-0.5f + y2 * (4.1666667908e-02f + y2 * (-1.3888889225e-03f + y2 * (2.4801587642e-05f + y2 * -2.7557314297e-07f))));
      const int q = ((int)k) & 3;
      const float c2 = (q == 0) ? cs : (q == 1) ? -sn : (q == 2) ? -cs : sn;
      const float s2 = (q == 0) ? sn : (q == 1) ? cs : (q == 2) ? -sn : -cs;
      tab[i] = float2{c2, s2}; }
  }
}

DI void inproj_phase(const int TID_in, KP p, int l, int vid) {
  const int wv = __builtin_amdgcn_readfirstlane(TID_in >> 6);
  unsigned char* ws = p->ws;
  f32x4 acc[2][2][4][2];
  for (int tile = vid; tile < 64 * 28; tile += gridDim.x) {
    int pm, pn; tile_coords(tile, 64, 28, pm, pn);
    const int brow = pm * 256, bcol = pn * 256;
    gemm_kloop8(fresh_tid(wv), (const u16*)(ws + WS_XN) + (long)brow * 1024, 1024, (const u16*)(ws + WS_WIN) + (long)bcol * 1024, 1024, 16, acc);
    const int TID = fresh_tid(wv);
    GEMM_IDS
    const int oz = opaque_zero(); const int browz = brow + oz;
    u16* proj = (u16*)(ws + WS_PROJ) + oz;
#pragma unroll
    for (int ai = 0; ai < 2; ++ai) {
      ACC_TO_LDS(ai);
      __syncthreads();
      if (pn >= 16) {
        EPI_ROWS_BEGIN(ai) *(uint2*)(proj + (long)row * NPJ + col) = pk4(sigm(v.x), sigm(v.y), sigm(v.z), sigm(v.w)); EPI_ROWS_END
      } else if (pn == 4 || pn == 5) {
        EPI_ROWS_BEGIN(ai) *(uint2*)(proj + (long)row * NPJ + col) = pk4(v.x * QD_SCALE, v.y * QD_SCALE, v.z * QD_SCALE, v.w * QD_SCALE); EPI_ROWS_END
      } else if (pn == 6 || pn == 7) {
        u16* kds = (u16*)(ws + WS_KDS) + oz;
        EPI_ROWS_BEGIN(ai)
          const int hv = col - PC_KD; const uint2 pk = pk4(v.x, v.y, v.z, v.w);
          *(uint2*)(proj + (long)row * NPJ + col) = pk;
          if (row < MP) *(float4*)(p->out + O_PDK + (long)l * MP * 512 + (long)row * 512 + hv) = v;
          else if (row < M) { const int rs = row - MP; *(float4*)(p->out + O_SDK + (long)l * MS * 512 + rs * 512 + hv) = v;
            *(uint2*)(kds + ((long)(rs >> 4) * SKP + PAST + (rs & 15)) * 512 + hv) = pk; }
        EPI_ROWS_END
      } else if (pn == 8 || pn == 9) {
        EPI_ROWS_BEGIN(ai)
          const int hv = col - PC_VD;
          if (row < MP) *(float4*)(p->out + O_PDV + (long)l * MP * 512 + (long)row * 512 + hv) = v;
          else if (row < M) *(float4*)(p->out + O_SDV + (long)l * MS * 512 + (row - MP) * 512 + hv) = v;
        EPI_ROWS_END
        u16* vtp = (u16*)(ws + WS_VDTP) + oz; u16* vts = (u16*)(ws + WS_VDTS) + oz;
#pragma unroll 4
        for (int it = 0; it < 16; ++it) { const int idx = it * 512 + tid; const int cl = idx & 255, r4 = (idx >> 8) * 4;
          const float* e = (const float*)smem + r4 * EP_LD + cl;
          const uint2 pk = pk4(e[0], e[EP_LD], e[2 * EP_LD], e[3 * EP_LD]);
          const int row0 = browz + ai * 128 + r4, hv = bcol + cl - PC_VD;
          if (row0 < MP) *(uint2*)(vtp + ((long)(row0 >> 12) * 512 + hv) * TP + kperm(row0 & (TP - 1))) = pk;
          else if (row0 < M) { const int rs = row0 - MP; *(uint2*)(vts + ((long)(rs >> 4) * 512 + hv) * SKP + kperm(PAST + (rs & 15))) = pk; } }
      } else {
        EPI_ROWS_BEGIN(ai) *(uint2*)(proj + (long)row * NPJ + col) = pk4(v.x, v.y, v.z, v.w); EPI_ROWS_END
      }
      __syncthreads();
    }
  }
  const int TID = fresh_tid(wv);
  GEMM_IDS
  for (int it = (int)gridDim.x - 1 - vid; it < 8 * 28; it += gridDim.x) {
    const int rg = it & 7, pn = it >> 3; const int row0 = MP + rg * 16, bcol = pn * 256;
    f32x4 c0, c1;
    sgemm16(lane, (const u16*)(ws + WS_XN) + (long)row0 * 1024, 1024, (const u16*)(ws + WS_WIN) + (long)bcol * 1024, 1024, 1024, wid * 32, wid * 32 + 16, c0, c1);
#pragma unroll
    for (int j = 0; j < 4; ++j) { const int row = row0 + fq * 4 + j; inproj_store_s(p, l, row, bcol + wid * 32 + fr, c0[j]); inproj_store_s(p, l, row, bcol + wid * 32 + 16 + fr, c1[j]); }
  }
}

template <int NR> DI void mid_unit(const int TID, KP p, int l, const int r0) {
  const int tid = TID, lane = tid & 63, wid = tid >> 6;
  unsigned char* ws = p->ws;
  u16* proj = (u16*)(ws + WS_PROJ);
  u16* tl = (u16*)smem;
  const float* gq = p->in[10] + l * 256; const float* gkv = p->in[11] + l * 128;
  const float2* rope = (const float2*)(ws + WS_ROPE);
  const float* cw = p->in[20] + l * 4 * 512; const float* cb = p->in[21] + l * 512;
  u16* xc = (u16*)(ws + WS_XC);
  const int rw0 = r0 + wid * NR;
  const bool pr = rw0 < MP; const int rs0 = rw0 - MP;
  const int b = pr ? (rw0 >> 12) : (rs0 >> 4), t0 = pr ? (rw0 & (TP - 1)) : (rs0 & 15);
  u16* prow0 = proj + (long)rw0 * NPJ;
  {
    uint2 vq[NR]; u32 vk[NR]; float x1[NR], x2[NR];
#pragma unroll
    for (int i = 0; i < NR; ++i) { const u16* pw = prow0 + (long)i * NPJ; vq[i] = *(const uint2*)(pw + PC_CQ + lane * 4); vk[i] = *(const u32*)(pw + PC_CKV + lane * 2);
      x1[i] = bf2f(pw[PC_KR + (lane & 15)]); x2[i] = bf2f(pw[PC_KR + 16 + (lane & 15)]); }
    const float4 g4 = *(const float4*)(gq + lane * 4); const float2 g2 = *(const float2*)(gkv + lane * 2);
#pragma unroll
    for (int i = 0; i < NR; ++i) {
      const int row = rw0 + i, t = t0 + i, pos = pr ? t : PAST + t; const int rs = row - MP;
      u16* prow = prow0 + (long)i * NPJ;
      { float a0 = lo2f(vq[i].x), a1 = hi2f(vq[i].x), a2 = lo2f(vq[i].y), a3 = hi2f(vq[i].y);
        float ss = wsum(a0 * a0 + a1 * a1 + a2 * a2 + a3 * a3); float rsd = rsqrtf(ss * (1.f / 256) + EPS);
        *(uint2*)(prow + PC_CQ + lane * 4) = pk4(a0 * rsd * g4.x, a1 * rsd * g4.y, a2 * rsd * g4.z, a3 * rsd * g4.w); }
      { float a0 = lo2f(vk[i]), a1 = hi2f(vk[i]);
        float ss = wsum(a0 * a0 + a1 * a1); float rsd = rsqrtf(ss * (1.f / 128) + EPS);
        float y0 = a0 * rsd * g2.x, y1 = a1 * rsd * g2.y;
        float* so = pr ? p->out + O_PCKV + (long)l * MP * 128 + (long)row * 128 : p->out + O_SCKV + (long)l * MS * 128 + rs * 128;
        *(float2*)(so + lane * 2) = float2{y0, y1};
        u32 pk = pk2(y0, y1);
        u16* kb = pr ? (u16*)(ws + WS_CKVP) + (long)row * 128 : (u16*)(ws + WS_CKVS) + ((long)b * SKP + PAST + t) * 128;
        *(u32*)(kb + lane * 2) = pk;
        tl[(lane * 2) * 72 + wid * NR + i] = (u16)(pk & 0xffff); tl[(lane * 2 + 1) * 72 + wid * NR + i] = (u16)(pk >> 16); }
      if (lane < 16) {
        float2 cs = rope[pos * 16 + lane];
        float o1 = x1[i] * cs.x - x2[i] * cs.y, o2 = x2[i] * cs.x + x1[i] * cs.y;
        float* so = pr ? p->out + O_PKR + (long)l * MP * 32 + (long)row * 32 : p->out + O_SKR + (long)l * MS * 32 + rs * 32;
        so[lane] = o1; so[lane + 16] = o2;
        u16* kb = pr ? (u16*)(ws + WS_KRP) + (long)row * 32 : (u16*)(ws + WS_KRS) + ((long)b * SKP + PAST + t) * 32;
        kb[lane] = f2bf(o1); kb[lane + 16] = f2bf(o2); }
    }
  }
  {
    const int f = lane * 8;
    uint4 xin[NR + 3];
#pragma unroll
    for (int k = 0; k < NR + 3; ++k) {
      const int tt = t0 + k - 3;
      if (tt >= 0) xin[k] = *(const uint4*)(prow0 + (long)(k - 3) * NPJ + PC_XL + f);
      else if (!pr) { const float* c0 = p->in[7] + (((long)l * 8 + b) * 3 + (tt + 3)) * 512 + f; float4 u0 = *(const float4*)c0, u1 = *(const float4*)(c0 + 4);
        xin[k] = uint4{pk2(u0.x, u0.y), pk2(u0.z, u0.w), pk2(u1.x, u1.y), pk2(u1.z, u1.w)}; }
      else xin[k] = uint4{0u, 0u, 0u, 0u};
    }
    float4 w[4][2];
#pragma unroll
    for (int k = 0; k < 4; ++k) { w[k][0] = *(const float4*)(cw + k * 512 + f); w[k][1] = *(const float4*)(cw + k * 512 + f + 4); }
    const float4 b0 = *(const float4*)(cb + f), b1 = *(const float4*)(cb + f + 4);
    const int T = pr ? TP : TS;
#pragma unroll
    for (int i = 0; i < NR; ++i) {
      float a[8] = {b0.x, b0.y, b0.z, b0.w, b1.x, b1.y, b1.z, b1.w};
#pragma unroll
      for (int k = 0; k < 4; ++k) { const uint4 v = xin[i + k];
        a[0] += lo2f(v.x) * w[k][0].x; a[1] += hi2f(v.x) * w[k][0].y; a[2] += lo2f(v.y) * w[k][0].z; a[3] += hi2f(v.y) * w[k][0].w;
        a[4] += lo2f(v.z) * w[k][1].x; a[5] += hi2f(v.z) * w[k][1].y; a[6] += lo2f(v.w) * w[k][1].z; a[7] += hi2f(v.w) * w[k][1].w; }
      *(uint4*)(xc + (long)(rw0 + i) * 512 + f) = uint4{pk2(a[0], a[1]), pk2(a[2], a[3]), pk2(a[4], a[5]), pk2(a[6], a[7])};
      const int t = t0 + i;
      if (t >= T - 3) { const uint4 v = xin[i + 3];
        float* so = pr ? p->out + O_PCV + (((long)l * 4 + b) * 3 + (t - (T - 3))) * 512 + f : p->out + O_SCV + (((long)l * 8 + b) * 3 + (t - (T - 3))) * 512 + f;
        *(float4*)so = float4{lo2f(v.x), hi2f(v.x), lo2f(v.y), hi2f(v.y)}; *(float4*)(so + 4) = float4{lo2f(v.z), hi2f(v.z), lo2f(v.w), hi2f(v.w)}; }
    }
  }
  __syncthreads();
  for (int id = tid; id < 128 * NR; id += 512) { const int c = id / NR, rg = id % NR; const int row = r0 + rg * 8;
    uint4 v = *(const uint4*)(tl + c * 72 + rg * 8);
    u16* dbase = (row < MP) ? (u16*)(ws + WS_CKVTP) + ((long)(row >> 12) * 128 + c) * TP : (u16*)(ws + WS_CKVTS) + ((long)((row - MP) >> 4) * 128 + c) * SKP;
    const int key = (row < MP) ? (row & (TP - 1)) : PAST + ((row - MP) & 15);
    *(uint2*)(dbase + kperm(key)) = uint2{v.x, v.y}; *(uint2*)(dbase + kperm(key + 4)) = uint2{v.z, v.w}; }
  __syncthreads();
}
DI void mid_phase(const int TID, KP p, int l) {
  for (int u = blockIdx.x; u < 256 + 16; u += gridDim.x) {
    if (u < 256) mid_unit<8>(TID, p, l, u * 64);
    else mid_unit<1>(TID, p, l, MP + (u - 256) * 8);
  }
}

DI void qlru_phase(const int TID_in, KP p, int l, int vid) {
  const int wv = __builtin_amdgcn_readfirstlane(TID_in >> 6);
  unsigned char* ws = p->ws;
  f32x4 acc[2][2][4][2];
  for (int tile = vid; tile < 64 * 9; tile += gridDim.x) {
    if (tile < 64 * 5) {
      int pm, pn; tile_coords(tile, 64, 5, pm, pn);
      const int brow = pm * 256, bcol = pn * 256;
      gemm_kloop8(fresh_tid(wv), (const u16*)(ws + WS_PROJ) + (long)brow * NPJ + PC_CQ, NPJ, (const u16*)(ws + WS_WQ) + (long)bcol * 256, 256, 4, acc);
      const int TID = fresh_tid(wv);
      GEMM_IDS
      const int oz = opaque_zero(); const int browz = brow + oz;
      u16* qm = (u16*)(ws + WS_QMLA) + oz;
#pragma unroll
      for (int ai = 0; ai < 2; ++ai) {
        ACC_TO_LDS(ai);
        __syncthreads();
        if (pn < 4) {
          EPI_ROWS_BEGIN(ai) *(uint2*)(qm + (long)row * 1280 + col) = pk4(v.x * QM_SCALE, v.y * QM_SCALE, v.z * QM_SCALE, v.w * QM_SCALE); EPI_ROWS_END
        } else {
          const float2* rope = (const float2*)(ws + WS_ROPE) + oz;
#pragma unroll 2
          for (int it = 0; it < 8; ++it) { const int idx = it * 512 + tid; const int rl = idx >> 5, hd = (idx >> 2) & 7, j4 = (idx & 3) * 4;
            const int row = browz + ai * 128 + rl;
            if (row < M) {
              const float* e = (const float*)smem + rl * EP_LD + hd * 32 + j4;
              const float4 x1 = *(const float4*)e, x2 = *(const float4*)(e + 16);
              const float4 c01 = *(const float4*)(rope + row_pos(row) * 16 + j4), c23 = *(const float4*)(rope + row_pos(row) * 16 + j4 + 2);
              u16* q = qm + (long)row * 1280 + 1024 + hd * 32 + j4;
              *(uint2*)q = pk4((x1.x * c01.x - x2.x * c01.y) * QM_SCALE, (x1.y * c01.z - x2.y * c01.w) * QM_SCALE, (x1.z * c23.x - x2.z * c23.y) * QM_SCALE, (x1.w * c23.z - x2.w * c23.w) * QM_SCALE);
              *(uint2*)(q + 16) = pk4((x2.x * c01.x + x1.x * c01.y) * QM_SCALE, (x2.y * c01.z + x1.y * c01.w) * QM_SCALE, (x2.z * c23.x + x1.z * c23.y) * QM_SCALE, (x2.w * c23.z + x1.w * c23.w) * QM_SCALE); } }
        }
        __syncthreads();
      }
    } else {
      int pm, pn; tile_coords(tile - 64 * 5, 64, 4, pm, pn);
      const int brow = pm * 256;
      gemm_kloop8(fresh_tid(wv), (const u16*)(ws + WS_XC) + (long)brow * 512 + (pn >> 1) * 256, 512, (const u16*)(ws + WS_WLRU) + (long)pn * 256 * 256, 256, 4, acc);
      const int TID = fresh_tid(wv);
      GEMM_IDS
      const int oz = opaque_zero(); const int browz = brow + oz;
      const u16* xc = (const u16*)(ws + WS_XC) + oz;
      float* ab = (float*)(ws + WS_A) + oz; float* bb = (float*)(ws + WS_B) + oz;
      const float* ba = p->in[23] + l * 512; const float* bxx = p->in[25] + l * 512; const float* lamb = p->in[26] + l * 512;
#pragma unroll
      for (int ai = 0; ai < 2; ++ai) {
        ACC_TO_LDS(ai);
        __syncthreads();
#pragma unroll 2
        for (int it = 0; it < 8; ++it) { const int idx = it * 512 + tid; const int rl = idx >> 5, f4 = (idx & 31) * 4;
          const int row = browz + ai * 128 + rl;
          if (row < M) {
            const float* e = (const float*)smem + rl * EP_LD + f4;
            const float4 ra = *(const float4*)e, rx = *(const float4*)(e + 128);
            const int f = pn * 128 + f4;
            const float4 lb = *(const float4*)(lamb + f), bav = *(const float4*)(ba + f), bxv = *(const float4*)(bxx + f);
            const uint2 xv = *(const uint2*)(xc + (long)row * 512 + f);
            const bool first = (row < MP) && ((row & (TP - 1)) == 0);
            float av[4], bv[4];
            const float raa[4] = {ra.x, ra.y, ra.z, ra.w}, rxa[4] = {rx.x, rx.y, rx.z, rx.w}, lba[4] = {lb.x, lb.y, lb.z, lb.w};
            const float baa[4] = {bav.x, bav.y, bav.z, bav.w}, bxa[4] = {bxv.x, bxv.y, bxv.z, bxv.w};
            const float xca[4] = {lo2f(xv.x), hi2f(xv.x), lo2f(xv.y), hi2f(xv.y)};
#pragma unroll
            for (int k = 0; k < 4; ++k) { const float nl = -lba[k]; const float sp = softplus_f(nl);
              const float r = sigm(raa[k] + baa[k]), ii = sigm(rxa[k] + bxa[k]); const float la = -8.f * r * sp;
              av[k] = __expf(la); const float mult = first ? 1.f : sqrtf(neg_expm1(2.f * la)); bv[k] = mult * ii * xca[k]; }
            *(float4*)(ab + (long)row * 512 + f) = float4{av[0], av[1], av[2], av[3]};
            *(float4*)(bb + (long)row * 512 + f) = float4{bv[0], bv[1], bv[2], bv[3]}; } }
        __syncthreads();
      }
    }
  }
  const int TID = fresh_tid(wv);
  GEMM_IDS
  for (int it = (int)gridDim.x - 1 - vid; it < 8 * 9; it += gridDim.x) {
    const int rg = it & 7, pn = it >> 3; const int row0 = MP + rg * 16;
    f32x4 c0, c1;
    if (pn < 5) {
      const int bcol = pn * 256;
      sgemm16(lane, (const u16*)(ws + WS_PROJ) + (long)row0 * NPJ + PC_CQ, NPJ, (const u16*)(ws + WS_WQ) + (long)bcol * 256, 256, 256, wid * 32, wid * 32 + 16, c0, c1);
      u16* qm = (u16*)(ws + WS_QMLA);
      if (pn < 4) {
#pragma unroll
        for (int j = 0; j < 4; ++j) { const long row = row0 + fq * 4 + j; qm[row * 1280 + bcol + wid * 32 + fr] = f2bf(c0[j] * QM_SCALE); qm[row * 1280 + bcol + wid * 32 + 16 + fr] = f2bf(c1[j] * QM_SCALE); }
      } else {
        const float2* rope = (const float2*)(ws + WS_ROPE);
#pragma unroll
        for (int j = 0; j < 4; ++j) { const int row = row0 + fq * 4 + j; const float2 cs = rope[row_pos(row) * 16 + fr];
          qm[(long)row * 1280 + 1024 + wid * 32 + fr] = f2bf((c0[j] * cs.x - c1[j] * cs.y) * QM_SCALE);
          qm[(long)row * 1280 + 1024 + wid * 32 + 16 + fr] = f2bf((c1[j] * cs.x + c0[j] * cs.y) * QM_SCALE); }
      }
    } else {
      const int pl = pn - 5;
      const u16* xc = (const u16*)(ws + WS_XC);
      sgemm16(lane, xc + (long)row0 * 512 + (pl >> 1) * 256, 512, (const u16*)(ws + WS_WLRU) + (long)pl * 256 * 256, 256, 256, wid * 16, 128 + wid * 16, c0, c1);
      const int f = pl * 128 + wid * 16 + fr;
      const float nl = -(p->in[26][l * 512 + f]); const float sp = softplus_f(nl);
      const float bav = p->in[23][l * 512 + f], bxv = p->in[25][l * 512 + f];
      float* ab = (float*)(ws + WS_A); float* bb = (float*)(ws + WS_B);
#pragma unroll
      for (int j = 0; j < 4; ++j) { const long row = row0 + fq * 4 + j;
        const float r = sigm(c0[j] + bav), ii = sigm(c1[j] + bxv); const float la = -8.f * r * sp;
        ab[row * 512 + f] = __expf(la); bb[row * 512 + f] = sqrtf(neg_expm1(2.f * la)) * ii * bf2f(xc[row * 512 + f]); }
    }
  }
}

DI void mla_task(const int TID, const u16* __restrict__ qbase, int nq, const u16* __restrict__ kck, const u16* __restrict__ kkr, const u16* __restrict__ vT, int ldv, int nkeys, u16* __restrict__ obase) {
  const int tid = TID, lane = tid & 63, hd = tid >> 6, r = lane & 31, h = lane >> 5;
  const u16* qp = qbase + (long)(r & (nq - 1)) * 1280;
  bf16x8 qf[10];
#pragma unroll
  for (int ks = 0; ks < 8; ++ks) qf[ks] = *(const bf16x8*)(qp + hd * 128 + ks * 16 + h * 8);
#pragma unroll
  for (int ks = 0; ks < 2; ++ks) qf[8 + ks] = *(const bf16x8*)(qp + 1024 + hd * 32 + ks * 16 + h * 8);
  f32x16 O[4];
#pragma unroll
  for (int i = 0; i < 4; ++i)
#pragma unroll
    for (int j = 0; j < 16; ++j) O[i][j] = 0.f;
  float m_run = -1e30f, l_run = 0.f;
  const int nt = (nkeys + 63) >> 6;
  const int wv = __builtin_amdgcn_readfirstlane(hd);
  const char* gp[5]; unsigned ginc[5];
#pragma unroll
  for (int i = 0; i < 5; ++i) {
    int g = wv + 8 * i; if (g > 38) g = 38;
    if (g < 21) { const int o = g * 1024 + lane * 16; const int row = o / 336, wi = o - row * 336;
      if (wi >= 256 && wi < 320) { gp[i] = (const char*)kkr + row * 64 + (wi - 256); ginc[i] = 64 * 64; }
      else { gp[i] = (const char*)kck + row * 256 + (wi < 256 ? wi : 0); ginc[i] = 64 * 256; } }
    else { const int o = (g - 21) * 1024 + lane * 16; const int row = o / 144, wi = o - row * 144;
      gp[i] = (const char*)vT + (long)row * ldv * 2 + (wi < 128 ? wi : 0); ginc[i] = 128; }
  }
#define MLA_ISSUE(buf) do { _Pragma("unroll") for (int i = 0; i < 5; ++i) { int g = wv + 8 * i; if (g > 38) g = 38; \
    __builtin_amdgcn_global_load_lds((const unsigned*)gp[i], (unsigned*)(smem + (buf) * 39936 + g * 1024), 16, 0, 0); gp[i] += ginc[i]; } } while (0)
#define MLA_QK(S, KT, KB) do { \
    _Pragma("unroll") for (int ks = 0; ks < 10; ++ks) { const bf16x8 a = *(const bf16x8*)((KT) + ((KB) * 32 + r) * 336 + ks * 32 + h * 16); \
      if (ks == 0) S = __builtin_amdgcn_mfma_f32_32x32x16_bf16(a, qf[ks], negm, 0, 0, 0); else S = __builtin_amdgcn_mfma_f32_32x32x16_bf16(a, qf[ks], S, 0, 0, 0); } } while (0)
#define MLA_SMPV(S, OTHER, VT, KB, T) do { \
    if (((T) == nt - 1) && (nkeys & 63)) { _Pragma("unroll") for (int j = 0; j < 16; ++j) if ((T) * 64 + (KB) * 32 + crow(j, h) >= nkeys) S[j] = -1e30f; } \
    float mx = S[0]; _Pragma("unroll") for (int j = 1; j < 16; ++j) mx = fmaxf(mx, S[j]); \
    if (first || __builtin_amdgcn_ballot_w64(mx > 8.f) != 0ull) { \
      mx = fmaxf(mx, __shfl_xor(mx, 32)); \
      const float d = first ? mx : fmaxf(mx, 0.f); \
      if (!first) { const float alpha = __builtin_amdgcn_exp2f(-d); l_run *= alpha; \
        _Pragma("unroll") for (int cb = 0; cb < 4; ++cb) _Pragma("unroll") for (int j = 0; j < 16; ++j) O[cb][j] *= alpha; } \
      _Pragma("unroll") for (int j = 0; j < 16; ++j) { S[j] -= d; negm[j] -= d; OTHER[j] -= d; } \
      first = false; } \
    float ls = 0.f; _Pragma("unroll") for (int j = 0; j < 16; ++j) { S[j] = __builtin_amdgcn_exp2f(S[j]); ls += S[j]; } \
    l_run += ls; \
    bf16x8 pk[2]; \
    _Pragma("unroll") for (int s2 = 0; s2 < 2; ++s2) { const uint4 w = uint4{pk2(S[8 * s2], S[8 * s2 + 1]), pk2(S[8 * s2 + 2], S[8 * s2 + 3]), pk2(S[8 * s2 + 4], S[8 * s2 + 5]), pk2(S[8 * s2 + 6], S[8 * s2 + 7])}; pk[s2] = __builtin_bit_cast(bf16x8, w); } \
    _Pragma("unroll") for (int cb = 0; cb < 4; ++cb) _Pragma("unroll") for (int s2 = 0; s2 < 2; ++s2) { \
      const bf16x8 va = *(const bf16x8*)((VT) + (cb * 32 + r) * 144 + ((KB) * 32 + 16 * s2) * 2 + h * 16); \
      O[cb] = __builtin_amdgcn_mfma_f32_32x32x16_bf16(va, pk[s2], O[cb], 0, 0, 0); } } while (0)
  MLA_ISSUE(0);
  if (nt > 1) MLA_ISSUE(1);
  asm volatile("s_waitcnt vmcnt(0)" ::: "memory");
  __builtin_amdgcn_s_barrier();
  f32x16 sA, sB, negm;
#pragma unroll
  for (int j = 0; j < 16; ++j) { negm[j] = 0.f; sB[j] = 0.f; }
  bool first = true;
  MLA_QK(sA, smem, 0);
  int cur = 0;
#pragma unroll 1
  for (int t = 0; t < nt; ++t) {
    const int nx1 = (cur == 2) ? 0 : cur + 1, nx2 = (cur == 0) ? 2 : cur - 1;
    if (t + 2 < nt) MLA_ISSUE(nx2);
    const unsigned char* Kt = smem + cur * 39936; const unsigned char* Vt = Kt + 21504;
    MLA_QK(sB, Kt, 1);
    MLA_SMPV(sA, sB, Vt, 0, t);
    if (t + 1 < nt) MLA_QK(sA, smem + nx1 * 39936, 0);
    MLA_SMPV(sB, sA, Vt, 1, t);
    asm volatile("s_waitcnt vmcnt(0)" ::: "memory");
    asm volatile("s_waitcnt lgkmcnt(0)" ::: "memory");
    __builtin_amdgcn_s_barrier();
    cur = nx1;
  }
  const float lt = l_run + __shfl_xor(l_run, 32); const float inv = 1.f / lt;
  if (r < nq) {
    u16* op = obase + (long)r * 1024 + hd * 128;
#pragma unroll
    for (int cb = 0; cb < 4; ++cb)
#pragma unroll
      for (int g = 0; g < 4; ++g) { uint2 o; o.x = pk2(O[cb][4 * g] * inv, O[cb][4 * g + 1] * inv); o.y = pk2(O[cb][4 * g + 2] * inv, O[cb][4 * g + 3] * inv);
        *(uint2*)(op + cb * 32 + 8 * g + 4 * h) = o; }
  }
}

DI void diff_task(const int TID, const u16* __restrict__ qbase, const u16* __restrict__ zbase, u16* __restrict__ obase, int nq, int qpos0,
                  const u16* __restrict__ kbase, long kstride, const u16* __restrict__ vT, int ldv, int nkeys_total,
                  float lam, float oml, float slope2, const float* __restrict__ subg) {
  const int tid = TID, lane = tid & 63, w = tid >> 6, r = lane & 31, h = lane >> 5;
  const int qw0 = w * 32;
  const bool wactive = qw0 < nq;
  const int qr = (qw0 + r < nq) ? qw0 + r : 0;
  const int wl = (nq - 1) >> 5;
  const int ntmax = (min(nkeys_total, ((qpos0 + wl * 32) / 64 + 1) * 64) + 63) >> 6;
  const int kvis = min(nkeys_total, ((qpos0 + qw0) / 64 + 1) * 64);
  const int ntw = wactive ? ((kvis + 63) >> 6) : 0;
  const u16* qp = qbase + (long)qr * NPJ;
  bf16x8 qf[2][2];
#pragma unroll
  for (int c = 0; c < 2; ++c)
#pragma unroll
    for (int ks = 0; ks < 2; ++ks) qf[c][ks] = *(const bf16x8*)(qp + c * 32 + ks * 16 + h * 8);
  f32x16 O[2][2];
#pragma unroll
  for (int c = 0; c < 2; ++c)
#pragma unroll
    for (int vb = 0; vb < 2; ++vb)
#pragma unroll
      for (int j = 0; j < 16; ++j) O[c][vb][j] = 0.f;
  float m_run[2] = {-1e30f, -1e30f}, l_run[2] = {0.f, 0.f};
  const float qposf = (float)(qpos0 + qw0 + r);
  const float b0q = slope2 * ((float)(4 * h) - qposf);
  const int sr = tid >> 3, sc = tid & 7;
  const unsigned oDK = (unsigned)(sr * (int)kstride * 2 + sc * 16), oDV = (unsigned)(sr * ldv * 2 + sc * 16);
  uint4 g0, g1;
#define DF_GLOAD(t) do { g0 = *(const uint4*)((const char*)(kbase + (long)(t) * 64 * kstride) + oDK); g1 = *(const uint4*)((const char*)(vT + (long)(t) * 64) + oDV); } while (0)
#define DF_LSTORE(s) do { unsigned char* Kt = smem + (s) * 18432; *(uint4*)(Kt + sr * 144 + sc * 16) = g0; *(uint4*)(Kt + 9216 + sr * 144 + sc * 16) = g1; } while (0)
  DF_GLOAD(ntmax - 1); DF_LSTORE((ntmax - 1) & 1);
  __syncthreads();
  for (int t = ntmax - 1; t >= 0; --t) {
    if (t > 0) DF_GLOAD(t - 1);
    if (t < ntw - 1) {
      const unsigned char* Kt = smem + (t & 1) * 18432; const unsigned char* Vt = Kt + 9216;
#pragma unroll 1
      for (int kb = 1; kb >= 0; --kb) {
        bf16x8 vf[2][2];
#pragma unroll
        for (int vb = 0; vb < 2; ++vb)
#pragma unroll
          for (int s2 = 0; s2 < 2; ++s2) vf[vb][s2] = *(const bf16x8*)(Vt + (vb * 32 + r) * 144 + (kb * 32 + 16 * s2) * 2 + h * 16);
        const float dl = slope2 * (float)(t * 64 + kb * 32);
        f32x16 sc[2];
#pragma unroll
        for (int c = 0; c < 2; ++c) { const float u = b0q + dl - m_run[c];
#pragma unroll
          for (int j = 0; j < 16; ++j) sc[c][j] = fmaf(slope2, (float)((j & 3) + 8 * (j >> 2)), u); }
#pragma unroll
        for (int ks = 0; ks < 2; ++ks)
#pragma unroll
          for (int c = 0; c < 2; ++c) { const bf16x8 a = *(const bf16x8*)(Kt + (kb * 32 + r) * 144 + (c * 32 + ks * 16 + h * 8) * 2); sc[c] = __builtin_amdgcn_mfma_f32_32x32x16_bf16(a, qf[c][ks], sc[c], 0, 0, 0); }
#pragma unroll
        for (int c = 0; c < 2; ++c) {
          float mx = sc[c][0];
#pragma unroll
          for (int j = 1; j < 16; ++j) mx = fmaxf(mx, sc[c][j]);
          if (__builtin_amdgcn_ballot_w64(mx > 8.f) != 0ull) {
            mx = fmaxf(mx, __shfl_xor(mx, 32));
            const float d = fmaxf(mx, 0.f); const float alpha = __builtin_amdgcn_exp2f(-d); m_run[c] += d; l_run[c] *= alpha;
#pragma unroll
            for (int vb = 0; vb < 2; ++vb)
#pragma unroll
              for (int j = 0; j < 16; ++j) O[c][vb][j] *= alpha;
#pragma unroll
            for (int j = 0; j < 16; ++j) sc[c][j] -= d;
          }
          float ls = 0.f;
#pragma unroll
          for (int j = 0; j < 16; ++j) { sc[c][j] = __builtin_amdgcn_exp2f(sc[c][j]); ls += sc[c][j]; }
          l_run[c] += ls;
#pragma unroll
          for (int s2 = 0; s2 < 2; ++s2) { const uint4 wv = uint4{pk2(sc[c][8 * s2], sc[c][8 * s2 + 1]), pk2(sc[c][8 * s2 + 2], sc[c][8 * s2 + 3]), pk2(sc[c][8 * s2 + 4], sc[c][8 * s2 + 5]), pk2(sc[c][8 * s2 + 6], sc[c][8 * s2 + 7])};
            const bf16x8 pk = __builtin_bit_cast(bf16x8, wv);
#pragma unroll
            for (int vb = 0; vb < 2; ++vb) O[c][vb] = __builtin_amdgcn_mfma_f32_32x32x16_bf16(vf[vb][s2], pk, O[c][vb], 0, 0, 0); }
        }
      }
    } else if (t < ntw) {
      const unsigned char* Kt = smem + (t & 1) * 18432; const unsigned char* Vt = Kt + 9216;
      const bool partial = (t * 64 + 64 > kvis);
#pragma unroll 1
      for (int kb = 1; kb >= 0; --kb) {
        bf16x8 vf[2][2];
#pragma unroll
        for (int vb = 0; vb < 2; ++vb)
#pragma unroll
          for (int s2 = 0; s2 < 2; ++s2) vf[vb][s2] = *(const bf16x8*)(Vt + (vb * 32 + r) * 144 + (kb * 32 + 16 * s2) * 2 + h * 16);
        const float kb0 = (float)(t * 64 + kb * 32 + 4 * h) - qposf;
#pragma unroll
        for (int c = 0; c < 2; ++c) {
          f32x16 s;
#pragma unroll
          for (int j = 0; j < 16; ++j) s[j] = 0.f;
#pragma unroll
          for (int ks = 0; ks < 2; ++ks) { bf16x8 a = *(const bf16x8*)(Kt + (kb * 32 + r) * 144 + (c * 32 + ks * 16 + h * 8) * 2); s = __builtin_amdgcn_mfma_f32_32x32x16_bf16(a, qf[c][ks], s, 0, 0, 0); }
#pragma unroll
          for (int j = 0; j < 16; ++j) { const float dk = kb0 + (float)((j & 3) + 8 * (j >> 2)); s[j] = fmaf(-slope2, fabsf(dk), s[j]); }
          if (partial) {
#pragma unroll
            for (int j = 0; j < 16; ++j) if (t * 64 + kb * 32 + crow(j, h) >= kvis) s[j] = -1e30f; }
          float mx = s[0];
#pragma unroll
          for (int j = 1; j < 16; ++j) mx = fmaxf(mx, s[j]);
          if (__builtin_amdgcn_ballot_w64(mx > m_run[c] + 8.f) != 0ull) {
            mx = fmaxf(mx, __shfl_xor(mx, 32));
            const float m_new = fmaxf(m_run[c], mx); const float alpha = __builtin_amdgcn_exp2f(m_run[c] - m_new); m_run[c] = m_new;
            l_run[c] *= alpha;
#pragma unroll
            for (int vb = 0; vb < 2; ++vb)
#pragma unroll
              for (int j = 0; j < 16; ++j) O[c][vb][j] *= alpha;
          }
          float ls = 0.f;
#pragma unroll
          for (int j = 0; j < 16; ++j) { s[j] = __builtin_amdgcn_exp2f(s[j] - m_run[c]); ls += s[j]; }
          l_run[c] += ls;
#pragma unroll
          for (int s2 = 0; s2 < 2; ++s2) { u32 w0 = pk2(s[8 * s2], s[8 * s2 + 1]), w1 = pk2(s[8 * s2 + 2], s[8 * s2 + 3]), w2 = pk2(s[8 * s2 + 4], s[8 * s2 + 5]), w3 = pk2(s[8 * s2 + 6], s[8 * s2 + 7]);
            uint4 wv = uint4{w0, w1, w2, w3}; bf16x8 pk = __builtin_bit_cast(bf16x8, wv);
#pragma unroll
            for (int vb = 0; vb < 2; ++vb) O[c][vb] = __builtin_amdgcn_mfma_f32_32x32x16_bf16(vf[vb][s2], pk, O[c][vb], 0, 0, 0); }
          __builtin_amdgcn_sched_barrier(0);
        }
      }
    }
    if (t > 0) DF_LSTORE((t - 1) & 1);
    __syncthreads();
  }
  if (wactive) {
    const float i0 = 1.f / (l_run[0] + __shfl_xor(l_run[0], 32)); const float i1 = lam / (l_run[1] + __shfl_xor(l_run[1], 32));
    float ss = 0.f;
#pragma unroll
    for (int vb = 0; vb < 2; ++vb)
#pragma unroll
      for (int j = 0; j < 16; ++j) { float o = O[0][vb][j] * i0 - O[1][vb][j] * i1; O[0][vb][j] = o; ss += o * o; }
    ss += __shfl_xor(ss, 32);
    const float rsd = rsqrtf(ss * (1.f / 64) + EPS) * oml;
    if (qw0 + r < nq) {
      const u16* zp = zbase + (long)(qw0 + r) * NPJ; u16* op = obase + (long)(qw0 + r) * NPJ;
#pragma unroll
      for (int vb = 0; vb < 2; ++vb)
#pragma unroll
        for (int g = 0; g < 4; ++g) { const int v0 = vb * 32 + 8 * g + 4 * h;
          uint2 z = *(const uint2*)(zp + v0); float4 gg = *(const float4*)(subg + v0);
          float y0 = O[0][vb][4 * g] * rsd * gg.x * silu(lo2f(z.x)), y1 = O[0][vb][4 * g + 1] * rsd * gg.y * silu(hi2f(z.x));
          float y2 = O[0][vb][4 * g + 2] * rsd * gg.z * silu(lo2f(z.y)), y3 = O[0][vb][4 * g + 3] * rsd * gg.w * silu(hi2f(z.y));
          uint2 o; o.x = pk2(y0, y1); o.y = pk2(y2, y3); *(uint2*)(op + v0) = o; }
    }
  }
}

DI void attn_phase(const int TID, KP p, int l, unsigned* ctr) {
  unsigned char* ws = p->ws;
  u16* proj = (u16*)(ws + WS_PROJ);
  const u16* qm = (const u16*)(ws + WS_QMLA);
  u16* olat = (u16*)(ws + WS_XN);
  const float* sc = (const float*)(ws + WS_CTL + 1024);
  const float* subg = p->in[19] + l * 64;
  volatile int* s_task = (volatile int*)(smem + TASK_OFF);
  for (;;) {
    int tid = TID; asm volatile("" : "+v"(tid));
    if (tid == 0) *s_task = (int)atomicAdd(ctr, 1u);
    __syncthreads();
    const int ti = *s_task;
    __syncthreads();
    if (ti >= g_tab.n) break;
    const u32 e = g_tab.t[ti]; const int ty = e >> 16, idx = e & 0xffff;
    if (ty == 0 || ty == 2) {
      const bool pr = (ty == 0);
      const int j = idx >> 5, b = pr ? ((idx >> 3) & 3) : (idx >> 3), hh = idx & 7;
      const long row0 = pr ? (long)b * TP + j * 256 : (long)MP + b * 16;
      const u16* kb = pr ? proj + (long)b * TP * NPJ + PC_KD + hh * 64 : (const u16*)(ws + WS_KDS) + (long)b * SKP * 512 + hh * 64;
      const u16* vt = pr ? (const u16*)(ws + WS_VDTP) + ((long)b * 512 + hh * 64) * TP : (const u16*)(ws + WS_VDTS) + ((long)b * 512 + hh * 64) * SKP;
      const float lam = sc[l * 2], oml = 1.f - sc[l * 2 + 1];
      for (int rep = 0; rep < REP_DIFF; ++rep) {
        diff_task(tid, proj + row0 * NPJ + PC_QD + hh * 64, proj + row0 * NPJ + PC_ZD + hh * 64, proj + row0 * NPJ + PC_VD + hh * 64, pr ? 256 : 16, pr ? j * 256 : PAST,
                kb, pr ? (long)NPJ : 512L, vt, pr ? TP : SKP, pr ? TP : SK, lam, oml, LOG2E * exp2f(-(float)(hh + 1)), subg);
        __syncthreads(); }
    } else if (ty == 1 || ty == 3) {
      const bool pr = (ty == 1);
      const int q32 = idx >> 2, b = pr ? (idx & 3) : idx;
      const long row0 = pr ? (long)b * TP + q32 * 32 : (long)MP + b * 16;
      const u16* kc = pr ? (const u16*)(ws + WS_CKVP) + (long)b * TP * 128 : (const u16*)(ws + WS_CKVS) + (long)b * SKP * 128;
      const u16* kr = pr ? (const u16*)(ws + WS_KRP) + (long)b * TP * 32 : (const u16*)(ws + WS_KRS) + (long)b * SKP * 32;
      const u16* vt = pr ? (const u16*)(ws + WS_CKVTP) + (long)b * 128 * TP : (const u16*)(ws + WS_CKVTS) + (long)b * 128 * SKP;
      for (int rep = 0; rep < REP_MLA; ++rep) {
        mla_task(tid, qm + row0 * 1280, pr ? 32 : 16, kc, kr, vt, pr ? TP : SKP, pr ? (q32 / 2 + 1) * 64 : SK, olat + row0 * 1024);
        __syncthreads(); }
    } else {
      const int b = idx >> 6, c = idx & 63; const long row0 = (long)b * TP + c * 64;
      const float* ab = (const float*)(ws + WS_A) + row0 * 512 + tid; const float* bb = (const float*)(ws + WS_B) + row0 * 512 + tid;
      float A = 1.f, B = 0.f;
#pragma unroll 16
      for (int i = 0; i < 64; ++i) { float a = ab[i * 512], x = bb[i * 512]; B = a * B + x; A *= a; }
      ((float2*)(ws + WS_SCAN))[(long)idx * 512 + tid] = float2{A, B};
    }
    __syncthreads();
  }
}

DI void uvscan_phase(const int TID_in, KP p, int l, int vid) {
  const int wv = __builtin_amdgcn_readfirstlane(TID_in >> 6);
  unsigned char* ws = p->ws;
  u16* proj = (u16*)(ws + WS_PROJ);
  f32x4 acc[2][2][4][2];
  for (int it = vid; it < 64 * 2 + 258 + 16; it += gridDim.x) {
    if (it < 64 * 2) {
      int pm, pn; tile_coords(it, 64, 2, pm, pn);
      const int brow = pm * 256, bcol = pn * 256;
      gemm_kloop8(fresh_tid(wv), (const u16*)(ws + WS_XN) + (long)brow * 1024 + pn * 512, 1024, (const u16*)(ws + WS_WUV) + (long)bcol * 512, 512, 8, acc);
      const int TID = fresh_tid(wv);
      GEMM_IDS
      const int oz = opaque_zero(); const int browz = brow + oz;
      u16* pz = proj + oz;
#pragma unroll
      for (int ai = 0; ai < 2; ++ai) {
        ACC_TO_LDS(ai);
        __syncthreads();
        EPI_ROWS_BEGIN(ai)
          u16* q = pz + (long)row * NPJ + PC_ZMLA + col; const uint2 z = *(const uint2*)q;
          *(uint2*)(q + (PC_QD - PC_ZMLA)) = pk4(v.x * silu(lo2f(z.x)), v.y * silu(hi2f(z.x)), v.z * silu(lo2f(z.y)), v.w * silu(hi2f(z.y)));
        EPI_ROWS_END
        __syncthreads();
      }
    } else {
      const int TID = fresh_tid(wv);
      GEMM_IDS
      const int s = it - 64 * 2;
      if (s >= 258) {
        const int q = s - 258; const int rg = q & 7, pn = q >> 3; const int row0 = MP + rg * 16, bcol = pn * 256;
        f32x4 c0, c1;
        sgemm16(lane, (const u16*)(ws + WS_XN) + (long)row0 * 1024 + pn * 512, 1024, (const u16*)(ws + WS_WUV) + (long)bcol * 512, 512, 512, wid * 32, wid * 32 + 16, c0, c1);
#pragma unroll
        for (int j = 0; j < 4; ++j) { const long row = row0 + fq * 4 + j; u16* q0 = proj + row * NPJ + PC_ZMLA + bcol + wid * 32 + fr;
          q0[PC_QD - PC_ZMLA] = f2bf(c0[j] * silu(bf2f(q0[0]))); q0[PC_QD - PC_ZMLA + 16] = f2bf(c1[j] * silu(bf2f(q0[16]))); }
        continue;
      }
      float hh; long row0; int nsteps; float* hout;
      if (s < 256) { const int b = s >> 6, c = s & 63; row0 = (long)b * TP + c * 64; nsteps = 64; hh = 0.f;
        const float2* sm = (const float2*)(ws + WS_SCAN) + (long)(b * 64) * 512 + tid;
        { int cc = 0;
          for (; cc + 16 <= c; cc += 16) { float2 t[16];
#pragma unroll
            for (int q = 0; q < 16; ++q) t[q] = sm[(long)(cc + q) * 512];
#pragma unroll
            for (int q = 0; q < 16; ++q) hh = t[q].x * hh + t[q].y; }
          for (; cc < c; ++cc) { float2 ab2 = sm[(long)cc * 512]; hh = ab2.x * hh + ab2.y; } }
        hout = (c == 63) ? p->out + O_PH + ((long)l * 4 + b) * 512 + tid : nullptr;
      } else { const int sb = (s - 256) * 4 + 0; (void)sb; row0 = 0; nsteps = 0; hh = 0.f; hout = nullptr; }
      if (s < 256) {
        const float* ab = (const float*)(ws + WS_A) + row0 * 512 + tid; const float* bb = (const float*)(ws + WS_B) + row0 * 512 + tid;
        u16* zp = proj + row0 * NPJ + PC_ZL + tid;
#pragma unroll 16
        for (int i = 0; i < nsteps; ++i) { float a = ab[(long)i * 512], x = bb[(long)i * 512]; float z = bf2f(zp[(long)i * NPJ]); hh = a * hh + x; zp[(long)i * NPJ + (PC_KD - PC_ZL)] = f2bf(hh * silu(z)); }
        if (hout) *hout = hh;
      } else {
        for (int q = 0; q < 4; ++q) { const int sb = (s - 256) * 4 + q; const long r0 = MP + sb * 16;
          float h2 = p->in[6][((long)l * 8 + sb) * 512 + tid];
          const float* ab = (const float*)(ws + WS_A) + r0 * 512 + tid; const float* bb = (const float*)(ws + WS_B) + r0 * 512 + tid;
          u16* zp = proj + r0 * NPJ + PC_ZL + tid;
#pragma unroll 16
          for (int i = 0; i < 16; ++i) { float a = ab[(long)i * 512], x = bb[(long)i * 512]; float z = bf2f(zp[(long)i * NPJ]); h2 = a * h2 + x; zp[(long)i * NPJ + (PC_KD - PC_ZL)] = f2bf(h2 * silu(z)); }
          p->out[O_SH + ((long)l * 8 + sb) * 512 + tid] = h2; }
      }
    }
  }
}

DI void oproj_phase(const int TID, KP p, int l, int vid) {
  GEMM_IDS
  unsigned char* ws = p->ws;
  f32x4 acc[1][2][4][2];
  for (int tile = vid; tile < 128 * 4; tile += gridDim.x) {
    int pm, pn; tile_coords(tile, 128, 4, pm, pn);
    const int brow = pm * 128, bcol = pn * 256;
    float4 mreg[16];
#pragma unroll
    for (int i = 0; i < 16; ++i) mreg[i] = float4{0.f, 0.f, 0.f, 0.f};
#pragma unroll 1
    for (int b = 0; b < 3; ++b) {
      const int acol = (b == 0) ? PC_QD : (b == 1) ? PC_VD : PC_KD;
      gemm_kloop_r3(TID, (const u16*)(ws + WS_PROJ) + (long)brow * NPJ + acol, NPJ, (const u16*)(ws + WS_WO) + ((long)b * 1024 + bcol) * 512, 512, 8, acc);
      const int oz = opaque_zero(); const int browz = brow + oz;
      const u16* gp = (const u16*)(ws + WS_PROJ) + oz + PC_G + b * 1024 + bcol;
      ACC_TO_LDS(0);
      __syncthreads();
#pragma unroll
      for (int it = 0; it < 16; ++it) { const int idx = it * 512 + tid; const int rl = idx >> 6, cl = (idx & 63) * 4;
        const float4 v = *(const float4*)((const float*)smem + rl * EP_LD + cl);
        const uint2 g = *(const uint2*)(gp + (long)(browz + rl) * NPJ + cl);
        mreg[it].x += lo2f(g.x) * v.x; mreg[it].y += hi2f(g.x) * v.y; mreg[it].z += lo2f(g.y) * v.z; mreg[it].w += hi2f(g.y) * v.w; }
      __syncthreads();
    }
    { const int oz = opaque_zero(); u16* mg = (u16*)(ws + WS_XN) + oz;
#pragma unroll
      for (int it = 0; it < 16; ++it) { const int idx = it * 512 + tid; const int rl = idx >> 6, cl = (idx & 63) * 4;
        *(uint2*)(mg + (long)(brow + rl) * 1024 + bcol + cl) = pk4(mreg[it].x, mreg[it].y, mreg[it].z, mreg[it].w); } }
  }
  for (int it = (int)gridDim.x - 1 - vid; it < 8 * 4; it += gridDim.x) {
    const int rg = it & 7, pn = it >> 3; const int row0 = MP + rg * 16, bcol = pn * 256;
    const u16* proj = (const u16*)(ws + WS_PROJ); u16* mg = (u16*)(ws + WS_XN);
    float m0[4] = {0.f, 0.f, 0.f, 0.f}, m1[4] = {0.f, 0.f, 0.f, 0.f};
#pragma unroll 1
    for (int b = 0; b < 3; ++b) {
      const int acol = (b == 0) ? PC_QD : (b == 1) ? PC_VD : PC_KD;
      f32x4 c0, c1;
      sgemm16(lane, proj + (long)row0 * NPJ + acol, NPJ, (const u16*)(ws + WS_WO) + ((long)b * 1024 + bcol) * 512, 512, 512, wid * 32, wid * 32 + 16, c0, c1);
#pragma unroll
      for (int j = 0; j < 4; ++j) { const long row = row0 + fq * 4 + j; const u16* g = proj + row * NPJ + PC_G + b * 1024 + bcol + wid * 32 + fr;
        m0[j] += bf2f(g[0]) * c0[j]; m1[j] += bf2f(g[16]) * c1[j]; }
    }
#pragma unroll
    for (int j = 0; j < 4; ++j) { const long row = row0 + fq * 4 + j; u16* q = mg + row * 1024 + bcol + wid * 32 + fr; q[0] = f2bf(m0[j]); q[16] = f2bf(m1[j]); }
  }
}

DI void wout_phase(const int TID_in, KP p, int l, int vid, float* outp) {
  const int wv = __builtin_amdgcn_readfirstlane(TID_in >> 6);
  unsigned char* ws = p->ws;
  f32x4 acc[2][2][4][2];
  for (int tile = vid; tile < 64 * 4; tile += gridDim.x) {
    int pm, pn; tile_coords(tile, 64, 4, pm, pn);
    const int brow = pm * 256, bcol = pn * 256;
    gemm_kloop8(fresh_tid(wv), (const u16*)(ws + WS_XN) + (long)brow * 1024, 1024, (const u16*)(ws + WS_WOUT) + (long)bcol * 1024, 1024, 16, acc);
    const int TID = fresh_tid(wv);
    GEMM_IDS
    const int oz = opaque_zero(); const int browz = brow + oz;
    float* out = outp + oz;
#pragma unroll
    for (int ai = 0; ai < 2; ++ai) {
      ACC_TO_LDS(ai);
      __syncthreads();
      EPI_ROWS_BEGIN(ai)
        if (row < M) { const float4 xo = (l == 0) ? (row < MP ? *(const float4*)(p->in[0] + (long)row * D + col) : *(const float4*)(p->in[1] + (long)(row - MP) * D + col)) : *(const float4*)(out + (long)row * D + col);
          *(float4*)(out + (long)row * D + col) = float4{xo.x + v.x, xo.y + v.y, xo.z + v.z, xo.w + v.w}; }
      EPI_ROWS_END
      __syncthreads();
    }
  }
  const int TID = fresh_tid(wv);
  GEMM_IDS
  for (int it = (int)gridDim.x - 1 - vid; it < 8 * 4; it += gridDim.x) {
    const int rg = it & 7, pn = it >> 3; const int row0 = MP + rg * 16, bcol = pn * 256;
    f32x4 c0, c1;
    sgemm16(lane, (const u16*)(ws + WS_XN) + (long)row0 * 1024, 1024, (const u16*)(ws + WS_WOUT) + (long)bcol * 1024, 1024, 1024, wid * 32, wid * 32 + 16, c0, c1);
#pragma unroll
    for (int j = 0; j < 4; ++j) { const int row = row0 + fq * 4 + j; const int col = bcol + wid * 32 + fr;
      const float* xo = (l == 0) ? p->in[1] + (long)(row - MP) * D + col : outp + (long)row * D + col;
      const float x0 = xo[0], x1 = xo[16];
      outp[(long)row * D + col] = x0 + c0[j]; outp[(long)row * D + col + 16] = x1 + c1[j]; }
  }
}

DI void final_phase(const int TID, KP p) {
  const int lane = TID & 63, wid = TID >> 6;
  const float* g = p->in[31];
  for (int row = blockIdx.x * 8 + wid; row < M; row += gridDim.x * 8) {
    float* src = p->out + (long)row * D;
    float4 v[4]; float ss = 0.f;
#pragma unroll
    for (int i = 0; i < 4; ++i) { v[i] = *(const float4*)(src + i * 256 + lane * 4); ss += v[i].x * v[i].x + v[i].y * v[i].y + v[i].z * v[i].z + v[i].w * v[i].w; }
    ss = wsum(ss); const float rs = rsqrtf(ss * (1.f / D) + EPS);
#pragma unroll
    for (int i = 0; i < 4; ++i) { float4 gg = *(const float4*)(g + i * 256 + lane * 4);
      *(float4*)(src + i * 256 + lane * 4) = float4{v[i].x * rs * gg.x, v[i].y * rs * gg.y, v[i].z * rs * gg.z, v[i].w * rs * gg.w}; }
  }
}


#define XB_TMO      128
#define XB_XCNT(j)  (256  + 64 * (j))
#define XB_XSUB(j)  (1280 + 64 * (j))
#define XB_XGEN(j)  (2304 + 64 * (j))
#define XB_TOP      3328
#define XB_TOPGEN   3392
#define XCD_BAR_WORDS 3456
#define XB_SPIN_CAP (1u << 22)
#define LAS __attribute__((address_space(3)))
DI unsigned xb_ld(unsigned* p) { return __hip_atomic_load(p, __ATOMIC_RELAXED, __HIP_MEMORY_SCOPE_AGENT); }
DI unsigned xb_add(unsigned* p, unsigned v) { return __hip_atomic_fetch_add(p, v, __ATOMIC_RELAXED, __HIP_MEMORY_SCOPE_AGENT); }
DI unsigned xb_xcc_id() { return (unsigned)__builtin_amdgcn_s_getreg((3 << 11) | 20) & 0xFu; }
#define XB_SPIN(cond, bar) do { unsigned _sp = 0; while (cond) { __builtin_amdgcn_s_sleep(1); \
    if ((++_sp & 255u) == 0u) { if (xb_ld(&(bar)[XB_TMO])) break; if (_sp > XB_SPIN_CAP) { atomicAdd(&(bar)[XB_TMO], 1u); break; } } } } while (0)
DI void xcd_barrier_complete(unsigned* bar, unsigned x, unsigned& nloc, unsigned& nx) {
  const unsigned G = gridDim.x;
  unsigned sum, cnt, mine, sp = 0u;
  for (;;) {
    sum = 0u; cnt = 0u; mine = 0u;
#pragma unroll
    for (unsigned j = 0; j < 16; ++j) { const unsigned c = xb_ld(&bar[XB_XCNT(j)]); sum += c; cnt += (c > 0u) ? 1u : 0u; mine = (j == x) ? c : mine; }
    if (sum == G) break;
    __builtin_amdgcn_s_sleep(1);
    if ((++sp & 255u) == 0u) { if (xb_ld(&bar[XB_TMO])) break; if (sp > XB_SPIN_CAP) { atomicAdd(&bar[XB_TMO], 1u); break; } }
  }
  nloc = mine > 0u ? mine : 1u; nx = cnt > 0u ? cnt : 1u;
}
DI void xcd_barrier(const int TID, unsigned* bar, unsigned x) {
  volatile LAS unsigned* st = (volatile LAS unsigned*)(smem + TASK_OFF + 16);
  asm volatile("s_waitcnt vmcnt(0)" ::: "memory");
  __syncthreads();
  if (TID == 0) {
    __builtin_amdgcn_s_waitcnt(0);
    unsigned nloc = st[0], nx = st[1];
    if (nloc == 0u) { xcd_barrier_complete(bar, x, nloc, nx); st[0] = nloc; st[1] = nx; }
    const unsigned old = xb_add(&bar[XB_XSUB(x)], 1u);
    const unsigned gen = old / nloc;
    if (old + 1u == (gen + 1u) * nloc) {
      __builtin_amdgcn_fence(__ATOMIC_RELEASE, "agent");
      asm volatile("s_waitcnt vmcnt(0)" ::: "memory");
      const unsigned og = xb_add(&bar[XB_TOP], 1u);
      const unsigned tg = og / nx;
      if (og + 1u == (tg + 1u) * nx) xb_add(&bar[XB_TOPGEN], 1u);
      else XB_SPIN(xb_ld(&bar[XB_TOPGEN]) == tg, bar);
      __builtin_amdgcn_fence(__ATOMIC_ACQUIRE, "agent");
      xb_add(&bar[XB_XGEN(x)], 1u);
      asm volatile("s_waitcnt vmcnt(0)" ::: "memory");
    } else {
      XB_SPIN(xb_ld(&bar[XB_XGEN(x)]) == gen, bar);
      __builtin_amdgcn_fence(__ATOMIC_ACQUIRE, "agent");
      asm volatile("s_waitcnt vmcnt(0)" ::: "memory");
    }
  }
  __syncthreads();
}

__global__ void __launch_bounds__(512, 2) mega(Params p_) {
  const int wave_s = __builtin_amdgcn_readfirstlane((int)(__builtin_amdgcn_workitem_id_x() >> 6));
  const int G = gridDim.x, bx = blockIdx.x;
  const int vid = (G % 8 == 0) ? (bx % 8) * (G / 8) + bx / 8 : bx;
  const int ph_lo = p_.ph_lo, ph_hi = p_.ph_hi;
  const unsigned xcc = xb_xcc_id();
  { const int t0 = __builtin_amdgcn_workitem_id_x(); if (t0 < 4) ((volatile LAS unsigned*)(smem + TASK_OFF))[4 + t0] = 0u; __syncthreads();
    if (t0 == 0) (void)xb_add((unsigned*)(p_.ws + WS_BAR) + XB_XCNT(xcc), 1u); }
  if (ph_hi - ph_lo > 1) cg::this_grid().sync();
  for (int ph = ph_lo; ph < ph_hi; ++ph) {
    int TID; asm volatile("v_mbcnt_lo_u32_b32 %0, -1, 0\n\tv_mbcnt_hi_u32_b32 %0, -1, %0" : "=v"(TID)); TID += wave_s * 64;
    KP p = (KP)__builtin_amdgcn_kernarg_segment_ptr(); asm volatile("" : "+s"(p));
    unsigned* ctrs = (unsigned*)(p->ws + WS_CTL);
    if (ph == NPH - 1) final_phase(TID, p);
    else {
      const int l = ph >> 3, s = ph & 7;
      switch (s) {
        case 0: for (int rep = 0; rep < REP_PREP; ++rep) { prep_phase(TID, p, l); __syncthreads(); } break;
        case 1: for (int rep = 0; rep < REP_INPROJ; ++rep) { inproj_phase(TID, p, l, vid); __syncthreads(); } break;
        case 2: mid_phase(TID, p, l); break;
        case 3: for (int rep = 0; rep < REP_QLRU; ++rep) { qlru_phase(TID, p, l, vid); __syncthreads(); } break;
        case 4: for (int rep = 0; rep < REP_ATTN; ++rep) { attn_phase(TID, p, l, ctrs + ph + 64 * rep); __syncthreads(); } break;
        case 5: for (int rep = 0; rep < REP_UVSCAN; ++rep) { uvscan_phase(TID, p, l, vid); __syncthreads(); } break;
        case 6: for (int rep = 0; rep < REP_OPROJ; ++rep) { oproj_phase(TID, p, l, vid); __syncthreads(); } break;
        default: wout_phase(TID, p, l, vid, p->out); break;
      }
    }
    if (TAIL_PHASE >= 0 && ph == NPH - 1) {
      for (int rep = 0; rep < TAIL_REPS; ++rep) {
        xcd_barrier(TID, (unsigned*)(p->ws + WS_BAR), xcc);
        if (TAIL_PHASE == 2) mid_phase(TID, p, 3);
        else if (TAIL_PHASE == 7) wout_phase(TID, p, 3, vid, (float*)(p->ws + WS_PROJ));
        else if (TAIL_PHASE == 1) inproj_phase(TID, p, 3, vid);
        else if (TAIL_PHASE == 6) oproj_phase(TID, p, 3, vid);
        else if (TAIL_PHASE == 8) final_phase(TID, p);
        __syncthreads();
      }
    }
    if (ph + 1 < ph_hi) {
      xcd_barrier(TID, (unsigned*)(p->ws + WS_BAR), xcc);
      for (int e = 0; e < EXTRA_SYNC; ++e) xcd_barrier(TID, (unsigned*)(p->ws + WS_BAR), xcc);
    }
  }
}

extern "C" void kernel_launch(void* const* d_in, const int* in_sizes, int n_in, void* d_out, int out_size, void* d_ws, size_t ws_size, hipStream_t stream) {
  static int grid = 0;
  if (grid == 0) {
    if (n_in != 32 || (long)out_size != O_END || ws_size < WS_END) { fprintf(stderr, "kernel_launch: unexpected shapes (n_in %d out %d ws %zu need %zu)\n", n_in, out_size, ws_size, (size_t)WS_END); grid = -1; return; }
    int dev = 0, cus = 0, per_cu = 0;
    (void)hipGetDevice(&dev); (void)hipDeviceGetAttribute(&cus, hipDeviceAttributeMultiprocessorCount, dev);
    if (hipFuncSetAttribute((const void*)mega, hipFuncAttributeMaxDynamicSharedMemorySize, LDS_BYTES) != hipSuccess) { fprintf(stderr, "hipFuncSetAttribute failed\n"); grid = -1; return; }
    if (hipOccupancyMaxActiveBlocksPerMultiprocessor(&per_cu, (const void*)mega, 512, LDS_BYTES) != hipSuccess || per_cu < 1) { fprintf(stderr, "occupancy query failed (%d)\n", per_cu); per_cu = 1; }
    (void)hipGetLastError();
    grid = cus;
  }
  if (grid < 0) return;
  (void)hipMemsetAsync((char*)d_ws + WS_CTL, 0, WS_ROPE, stream);
  Params p{};
  for (int i = 0; i < 32; ++i) p.in[i] = (const float*)d_in[i];
  p.out = (float*)d_out; p.ws = (unsigned char*)d_ws;
#if ONE_LAUNCH
  p.ph_lo = 0; p.ph_hi = NPH;
  void* args[] = {&p};
  hipError_t e = hipLaunchCooperativeKernel((const void*)mega, dim3(grid), dim3(512), args, LDS_BYTES, stream);
  if (e != hipSuccess) fprintf(stderr, "cooperative launch failed: %s\n", hipGetErrorString(e));
#else
  for (int ph = 0; ph < NPH; ++ph) { p.ph_lo = ph; p.ph_hi = ph + 1; hipLaunchKernelGGL(mega, dim3(grid), dim3(512), LDS_BYTES, stream, p); }
#endif
}
```

```cpp
#include <hip/hip_runtime.h>
#include <hip/hip_cooperative_groups.h>
#include <cstdio>
namespace cg = cooperative_groups;

#ifndef ONE_LAUNCH
#define ONE_LAUNCH 1
#endif
#define REP_PREP 1
#define REP_INPROJ 1
#define REP_QLRU 1
#define REP_ATTN 1
#define REP_OPROJ 1
#define REP_UVSCAN 1
#define TAIL_PHASE -1
#define TAIL_REPS 4
#define REP_MLA 1
#define REP_DIFF 1
#define EXTRA_SYNC 0

typedef unsigned short u16;
typedef unsigned int u32;
using bf16x8 = __attribute__((ext_vector_type(8))) short;
using s16x4  = __attribute__((ext_vector_type(4))) short;
using f32x4  = __attribute__((ext_vector_type(4))) float;
using f32x16 = __attribute__((ext_vector_type(16))) float;
typedef float f32x2 __attribute__((ext_vector_type(2)));
typedef __bf16 bf16x2 __attribute__((ext_vector_type(2)));
#define DI __device__ __forceinline__

constexpr int D = 1024, TP = 4096, MP = 16384, TS = 16, MS = 128, M = MP + MS, MT = 65, MPAD = MT * 256;
constexpr int PAST = 2048, SK = PAST + TS, SKP = 2112;
constexpr int NIN = 7072, NPJ = 7168, DEPTH = 4;
constexpr float EPS = 1e-6f;
constexpr float LOG2E = 1.4426950408889634f;
constexpr float QM_SCALE = 0.10206207261596575f * LOG2E;
constexpr float QD_SCALE = 0.17677669529663687f * LOG2E;
constexpr int PC_CQ = 0, PC_CKV = 256, PC_KR = 384, PC_ZMLA = 512, PC_QD = 1024, PC_KD = 1536, PC_VD = 2048, PC_ZD = 2560,
              PC_XL = 3072, PC_ZL = 3584, PC_G = 4096;
constexpr long O_YP = 0, O_YS = O_YP + (long)MP * D, O_PCKV = O_YS + (long)MS * D, O_PKR = O_PCKV + 4L * MP * 128,
               O_PDK = O_PKR + 4L * MP * 32, O_PDV = O_PDK + 4L * MP * 512, O_PH = O_PDV + 4L * MP * 512, O_PCV = O_PH + 4L * 4 * 512,
               O_SCKV = O_PCV + 4L * 4 * 3 * 512, O_SKR = O_SCKV + 4L * MS * 128, O_SDK = O_SKR + 4L * MS * 32, O_SDV = O_SDK + 4L * MS * 512,
               O_SH = O_SDV + 4L * MS * 512, O_SCV = O_SH + 4L * 8 * 512, O_END = O_SCV + 4L * 8 * 3 * 512;
constexpr size_t al(size_t x) { return (x + 255) & ~(size_t)255; }
constexpr size_t WS_CTL = 0, WS_BAR = 4096, WS_ROPE = 20480, WS_WIN = WS_ROPE + al(4096 * 16 * 8), WS_WQ = WS_WIN + al((size_t)NPJ * 1024 * 2),
                 WS_WUV = WS_WQ + al(1280 * 256 * 2), WS_WO = WS_WUV + al(512 * 512 * 2), WS_WOUT = WS_WO + al(3 * 1024 * 512 * 2),
                 WS_WLRU = WS_WOUT + al(1024 * 1024 * 2), WS_XN = WS_WLRU + al(1024 * 256 * 2), WS_PROJ = WS_XN + al((size_t)MPAD * 1024 * 2),
                 WS_QMLA = WS_PROJ + al((size_t)MPAD * NPJ * 2), WS_XC = WS_QMLA + al((size_t)MPAD * 1280 * 2), WS_A = WS_XC + al((size_t)MPAD * 512 * 2),
                 WS_B = WS_A + al((size_t)M * 512 * 4), WS_SCAN = WS_B + al((size_t)M * 512 * 4), WS_CKVP = WS_SCAN + al(4 * 64 * 512 * 8),
                 WS_CKVTP = WS_CKVP + al((size_t)MP * 128 * 2), WS_KRP = WS_CKVTP + al((size_t)MP * 128 * 2), WS_VDTP = WS_KRP + al((size_t)MP * 32 * 2),
                 WS_CKVS = WS_VDTP + al((size_t)MP * 512 * 2), WS_CKVTS = WS_CKVS + al(8 * SKP * 128 * 2), WS_KRS = WS_CKVTS + al(8 * SKP * 128 * 2),
                 WS_KDS = WS_KRS + al(8 * SKP * 32 * 2), WS_VDTS = WS_KDS + al((size_t)8 * SKP * 512 * 2), WS_END = WS_VDTS + al((size_t)8 * SKP * 512 * 2);
constexpr int EP_LD = 260;
constexpr int LDS_BYTES = 147456 + 256;
constexpr int TASK_OFF = 147456;
constexpr int NPH = 33;

struct Params { const float* in[32]; float* out; unsigned char* ws; int ph_lo, ph_hi; };
typedef const Params __attribute__((address_space(4)))* KP;

extern __shared__ __attribute__((aligned(16))) unsigned char smem[];

DI float bf2f(u16 v) { return __uint_as_float((u32)v << 16); }
DI u32 pk2(float a, float b) { f32x2 v = {a, b}; bf16x2 r = __builtin_convertvector(v, bf16x2); return __builtin_bit_cast(u32, r); }
DI u16 f2bf(float a) { return (u16)(pk2(a, 0.f) & 0xffffu); }
DI float lo2f(u32 v) { return __uint_as_float(v << 16); }
DI float hi2f(u32 v) { return __uint_as_float(v & 0xffff0000u); }
DI float sigm(float x) { return 1.f / (1.f + __expf(-x)); }
DI float silu(float x) { return x / (1.f + __expf(-x)); }
DI float softplus_f(float x) { return fmaxf(x, 0.f) + __logf(1.f + __expf(-fabsf(x))); }
DI float neg_expm1(float x) { const float t = x * (1.f + x * (0.5f + x * (0.16666667f + x * 0.041666668f))); return (x > -0.1f) ? -t : 1.f - __expf(x); }
DI float wsum(float v) { for (int o = 32; o; o >>= 1) v += __shfl_xor(v, o); return v; }
DI int kperm(int k) { int q = (k >> 2) & 3; q = (q == 1) ? 2 : (q == 2) ? 1 : q; return (k & ~15) | (q << 2) | (k & 3); }
DI int crow(int reg, int h) { return (reg & 3) + 8 * (reg >> 2) + 4 * h; }
DI int row_pos(int row) { return row < MP ? (row & (TP - 1)) : PAST + ((row - MP) & 15); }

struct TaskTab { int n; u32 t[1408]; };
constexpr TaskTab make_tab() {
  TaskTab x{}; int n = 0;
  for (int i = 0; i < 64; ++i) x.t[n++] = (2u << 16) | i;
  for (int i = 0; i < 8; ++i) x.t[n++] = (3u << 16) | i;
  for (int L = 144; L >= 1; --L) {
    for (int j = 0; j < 16; ++j) if (9 * (j + 1) == L) for (int i = 0; i < 32; ++i) x.t[n++] = (0u << 16) | (j * 32 + i);
    for (int q = 0; q < 128; ++q) if (q / 2 + 1 == L) for (int b = 0; b < 4; ++b) x.t[n++] = (1u << 16) | (q * 4 + b);
  }
  for (int i = 0; i < 256; ++i) x.t[n++] = (4u << 16) | i;
  x.n = n; return x;
}
__device__ const TaskTab g_tab = make_tab();
__device__ const float g_invf[16] = {1.0f, 0.5623413251903491f, 0.31622776601683794f, 0.1778279410038923f, 0.1f, 0.05623413251903491f,
  0.031622776601683794f, 0.01778279410038923f, 0.01f, 0.005623413251903491f, 0.0031622776601683794f, 0.001778279410038923f, 0.001f,
  0.0005623413251903491f, 0.00031622776601683794f, 0.0001778279410038923f};

DI int lds_byte(int r, int c) { int st = (r >> 4) * 2 + (c >> 5), rr = r & 15, cc = c & 31, ob = rr * 64 + cc * 2; return st * 1024 + (ob ^ (((ob >> 9) & 1) << 5)); }
DI void stage_rc(int b, int& R, int& C) { int st = b >> 10, sb = b & 1023, swz = sb ^ (((sb >> 9) & 1) << 5); R = (st >> 1) * 16 + (swz >> 6); C = (st & 1) * 32 + ((swz & 63) >> 1); }

#define SA(b, h) (smem + ((b) * 2 + (h)) * 16384)
#define SB(b, h) (smem + (4 + (b) * 2 + (h)) * 16384)
#define STAGE_A(P, half, kt) do { const u16* _g = A + (long)(half) * 128 * lda + (long)(kt) * 64; \
    __builtin_amdgcn_global_load_lds((const unsigned*)(_g + offA0), (unsigned*)((P) + wbase), 16, 0, 0); \
    __builtin_amdgcn_global_load_lds((const unsigned*)(_g + 64 * lda + offA0), (unsigned*)((P) + wbase + 8192), 16, 0, 0); } while (0)
#define STAGE_B(P, half, kt) do { const u16* _g = Bt + (long)(half) * 128 * ldb + (long)(kt) * 64; \
    __builtin_amdgcn_global_load_lds((const unsigned*)(_g + offB0), (unsigned*)((P) + wbase), 16, 0, 0); \
    __builtin_amdgcn_global_load_lds((const unsigned*)(_g + 64 * ldb + offB0), (unsigned*)((P) + wbase + 8192), 16, 0, 0); } while (0)
#define LDA(dst, b, h) _Pragma("unroll") for (int m = 0; m < 4; ++m) _Pragma("unroll") for (int k = 0; k < 2; ++k) \
    dst[m][k] = *reinterpret_cast<const bf16x8*>(SA(b, h) + lds_byte(wr * 64 + m * 16 + fr, k * 32 + fq * 8))
#define LDB(dst, b, h) _Pragma("unroll") for (int n = 0; n < 2; ++n) _Pragma("unroll") for (int k = 0; k < 2; ++k) \
    dst[n][k] = *reinterpret_cast<const bf16x8*>(SB(b, h) + lds_byte(wc * 32 + n * 16 + fr, k * 32 + fq * 8))
#define MMA(ai, bj, At, Bx) do { __builtin_amdgcn_s_setprio(1); \
    _Pragma("unroll") for (int m = 0; m < 4; ++m) _Pragma("unroll") for (int n = 0; n < 2; ++n) _Pragma("unroll") for (int k = 0; k < 2; ++k) \
      acc[ai][bj][m][n] = __builtin_amdgcn_mfma_f32_16x16x32_bf16(At[m][k], Bx[n][k], acc[ai][bj][m][n], 0, 0, 0); \
    __builtin_amdgcn_s_setprio(0); } while (0)
#define WAIT_V(n) asm volatile("s_waitcnt vmcnt(" #n ")" ::: "memory")
#define WAIT_L(n) asm volatile("s_waitcnt lgkmcnt(" #n ")" ::: "memory")
#define BAR __builtin_amdgcn_s_barrier()
#define SCHED __builtin_amdgcn_sched_barrier(0)

template <int NA> DI void gemm_kloop(const int TID, const u16* __restrict__ A, int lda, const u16* __restrict__ Bt, int ldb, int nt, f32x4 (&acc)[NA][2][4][2]) {
  const int tid = TID, wid = tid >> 6, lane = tid & 63, wr = wid >> 2, wc = wid & 3, fr = lane & 15, fq = lane >> 4;
  unsigned offA0, offB0;
  { int r, c; stage_rc(tid * 16, r, c); offA0 = r * lda + c; offB0 = r * ldb + c; }
  const int wbase = __builtin_amdgcn_readfirstlane(wid) * 1024;
#pragma unroll
  for (int a = 0; a < NA; ++a)
#pragma unroll
    for (int b = 0; b < 2; ++b)
#pragma unroll
      for (int m = 0; m < 4; ++m)
#pragma unroll
        for (int n = 0; n < 2; ++n) acc[a][b][m][n] = f32x4{0.f, 0.f, 0.f, 0.f};
  STAGE_B(SB(0, 0), 0, 0); STAGE_A(SA(0, 0), 0, 0); STAGE_B(SB(0, 1), 1, 0); if (NA == 2) STAGE_A(SA(0, 1), 1, 0);
  WAIT_V(0); __syncthreads();
#pragma unroll 1
  for (int t = 0; t < nt; ++t) {
    const int cb = t & 1, nb = cb ^ 1;
    if (t + 1 < nt) { STAGE_B(SB(nb, 0), 0, t + 1); STAGE_A(SA(nb, 0), 0, t + 1); STAGE_B(SB(nb, 1), 1, t + 1); if (NA == 2) STAGE_A(SA(nb, 1), 1, t + 1); }
#pragma unroll 1
    for (int k = 0; k < 2; ++k) {
      bf16x8 Bf[2][2];
#pragma unroll
      for (int bj = 0; bj < 2; ++bj)
#pragma unroll
        for (int n = 0; n < 2; ++n) Bf[bj][n] = *reinterpret_cast<const bf16x8*>(SB(cb, bj) + lds_byte(wc * 32 + n * 16 + fr, k * 32 + fq * 8));
#pragma unroll
      for (int ai = 0; ai < NA; ++ai) {
        bf16x8 Af[4];
#pragma unroll
        for (int m = 0; m < 4; ++m) Af[m] = *reinterpret_cast<const bf16x8*>(SA(cb, ai) + lds_byte(wr * 64 + m * 16 + fr, k * 32 + fq * 8));
#pragma unroll
        for (int bj = 0; bj < 2; ++bj)
#pragma unroll
          for (int m = 0; m < 4; ++m)
#pragma unroll
            for (int n = 0; n < 2; ++n) acc[ai][bj][m][n] = __builtin_amdgcn_mfma_f32_16x16x32_bf16(Af[m], Bf[bj][n], acc[ai][bj][m][n], 0, 0, 0);
      }
    }
    WAIT_V(0); __syncthreads();
  }
}

#define LDA8(dst, b, h) _Pragma("unroll") for (int m = 0; m < 4; ++m) _Pragma("unroll") for (int k = 0; k < 2; ++k) \
    dst[m][k] = *reinterpret_cast<const bf16x8*>(SA(b, h) + lds_byte(wr * 64 + m * 16 + fr, k * 32 + fq * 8))
#define LDB8(dst, b, h) _Pragma("unroll") for (int n = 0; n < 2; ++n) _Pragma("unroll") for (int k = 0; k < 2; ++k) \
    dst[n][k] = *reinterpret_cast<const bf16x8*>(SB(b, h) + lds_byte(wc * 32 + n * 16 + fr, k * 32 + fq * 8))
#define MMA8(ai, bj, At, Bx) do { __builtin_amdgcn_s_setprio(1); \
    _Pragma("unroll") for (int m = 0; m < 4; ++m) _Pragma("unroll") for (int n = 0; n < 2; ++n) _Pragma("unroll") for (int k = 0; k < 2; ++k) \
      acc[ai][bj][m][n] = __builtin_amdgcn_mfma_f32_16x16x32_bf16(At[m][k], Bx[n][k], acc[ai][bj][m][n], 0, 0, 0); \
    __builtin_amdgcn_s_setprio(0); } while (0)
DI void gemm_kloop8(const int TID, const u16* __restrict__ A, int lda, const u16* __restrict__ Bt, int ldb, int nt, f32x4 (&acc)[2][2][4][2]) {
  const int tid = TID, wid = tid >> 6, lane = tid & 63, wr = wid >> 2, wc = wid & 3, fr = lane & 15, fq = lane >> 4;
  unsigned offA0, offB0;
  { int r, c; stage_rc(tid * 16, r, c); offA0 = r * lda + c; offB0 = r * ldb + c; }
  const int wbase = __builtin_amdgcn_readfirstlane(wid) * 1024;
#pragma unroll
  for (int a = 0; a < 2; ++a)
#pragma unroll
    for (int b = 0; b < 2; ++b)
#pragma unroll
      for (int m = 0; m < 4; ++m)
#pragma unroll
        for (int n = 0; n < 2; ++n) acc[a][b][m][n] = f32x4{0.f, 0.f, 0.f, 0.f};
  bf16x8 At[4][2], B0[2][2], B1[2][2];
  STAGE_B(SB(0, 0), 0, 0); STAGE_A(SA(0, 0), 0, 0);
  STAGE_B(SB(0, 1), 1, 0); STAGE_A(SA(0, 1), 1, 0);
  if (wr == 1) BAR;
  WAIT_V(4); BAR;
  STAGE_B(SB(1, 0), 0, 1); STAGE_A(SA(1, 0), 0, 1); STAGE_B(SB(1, 1), 1, 1);
  WAIT_V(6); BAR;
#pragma unroll 1
  for (int t = 0; t < nt - 2; t += 2) {
    LDB8(B0, 0, 0); SCHED; LDA8(At, 0, 0); STAGE_A(SA(1, 1), 1, t + 1);
    WAIT_L(8); BAR; WAIT_L(0); MMA8(0, 0, At, B0); BAR; SCHED;
    LDB8(B1, 0, 1); STAGE_B(SB(0, 0), 0, t + 2);
    BAR; WAIT_L(0); MMA8(0, 1, At, B1); BAR;
    LDA8(At, 0, 1); STAGE_A(SA(0, 0), 0, t + 2);
    BAR; WAIT_L(0); MMA8(1, 0, At, B0); BAR; SCHED;
    STAGE_B(SB(0, 1), 1, t + 2);
    WAIT_V(6); BAR; MMA8(1, 1, At, B1); BAR;
    LDB8(B0, 1, 0); SCHED; LDA8(At, 1, 0); STAGE_A(SA(0, 1), 1, t + 2);
    WAIT_L(8); BAR; WAIT_L(0); MMA8(0, 0, At, B0); BAR; SCHED;
    LDB8(B1, 1, 1); STAGE_B(SB(1, 0), 0, t + 3);
    BAR; WAIT_L(0); MMA8(0, 1, At, B1); BAR;
    LDA8(At, 1, 1); STAGE_A(SA(1, 0), 0, t + 3);
    BAR; WAIT_L(0); MMA8(1, 0, At, B0); BAR; SCHED;
    STAGE_B(SB(1, 1), 1, t + 3);
    WAIT_V(6); BAR; MMA8(1, 1, At, B1); BAR;
  }
  { LDB8(B0, 0, 0); LDA8(At, 0, 0); STAGE_A(SA(1, 1), 1, nt - 1);
    BAR; WAIT_L(0); MMA8(0, 0, At, B0); BAR;
    LDB8(B1, 0, 1); BAR; WAIT_L(0); MMA8(0, 1, At, B1); BAR;
    LDA8(At, 0, 1); WAIT_V(4); BAR; WAIT_L(0); MMA8(1, 0, At, B0); MMA8(1, 1, At, B1); BAR; }
  { LDB8(B0, 1, 0); LDA8(At, 1, 0); WAIT_V(2); BAR; WAIT_L(0); MMA8(0, 0, At, B0); BAR;
    LDB8(B1, 1, 1); WAIT_V(0); BAR; WAIT_L(0); MMA8(0, 1, At, B1); BAR;
    LDA8(At, 1, 1); BAR; WAIT_L(0); MMA8(1, 0, At, B0); MMA8(1, 1, At, B1); BAR; }
  if (wr == 0) BAR;
  __syncthreads();
}

DI void gemm_kloop_r3(const int TID, const u16* __restrict__ A, int lda, const u16* __restrict__ Bt, int ldb, int nt, f32x4 (&acc)[1][2][4][2]) {
  const int tid = TID, wid = tid >> 6, lane = tid & 63, wr = wid >> 2, wc = wid & 3, fr = lane & 15, fq = lane >> 4;
  unsigned offA0, offB0;
  { int r, c; stage_rc(tid * 16, r, c); offA0 = r * lda + c; offB0 = r * ldb + c; }
  const int wbase = __builtin_amdgcn_readfirstlane(wid) * 1024;
#pragma unroll
  for (int b = 0; b < 2; ++b)
#pragma unroll
    for (int m = 0; m < 4; ++m)
#pragma unroll
      for (int n = 0; n < 2; ++n) acc[0][b][m][n] = f32x4{0.f, 0.f, 0.f, 0.f};
#define R3A(i) (smem + (i) * 49152)
#define R3B(i, h) (smem + (i) * 49152 + 16384 + (h) * 16384)
#define R3_STAGE(i, kt) do { STAGE_B(R3B(i, 0), 0, kt); STAGE_A(R3A(i), 0, kt); STAGE_B(R3B(i, 1), 1, kt); } while (0)
  R3_STAGE(0, 0); R3_STAGE(1, 1);
  WAIT_V(6); BAR;
  int cur = 0;
#pragma unroll 1
  for (int t = 0; t < nt; ++t) {
    const int nx1 = (cur == 2) ? 0 : cur + 1, nx2 = (cur == 0) ? 2 : cur - 1;
    if (t + 2 < nt) R3_STAGE(nx2, t + 2);
#pragma unroll
    for (int k = 0; k < 2; ++k) {
      bf16x8 Bf[2][2], Af[4];
#pragma unroll
      for (int bj = 0; bj < 2; ++bj)
#pragma unroll
        for (int n = 0; n < 2; ++n) Bf[bj][n] = *reinterpret_cast<const bf16x8*>(R3B(cur, bj) + lds_byte(wc * 32 + n * 16 + fr, k * 32 + fq * 8));
#pragma unroll
      for (int m = 0; m < 4; ++m) Af[m] = *reinterpret_cast<const bf16x8*>(R3A(cur) + lds_byte(wr * 64 + m * 16 + fr, k * 32 + fq * 8));
#pragma unroll
      for (int bj = 0; bj < 2; ++bj)
#pragma unroll
        for (int m = 0; m < 4; ++m)
#pragma unroll
          for (int n = 0; n < 2; ++n) acc[0][bj][m][n] = __builtin_amdgcn_mfma_f32_16x16x32_bf16(Af[m], Bf[bj][n], acc[0][bj][m][n], 0, 0, 0);
    }
    if (t + 2 < nt) WAIT_V(6); else WAIT_V(0);
    WAIT_L(0); BAR;
    cur = nx1;
  }
}

DI void tile_coords(int tile, int nM, int nN, int& pm, int& pn) {
  int nig = 8 * nN, gid = tile / nig, fm = gid * 8, gsz = min(nM - fm, 8), loc = tile % nig;
  pm = fm + loc % gsz; pn = loc / gsz;
}

#define GEMM_IDS const int tid = TID, wid = tid >> 6, lane = tid & 63, wr = wid >> 2, wc = wid & 3, fr = lane & 15, fq = lane >> 4; (void)tid; (void)wr; (void)wc; (void)fr; (void)fq; (void)lane;
DI int fresh_tid(int wv) { int l; asm volatile("v_mbcnt_lo_u32_b32 %0, -1, 0\n\tv_mbcnt_hi_u32_b32 %0, -1, %0" : "=v"(l)); return wv * 64 + l; }
DI int opaque_zero() { int z; asm volatile("s_mov_b32 %0, 0" : "=s"(z)); return z; }
#define ACC_TO_LDS(ai) do { float* _e = (float*)smem; \
  _Pragma("unroll") for (int bj = 0; bj < 2; ++bj) _Pragma("unroll") for (int m = 0; m < 4; ++m) _Pragma("unroll") for (int n = 0; n < 2; ++n) _Pragma("unroll") for (int j = 0; j < 4; ++j) \
    _e[(wr * 64 + m * 16 + fq * 4 + j) * EP_LD + bj * 128 + wc * 32 + n * 16 + fr] = acc[ai][bj][m][n][j]; } while (0)
#define EPI_ROWS_BEGIN(ai) _Pragma("unroll 4") for (int _it = 0; _it < 16; ++_it) { const int _idx = _it * 512 + tid; const int rl = _idx >> 6, cl = (_idx & 63) * 4; \
    const float4 v = *(const float4*)((const float*)smem + rl * EP_LD + cl); const int row = browz + (ai) * 128 + rl; const int col = bcol + cl; (void)row; (void)col;
#define EPI_ROWS_END }
DI uint2 pk4(float a, float b, float c, float d) { uint2 o; o.x = pk2(a, b); o.y = pk2(c, d); return o; }

DI void sgemm16(const int lane, const u16* __restrict__ A, int lda, const u16* __restrict__ Bt, int ldb, int K, int bc0, int bc1, f32x4& c0, f32x4& c1) {
  const int fr = lane & 15, fq = lane >> 4;
  const u16* ap = A + (long)fr * lda + fq * 8;
  const u16* b0 = Bt + (long)(bc0 + fr) * ldb + fq * 8; const u16* b1 = Bt + (long)(bc1 + fr) * ldb + fq * 8;
  c0 = f32x4{0.f, 0.f, 0.f, 0.f}; c1 = c0;
#pragma unroll 8
  for (int k = 0; k < K; k += 32) { const bf16x8 a = *(const bf16x8*)(ap + k), x = *(const bf16x8*)(b0 + k), y = *(const bf16x8*)(b1 + k);
    c0 = __builtin_amdgcn_mfma_f32_16x16x32_bf16(a, x, c0, 0, 0, 0); c1 = __builtin_amdgcn_mfma_f32_16x16x32_bf16(a, y, c1, 0, 0, 0); }
}
DI void inproj_store_s(KP p, int l, int row, int col, float v) {
  unsigned char* ws = p->ws; u16* proj = (u16*)(ws + WS_PROJ);
  const int rs = row - MP;
  if (col >= PC_G) proj[(long)row * NPJ + col] = f2bf(sigm(v));
  else if (col >= PC_QD && col < PC_KD) proj[(long)row * NPJ + col] = f2bf(v * QD_SCALE);
  else if (col >= PC_KD && col < PC_VD) { const int hv = col - PC_KD; p->out[O_SDK + (long)l * MS * 512 + rs * 512 + hv] = v;
    ((u16*)(ws + WS_KDS))[((long)(rs >> 4) * SKP + PAST + (rs & 15)) * 512 + hv] = f2bf(v); }
  else if (col >= PC_VD && col < PC_ZD) { const int hv = col - PC_VD; p->out[O_SDV + (long)l * MS * 512 + rs * 512 + hv] = v;
    ((u16*)(ws + WS_VDTS))[((long)(rs >> 4) * 512 + hv) * SKP + kperm(PAST + (rs & 15))] = f2bf(v); }
  else proj[(long)row * NPJ + col] = f2bf(v);
}

template <bool PERM> DI void transpose_tile(const int TID, const float* __restrict__ src, long ld_s, u16* __restrict__ dst, long ld_d, int r0, int c0, int drow0) {
  u16* tl = (u16*)smem;
  const int tid = TID;
  { int rr = tid >> 3, cc = (tid & 7) * 4; float4 v = *(const float4*)(src + (long)(r0 + rr) * ld_s + c0 + cc);
    tl[(cc + 0) * 72 + rr] = f2bf(v.x); tl[(cc + 1) * 72 + rr] = f2bf(v.y); tl[(cc + 2) * 72 + rr] = f2bf(v.z); tl[(cc + 3) * 72 + rr] = f2bf(v.w); }
  __syncthreads();
  if (tid < 256) { int cc = tid >> 3, rr = (tid & 7) * 8; uint4 v = *(const uint4*)(tl + cc * 72 + rr);
    if (PERM) { u16* d = dst + (long)(drow0 + cc) * ld_d; *(uint2*)(d + kperm(r0 + rr)) = uint2{v.x, v.y}; *(uint2*)(d + kperm(r0 + rr + 4)) = uint2{v.z, v.w}; }
    else *(uint4*)(dst + (long)(drow0 + cc) * ld_d + r0 + rr) = v; }
  __syncthreads();
}

DI void rmsnorm_rows_to_bf16(const int TID, KP p, int l) {
  const int lane = TID & 63, wid = TID >> 6;
  const float* g = p->in[8] + l * D;
  u16* xn = (u16*)(p->ws + WS_XN);
  for (int row = blockIdx.x * 8 + wid; row < M; row += gridDim.x * 8) {
    const float* src = (l == 0) ? (row < MP ? p->in[0] + (long)row * D : p->in[1] + (long)(row - MP) * D) : p->out + (long)row * D;
    float4 v[4]; float ss = 0.f;
#pragma unroll
    for (int i = 0; i < 4; ++i) { v[i] = *(const float4*)(src + i * 256 + lane * 4); ss += v[i].x * v[i].x + v[i].y * v[i].y + v[i].z * v[i].z + v[i].w * v[i].w; }
    ss = wsum(ss); const float rs = rsqrtf(ss * (1.f / D) + EPS);
#pragma unroll
    for (int i = 0; i < 4; ++i) { float4 gg = *(const float4*)(g + i * 256 + lane * 4);
      uint2 o; o.x = pk2(v[i].x * rs * gg.x, v[i].y * rs * gg.y); o.y = pk2(v[i].z * rs * gg.z, v[i].w * rs * gg.w);
      *(uint2*)(xn + (long)row * D + i * 256 + lane * 4) = o; }
  }
}

DI void prep_phase(const int TID, KP p, int l) {
  const int tid = TID, G = gridDim.x, bx = blockIdx.x;
  const long gtid = (long)bx * 512 + tid, gn = (long)G * 512;
  unsigned char* ws = p->ws;
  rmsnorm_rows_to_bf16(TID, p, l);
  { const float* w = p->in[9] + (long)l * 1024 * NIN; u16* d = (u16*)(ws + WS_WIN);
    for (int i = bx; i < 16 * 221; i += G) { int kt = i & 15, ct = i >> 4, c0 = ct * 32; transpose_tile<false>(TID, w, NIN, d, 1024, kt * 64, c0, c0 < 416 ? c0 : c0 + 96); }
    for (long i = gtid; i < 96 * 1024 / 8; i += gn) { const unsigned z = (unsigned)TID >> 31; ((uint4*)(d + 416 * 1024))[i] = uint4{z, z, z, z}; } }
  for (int b = 0; b < 3; ++b) { const float* w = p->in[27 + b] + (long)l * 512 * 1024; u16* d = (u16*)(ws + WS_WO) + (long)b * 1024 * 512;
    for (int i = bx; i < 8 * 32; i += G) { int rt = i & 7, ct = i >> 3; transpose_tile<false>(TID, w, 1024, d, 512, rt * 64, ct * 32, ct * 32); } }
  { const float* w = p->in[30] + (long)l * 1024 * 1024; u16* d = (u16*)(ws + WS_WOUT);
    for (int i = bx; i < 16 * 32; i += G) { int rt = i & 15, ct = i >> 4; transpose_tile<false>(TID, w, 1024, d, 1024, rt * 64, ct * 32, ct * 32); } }
  { const float* c = p->in[2] + (long)l * 8 * PAST * 128; u16* d = (u16*)(ws + WS_CKVTS);
    for (int i = bx; i < 8 * 32 * 4; i += G) { int sb = i >> 7, r = i & 127, rt = r & 31, ct = r >> 5;
      transpose_tile<true>(TID, c + (long)sb * PAST * 128, 128, d + (long)sb * 128 * SKP, SKP, rt * 64, ct * 32, ct * 32); } }
  { const float* c = p->in[5] + (long)l * 8 * PAST * 512; u16* d = (u16*)(ws + WS_VDTS);
    for (int i = bx; i < 8 * 32 * 16; i += G) { int sb = i >> 9, r = i & 511, rt = r & 31, ct = r >> 5;
      transpose_tile<true>(TID, c + (long)sb * PAST * 512, 512, d + (long)sb * 512 * SKP, SKP, rt * 64, ct * 32, ct * 32); } }
  { const float* c = p->in[2] + (long)l * 8 * PAST * 128; u16* d = (u16*)(ws + WS_CKVS);
    for (long i = gtid; i < 8L * PAST * 128 / 4; i += gn) { long e = i * 4; int sb = (int)(e / (PAST * 128)); long r = e - (long)sb * PAST * 128;
      float4 v = *(const float4*)(c + e); uint2 o; o.x = pk2(v.x, v.y); o.y = pk2(v.z, v.w); *(uint2*)(d + (long)sb * SKP * 128 + r) = o; } }
  { const float* c = p->in[3] + (long)l * 8 * PAST * 32; u16* d = (u16*)(ws + WS_KRS);
    for (long i = gtid; i < 8L * PAST * 32 / 4; i += gn) { long e = i * 4; int sb = (int)(e / (PAST * 32)); long r = e - (long)sb * PAST * 32;
      float4 v = *(const float4*)(c + e); uint2 o; o.x = pk2(v.x, v.y); o.y = pk2(v.z, v.w); *(uint2*)(d + (long)sb * SKP * 32 + r) = o; } }
  { const float* c = p->in[4] + (long)l * 8 * PAST * 512; u16* d = (u16*)(ws + WS_KDS);
    for (long i = gtid; i < 8L * PAST * 512 / 4; i += gn) { long e = i * 4; int sb = (int)(e / (PAST * 512)); long r = e - (long)sb * PAST * 512;
      float4 v = *(const float4*)(c + e); uint2 o; o.x = pk2(v.x, v.y); o.y = pk2(v.z, v.w); *(uint2*)(d + (long)sb * SKP * 512 + r) = o; } }
  for (long i = gtid; i < 8L * 48 * 128; i += gn) { int sb = (int)(i / (48 * 128)); int r = (int)(i % (48 * 128)); ((u16*)(ws + WS_CKVS))[((long)sb * SKP + SK) * 128 + r] = 0; }
  for (long i = gtid; i < 8L * 48 * 32; i += gn) { int sb = (int)(i / (48 * 32)); int r = (int)(i % (48 * 32)); ((u16*)(ws + WS_KRS))[((long)sb * SKP + SK) * 32 + r] = 0; }
  for (long i = gtid; i < 8L * 48 * 512; i += gn) { int sb = (int)(i / (48 * 512)); int r = (int)(i % (48 * 512)); ((u16*)(ws + WS_KDS))[((long)sb * SKP + SK) * 512 + r] = 0; }
  for (long i = gtid; i < 8L * 128 * 48; i += gn) { int rw = (int)(i / 48), k = (int)(i % 48); ((u16*)(ws + WS_CKVTS))[(long)rw * SKP + SK + k] = 0; }
  for (long i = gtid; i < 8L * 512 * 48; i += gn) { int rw = (int)(i / 48), k = (int)(i % 48); ((u16*)(ws + WS_VDTS))[(long)rw * SKP + SK + k] = 0; }
  { const float* uq = p->in[12] + (long)l * 256 * 768; const float* uk = p->in[13] + (long)l * 128 * 512; u16* d = (u16*)(ws + WS_WQ);
    for (long i = gtid; i < 1280L * 256; i += gn) { int n = (int)(i >> 8), r = (int)(i & 255); float s;
      if (n < 1024) { int hd = n >> 7, c = n & 127; const float* a = uq + r * 768 + hd * 96; const float* b = uk + c * 512 + hd * 64; s = 0.f;
        for (int dd = 0; dd < 64; dd += 4) { float4 x = *(const float4*)(a + dd), y = *(const float4*)(b + dd); s += x.x * y.x + x.y * y.y + x.z * y.z + x.w * y.w; } }
      else { int hd = (n - 1024) >> 5, j = (n - 1024) & 31; s = uq[r * 768 + hd * 96 + 64 + j]; }
      d[i] = f2bf(s); } }
  { const float* uv = p->in[14] + (long)l * 128 * 512; u16* d = (u16*)(ws + WS_WUV);
    for (long i = gtid; i < 512L * 512; i += gn) { int n = (int)(i >> 9), kk = (int)(i & 511); int hd = n >> 6, v = n & 63, hk = (n >> 8) * 4 + (kk >> 7), c = kk & 127;
      d[i] = (hk == hd) ? f2bf(uv[c * 512 + hd * 64 + v]) : (u16)0; } }
  { const float* wa = p->in[22] + (long)l * 8 * 4096; const float* wx = p->in[24] + (long)l * 8 * 4096; u16* d = (u16*)(ws + WS_WLRU);
    for (long i = gtid; i < 1024L * 256; i += gn) { int nn = (int)(i >> 8), kk = (int)(i & 255); int pn = nn >> 8, nl = nn & 255; int f = pn * 128 + (nl & 127);
      int blk = f >> 6, o = f & 63, bk = (pn >> 1) * 4 + (kk >> 6), ii = kk & 63; const float* w = (nl < 128) ? wa : wx;
      d[i] = (bk == blk) ? f2bf(w[blk * 4096 + ii * 64 + o]) : (u16)0; } }
  if (bx == 0 && tid == 0) {
    float s1 = 0.f, s2 = 0.f;
    for (int i = 0; i < 32; ++i) { s1 += p->in[15][l * 32 + i] * p->in[16][l * 32 + i]; s2 += p->in[17][l * 32 + i] * p->in[18][l * 32 + i]; }
    const float lam_init = 0.8f - 0.6f * expf(-0.3f * (float)l);
    float* sc = (float*)(ws + WS_CTL + 1024);
    sc[l * 2 + 0] = expf(s1) - expf(s2) + lam_init; sc[l * 2 + 1] = lam_init;
  }
  if (l == 0) {
    float2* tab = (float2*)(ws + WS_ROPE);
    for (long i = gtid; i < 4096 * 16; i += gn) { int pos = (int)(i >> 4), j = (int)(i & 15);
      const float a = (float)pos * g_invf[j];
      const float k = rintf(a * 0.63661977236758134f);
      float y = fmaf(-k, 1.5707963109016418f, a); y = fmaf(-k, 1.5893254712295857e-08f, y); y = fmaf(-k, 6.0770999344e-16f, y);
      const float y2 = y * y;
      const float sn = y * (1.f + y2 * (-1.6666667163e-01f + y2 * (8.3333337680e-03f + y2 * (-1.9841270114e-04f + y2 * 2.7557314297e-06f))));
      const float cs = 1.f + y2 * (-0.5f + y2 * (4.1666667908e-02f + y2 * (-1.3888889225e-03f + y2 * (2.4801587642e-05f + y2 * -2.7557314297e-07f))));
      const int q = ((int)k) & 3;
      const float c2 = (q == 0) ? cs : (q == 1) ? -sn : (q == 2) ? -cs : sn;
      const float s2 = (q == 0) ? sn : (q == 1) ? cs : (q == 2) ? -sn : -cs;
      tab[i] = float2{c2, s2}; }
  }
}

DI void inproj_phase(const int TID_in, KP p, int l, int vid) {
  const int wv = __builtin_amdgcn_readfirstlane(TID_in >> 6);
  unsigned char* ws = p->ws;
  f32x4 acc[2][2][4][2];
  for (int tile = vid; tile < 64 * 28; tile += gridDim.x) {
    int pm, pn; tile_coords(tile, 64, 28, pm, pn);
    const int brow = pm * 256, bcol = pn * 256;
    gemm_kloop8(fresh_tid(wv), (const u16*)(ws + WS_XN) + (long)brow * 1024, 1024, (const u16*)(ws + WS_WIN) + (long)bcol * 1024, 1024, 16, acc);
    const int TID = fresh_tid(wv);
    GEMM_IDS
    const int oz = opaque_zero(); const int browz = brow + oz;
    u16* proj = (u16*)(ws + WS_PROJ) + oz;
#pragma unroll
    for (int ai = 0; ai < 2; ++ai) {
      ACC_TO_LDS(ai);
      __syncthreads();
      if (pn >= 16) {
        EPI_ROWS_BEGIN(ai) *(uint2*)(proj + (long)row * NPJ + col) = pk4(sigm(v.x), sigm(v.y), sigm(v.z), sigm(v.w)); EPI_ROWS_END
      } else if (pn == 4 || pn == 5) {
        EPI_ROWS_BEGIN(ai) *(uint2*)(proj + (long)row * NPJ + col) = pk4(v.x * QD_SCALE, v.y * QD_SCALE, v.z * QD_SCALE, v.w * QD_SCALE); EPI_ROWS_END
      } else if (pn == 6 || pn == 7) {
        u16* kds = (u16*)(ws + WS_KDS) + oz;
        EPI_ROWS_BEGIN(ai)
          const int hv = col - PC_KD; const uint2 pk = pk4(v.x, v.y, v.z, v.w);
          *(uint2*)(proj + (long)row * NPJ + col) = pk;
          if (row < MP) *(float4*)(p->out + O_PDK + (long)l * MP * 512 + (long)row * 512 + hv) = v;
          else if (row < M) { const int rs = row - MP; *(float4*)(p->out + O_SDK + (long)l * MS * 512 + rs * 512 + hv) = v;
            *(uint2*)(kds + ((long)(rs >> 4) * SKP + PAST + (rs & 15)) * 512 + hv) = pk; }
        EPI_ROWS_END
      } else if (pn == 8 || pn == 9) {
        EPI_ROWS_BEGIN(ai)
          const int hv = col - PC_VD;
          if (row < MP) *(float4*)(p->out + O_PDV + (long)l * MP * 512 + (long)row * 512 + hv) = v;
          else if (row < M) *(float4*)(p->out + O_SDV + (long)l * MS * 512 + (row - MP) * 512 + hv) = v;
        EPI_ROWS_END
        u16* vtp = (u16*)(ws + WS_VDTP) + oz; u16* vts = (u16*)(ws + WS_VDTS) + oz;
#pragma unroll 4
        for (int it = 0; it < 16; ++it) { const int idx = it * 512 + tid; const int cl = idx & 255, r4 = (idx >> 8) * 4;
          const float* e = (const float*)smem + r4 * EP_LD + cl;
          const uint2 pk = pk4(e[0], e[EP_LD], e[2 * EP_LD], e[3 * EP_LD]);
          const int row0 = browz + ai * 128 + r4, hv = bcol + cl - PC_VD;
          if (row0 < MP) *(uint2*)(vtp + ((long)(row0 >> 12) * 512 + hv) * TP + kperm(row0 & (TP - 1))) = pk;
          else if (row0 < M) { const int rs = row0 - MP; *(uint2*)(vts + ((long)(rs >> 4) * 512 + hv) * SKP + kperm(PAST + (rs & 15))) = pk; } }
      } else {
        EPI_ROWS_BEGIN(ai) *(uint2*)(proj + (long)row * NPJ + col) = pk4(v.x, v.y, v.z, v.w); EPI_ROWS_END
      }
      __syncthreads();
    }
  }
  const int TID = fresh_tid(wv);
  GEMM_IDS
  for (int it = (int)gridDim.x - 1 - vid; it < 8 * 28; it += gridDim.x) {
    const int rg = it & 7, pn = it >> 3; const int row0 = MP + rg * 16, bcol = pn * 256;
    f32x4 c0, c1;
    sgemm16(lane, (const u16*)(ws + WS_XN) + (long)row0 * 1024, 1024, (const u16*)(ws + WS_WIN) + (long)bcol * 1024, 1024, 1024, wid * 32, wid * 32 + 16, c0, c1);
#pragma unroll
    for (int j = 0; j < 4; ++j) { const int row = row0 + fq * 4 + j; inproj_store_s(p, l, row, bcol + wid * 32 + fr, c0[j]); inproj_store_s(p, l, row, bcol + wid * 32 + 16 + fr, c1[j]); }
  }
}

template <int NR> DI void mid_unit(const int TID, KP p, int l, const int r0) {
  const int tid = TID, lane = tid & 63, wid = tid >> 6;
  unsigned char* ws = p->ws;
  u16* proj = (u16*)(ws + WS_PROJ);
  u16* tl = (u16*)smem;
  const float* gq = p->in[10] + l * 256; const float* gkv = p->in[11] + l * 128;
  const float2* rope = (const float2*)(ws + WS_ROPE);
  const float* cw = p->in[20] + l * 4 * 512; const float* cb = p->in[21] + l * 512;
  u16* xc = (u16*)(ws + WS_XC);
  const int rw0 = r0 + wid * NR;
  const bool pr = rw0 < MP; const int rs0 = rw0 - MP;
  const int b = pr ? (rw0 >> 12) : (rs0 >> 4), t0 = pr ? (rw0 & (TP - 1)) : (rs0 & 15);
  u16* prow0 = proj + (long)rw0 * NPJ;
  {
    uint2 vq[NR]; u32 vk[NR]; float x1[NR], x2[NR];
#pragma unroll
    for (int i = 0; i < NR; ++i) { const u16* pw = prow0 + (long)i * NPJ; vq[i] = *(const uint2*)(pw + PC_CQ + lane * 4); vk[i] = *(const u32*)(pw + PC_CKV + lane * 2);
      x1[i] = bf2f(pw[PC_KR + (lane & 15)]); x2[i] = bf2f(pw[PC_KR + 16 + (lane & 15)]); }
    const float4 g4 = *(const float4*)(gq + lane * 4); const float2 g2 = *(const float2*)(gkv + lane * 2);
#pragma unroll
    for (int i = 0; i < NR; ++i) {
      const int row = rw0 + i, t = t0 + i, pos = pr ? t : PAST + t; const int rs = row - MP;
      u16* prow = prow0 + (long)i * NPJ;
      { float a0 = lo2f(vq[i].x), a1 = hi2f(vq[i].x), a2 = lo2f(vq[i].y), a3 = hi2f(vq[i].y);
        float ss = wsum(a0 * a0 + a1 * a1 + a2 * a2 + a3 * a3); float rsd = rsqrtf(ss * (1.f / 256) + EPS);
        *(uint2*)(prow + PC_CQ + lane * 4) = pk4(a0 * rsd * g4.x, a1 * rsd * g4.y, a2 * rsd * g4.z, a3 * rsd * g4.w); }
      { float a0 = lo2f(vk[i]), a1 = hi2f(vk[i]);
        float ss = wsum(a0 * a0 + a1 * a1); float rsd = rsqrtf(ss * (1.f / 128) + EPS);
        float y0 = a0 * rsd * g2.x, y1 = a1 * rsd * g2.y;
        float* so = pr ? p->out + O_PCKV + (long)l * MP * 128 + (long)row * 128 : p->out + O_SCKV + (long)l * MS * 128 + rs * 128;
        *(float2*)(so + lane * 2) = float2{y0, y1};
        u32 pk = pk2(y0, y1);
        u16* kb = pr ? (u16*)(ws + WS_CKVP) + (long)row * 128 : (u16*)(ws + WS_CKVS) + ((long)b * SKP + PAST + t) * 128;
        *(u32*)(kb + lane * 2) = pk;
        tl[(lane * 2) * 72 + wid * NR + i] = (u16)(pk & 0xffff); tl[(lane * 2 + 1) * 72 + wid * NR + i] = (u16)(pk >> 16); }
      if (lane < 16) {
        float2 cs = rope[pos * 16 + lane];
        float o1 = x1[i] * cs.x - x2[i] * cs.y, o2 = x2[i] * cs.x + x1[i] * cs.y;
        float* so = pr ? p->out + O_PKR + (long)l * MP * 32 + (long)row * 32 : p->out + O_SKR + (long)l * MS * 32 + rs * 32;
        so[lane] = o1; so[lane + 16] = o2;
        u16* kb = pr ? (u16*)(ws + WS_KRP) + (long)row * 32 : (u16*)(ws + WS_KRS) + ((long)b * SKP + PAST + t) * 32;
        kb[lane] = f2bf(o1); kb[lane + 16] = f2bf(o2); }
    }
  }
  {
    const int f = lane * 8;
    uint4 xin[NR + 3];
#pragma unroll
    for (int k = 0; k < NR + 3; ++k) {
      const int tt = t0 + k - 3;
      if (tt >= 0) xin[k] = *(const uint4*)(prow0 + (long)(k - 3) * NPJ + PC_XL + f);
      else if (!pr) { const float* c0 = p->in[7] + (((long)l * 8 + b) * 3 + (tt + 3)) * 512 + f; float4 u0 = *(const float4*)c0, u1 = *(const float4*)(c0 + 4);
        xin[k] = uint4{pk2(u0.x, u0.y), pk2(u0.z, u0.w), pk2(u1.x, u1.y), pk2(u1.z, u1.w)}; }
      else xin[k] = uint4{0u, 0u, 0u, 0u};
    }
    float4 w[4][2];
#pragma unroll
    for (int k = 0; k < 4; ++k) { w[k][0] = *(const float4*)(cw + k * 512 + f); w[k][1] = *(const float4*)(cw + k * 512 + f + 4); }
    const float4 b0 = *(const float4*)(cb + f), b1 = *(const float4*)(cb + f + 4);
    const int T = pr ? TP : TS;
#pragma unroll
    for (int i = 0; i < NR; ++i) {
      float a[8] = {b0.x, b0.y, b0.z, b0.w, b1.x, b1.y, b1.z, b1.w};
#pragma unroll
      for (int k = 0; k < 4; ++k) { const uint4 v = xin[i + k];
        a[0] += lo2f(v.x) * w[k][0].x; a[1] += hi2f(v.x) * w[k][0].y; a[2] += lo2f(v.y) * w[k][0].z; a[3] += hi2f(v.y) * w[k][0].w;
        a[4] += lo2f(v.z) * w[k][1].x; a[5] += hi2f(v.z) * w[k][1].y; a[6] += lo2f(v.w) * w[k][1].z; a[7] += hi2f(v.w) * w[k][1].w; }
      *(uint4*)(xc + (long)(rw0 + i) * 512 + f) = uint4{pk2(a[0], a[1]), pk2(a[2], a[3]), pk2(a[4], a[5]), pk2(a[6], a[7])};
      const int t = t0 + i;
      if (t >= T - 3) { const uint4 v = xin[i + 3];
        float* so = pr ? p->out + O_PCV + (((long)l * 4 + b) * 3 + (t - (T - 3))) * 512 + f : p->out + O_SCV + (((long)l * 8 + b) * 3 + (t - (T - 3))) * 512 + f;
        *(float4*)so = float4{lo2f(v.x), hi2f(v.x), lo2f(v.y), hi2f(v.y)}; *(float4*)(so + 4) = float4{lo2f(v.z), hi2f(v.z), lo2f(v.w), hi2f(v.w)}; }
    }
  }
  __syncthreads();
  for (int id = tid; id < 128 * NR; id += 512) { const int c = id / NR, rg = id % NR; const int row = r0 + rg * 8;
    uint4 v = *(const uint4*)(tl + c * 72 + rg * 8);
    u16* dbase = (row < MP) ? (u16*)(ws + WS_CKVTP) + ((long)(row >> 12) * 128 + c) * TP : (u16*)(ws + WS_CKVTS) + ((long)((row - MP) >> 4) * 128 + c) * SKP;
    const int key = (row < MP) ? (row & (TP - 1)) : PAST + ((row - MP) & 15);
    *(uint2*)(dbase + kperm(key)) = uint2{v.x, v.y}; *(uint2*)(dbase + kperm(key + 4)) = uint2{v.z, v.w}; }
  __syncthreads();
}
DI void mid_phase(const int TID, KP p, int l) {
  for (int u = blockIdx.x; u < 256 + 16; u += gridDim.x) {
    if (u < 256) mid_unit<8>(TID, p, l, u * 64);
    else mid_unit<1>(TID, p, l, MP + (u - 256) * 8);
  }
}

DI void qlru_phase(const int TID_in, KP p, int l, int vid) {
  const int wv = __builtin_amdgcn_readfirstlane(TID_in >> 6);
  unsigned char* ws = p->ws;
  f32x4 acc[2][2][4][2];
  for (int tile = vid; tile < 64 * 9; tile += gridDim.x) {
    if (tile < 64 * 5) {
      int pm, pn; tile_coords(tile, 64, 5, pm, pn);
      const int brow = pm * 256, bcol = pn * 256;
      gemm_kloop8(fresh_tid(wv), (const u16*)(ws + WS_PROJ) + (long)brow * NPJ + PC_CQ, NPJ, (const u16*)(ws + WS_WQ) + (long)bcol * 256, 256, 4, acc);
      const int TID = fresh_tid(wv);
      GEMM_IDS
      const int oz = opaque_zero(); const int browz = brow + oz;
      u16* qm = (u16*)(ws + WS_QMLA) + oz;
#pragma unroll
      for (int ai = 0; ai < 2; ++ai) {
        ACC_TO_LDS(ai);
        __syncthreads();
        if (pn < 4) {
          EPI_ROWS_BEGIN(ai) *(uint2*)(qm + (long)row * 1280 + col) = pk4(v.x * QM_SCALE, v.y * QM_SCALE, v.z * QM_SCALE, v.w * QM_SCALE); EPI_ROWS_END
        } else {
          const float2* rope = (const float2*)(ws + WS_ROPE) + oz;
#pragma unroll 2
          for (int it = 0; it < 8; ++it) { const int idx = it * 512 + tid; const int rl = idx >> 5, hd = (idx >> 2) & 7, j4 = (idx & 3) * 4;
            const int row = browz + ai * 128 + rl;
            if (row < M) {
              const float* e = (const float*)smem + rl * EP_LD + hd * 32 + j4;
              const float4 x1 = *(const float4*)e, x2 = *(const float4*)(e + 16);
              const float4 c01 = *(const float4*)(rope + row_pos(row) * 16 + j4), c23 = *(const float4*)(rope + row_pos(row) * 16 + j4 + 2);
              u16* q = qm + (long)row * 1280 + 1024 + hd * 32 + j4;
              *(uint2*)q = pk4((x1.x * c01.x - x2.x * c01.y) * QM_SCALE, (x1.y * c01.z - x2.y * c01.w) * QM_SCALE, (x1.z * c23.x - x2.z * c23.y) * QM_SCALE, (x1.w * c23.z - x2.w * c23.w) * QM_SCALE);
              *(uint2*)(q + 16) = pk4((x2.x * c01.x + x1.x * c01.y) * QM_SCALE, (x2.y * c01.z + x1.y * c01.w) * QM_SCALE, (x2.z * c23.x + x1.z * c23.y) * QM_SCALE, (x2.w * c23.z + x1.w * c23.w) * QM_SCALE); } }
        }
        __syncthreads();
      }
    } else {
      int pm, pn; tile_coords(tile - 64 * 5, 64, 4, pm, pn);
      const int brow = pm * 256;
      gemm_kloop8(fresh_tid(wv), (const u16*)(ws + WS_XC) + (long)brow * 512 + (pn >> 1) * 256, 512, (const u16*)(ws + WS_WLRU) + (long)pn * 256 * 256, 256, 4, acc);
      const int TID = fresh_tid(wv);
      GEMM_IDS
      const int oz = opaque_zero(); const int browz = brow + oz;
      const u16* xc = (const u16*)(ws + WS_XC) + oz;
      float* ab = (float*)(ws + WS_A) + oz; float* bb = (float*)(ws + WS_B) + oz;
      const float* ba = p->in[23] + l * 512; const float* bxx = p->in[25] + l * 512; const float* lamb = p->in[26] + l * 512;
#pragma unroll
      for (int ai = 0; ai < 2; ++ai) {
        ACC_TO_LDS(ai);
        __syncthreads();
#pragma unroll 2
        for (int it = 0; it < 8; ++it) { const int idx = it * 512 + tid; const int rl = idx >> 5, f4 = (idx & 31) * 4;
          const int row = browz + ai * 128 + rl;
          if (row < M) {
            const float* e = (const float*)smem + rl * EP_LD + f4;
            const float4 ra = *(const float4*)e, rx = *(const float4*)(e + 128);
            const int f = pn * 128 + f4;
            const float4 lb = *(const float4*)(lamb + f), bav = *(const float4*)(ba + f), bxv = *(const float4*)(bxx + f);
            const uint2 xv = *(const uint2*)(xc + (long)row * 512 + f);
            const bool first = (row < MP) && ((row & (TP - 1)) == 0);
            float av[4], bv[4];
            const float raa[4] = {ra.x, ra.y, ra.z, ra.w}, rxa[4] = {rx.x, rx.y, rx.z, rx.w}, lba[4] = {lb.x, lb.y, lb.z, lb.w};
            const float baa[4] = {bav.x, bav.y, bav.z, bav.w}, bxa[4] = {bxv.x, bxv.y, bxv.z, bxv.w};
            const float xca[4] = {lo2f(xv.x), hi2f(xv.x), lo2f(xv.y), hi2f(xv.y)};
#pragma unroll
            for (int k = 0; k < 4; ++k) { const float nl = -lba[k]; const float sp = softplus_f(nl);
              const float r = sigm(raa[k] + baa[k]), ii = sigm(rxa[k] + bxa[k]); const float la = -8.f * r * sp;
              av[k] = __expf(la); const float mult = first ? 1.f : sqrtf(neg_expm1(2.f * la)); bv[k] = mult * ii * xca[k]; }
            *(float4*)(ab + (long)row * 512 + f) = float4{av[0], av[1], av[2], av[3]};
            *(float4*)(bb + (long)row * 512 + f) = float4{bv[0], bv[1], bv[2], bv[3]}; } }
        __syncthreads();
      }
    }
  }
  const int TID = fresh_tid(wv);
  GEMM_IDS
  for (int it = (int)gridDim.x - 1 - vid; it < 8 * 9; it += gridDim.x) {
    const int rg = it & 7, pn = it >> 3; const int row0 = MP + rg * 16;
    f32x4 c0, c1;
    if (pn < 5) {
      const int bcol = pn * 256;
      sgemm16(lane, (const u16*)(ws + WS_PROJ) + (long)row0 * NPJ + PC_CQ, NPJ, (const u16*)(ws + WS_WQ) + (long)bcol * 256, 256, 256, wid * 32, wid * 32 + 16, c0, c1);
      u16* qm = (u16*)(ws + WS_QMLA);
      if (pn < 4) {
#pragma unroll
        for (int j = 0; j < 4; ++j) { const long row = row0 + fq * 4 + j; qm[row * 1280 + bcol + wid * 32 + fr] = f2bf(c0[j] * QM_SCALE); qm[row * 1280 + bcol + wid * 32 + 16 + fr] = f2bf(c1[j] * QM_SCALE); }
      } else {
        const float2* rope = (const float2*)(ws + WS_ROPE);
#pragma unroll
        for (int j = 0; j < 4; ++j) { const int row = row0 + fq * 4 + j; const float2 cs = rope[row_pos(row) * 16 + fr];
          qm[(long)row * 1280 + 1024 + wid * 32 + fr] = f2bf((c0[j] * cs.x - c1[j] * cs.y) * QM_SCALE);
          qm[(long)row * 1280 + 1024 + wid * 32 + 16 + fr] = f2bf((c1[j] * cs.x + c0[j] * cs.y) * QM_SCALE); }
      }
    } else {
      const int pl = pn - 5;
      const u16* xc = (const u16*)(ws + WS_XC);
      sgemm16(lane, xc + (long)row0 * 512 + (pl >> 1) * 256, 512, (const u16*)(ws + WS_WLRU) + (long)pl * 256 * 256, 256, 256, wid * 16, 128 + wid * 16, c0, c1);
      const int f = pl * 128 + wid * 16 + fr;
      const float nl = -(p->in[26][l * 512 + f]); const float sp = softplus_f(nl);
      const float bav = p->in[23][l * 512 + f], bxv = p->in[25][l * 512 + f];
      float* ab = (float*)(ws + WS_A); float* bb = (float*)(ws + WS_B);
#pragma unroll
      for (int j = 0; j < 4; ++j) { const long row = row0 + fq * 4 + j;
        const float r = sigm(c0[j] + bav), ii = sigm(c1[j] + bxv); const float la = -8.f * r * sp;
        ab[row * 512 + f] = __expf(la); bb[row * 512 + f] = sqrtf(neg_expm1(2.f * la)) * ii * bf2f(xc[row * 512 + f]); }
    }
  }
}

DI void mla_task(const int TID, const u16* __restrict__ qbase, int nq, const u16* __restrict__ kck, const u16* __restrict__ kkr, const u16* __restrict__ vT, int ldv, int nkeys, u16* __restrict__ obase) {
  const int tid = TID, lane = tid & 63, hd = tid >> 6, r = lane & 31, h = lane >> 5;
  const u16* qp = qbase + (long)(r & (nq - 1)) * 1280;
  bf16x8 qf[10];
#pragma unroll
  for (int ks = 0; ks < 8; ++ks) qf[ks] = *(const bf16x8*)(qp + hd * 128 + ks * 16 + h * 8);
#pragma unroll
  for (int ks = 0; ks < 2; ++ks) qf[8 + ks] = *(const bf16x8*)(qp + 1024 + hd * 32 + ks * 16 + h * 8);
  f32x16 O[4];
#pragma unroll
  for (int i = 0; i < 4; ++i)
#pragma unroll
    for (int j = 0; j < 16; ++j) O[i][j] = 0.f;
  float m_run = -1e30f, l_run = 0.f;
  const int nt = (nkeys + 63) >> 6;
  const int wv = __builtin_amdgcn_readfirstlane(hd);
  const char* gp[5]; unsigned ginc[5];
#pragma unroll
  for (int i = 0; i < 5; ++i) {
    int g = wv + 8 * i; if (g > 38) g = 38;
    if (g < 21) { const int o = g * 1024 + lane * 16; const int row = o / 336, wi = o - row * 336;
      if (wi >= 256 && wi < 320) { gp[i] = (const char*)kkr + row * 64 + (wi - 256); ginc[i] = 64 * 64; }
      else { gp[i] = (const char*)kck + row * 256 + (wi < 256 ? wi : 0); ginc[i] = 64 * 256; } }
    else { const int o = (g - 21) * 1024 + lane * 16; const int row = o / 144, wi = o - row * 144;
      gp[i] = (const char*)vT + (long)row * ldv * 2 + (wi < 128 ? wi : 0); ginc[i] = 128; }
  }
#define MLA_ISSUE(buf) do { _Pragma("unroll") for (int i = 0; i < 5; ++i) { int g = wv + 8 * i; if (g > 38) g = 38; \
    __builtin_amdgcn_global_load_lds((const unsigned*)gp[i], (unsigned*)(smem + (buf) * 39936 + g * 1024), 16, 0, 0); gp[i] += ginc[i]; } } while (0)
#define MLA_QK(S, KT, KB) do { bf16x8 kfr[10]; \
    _Pragma("unroll") for (int ks = 0; ks < 10; ++ks) kfr[ks] = *(const bf16x8*)((KT) + ((KB) * 32 + r) * 336 + ks * 32 + h * 16); \
    _Pragma("unroll") for (int ks = 0; ks < 10; ++ks) { \
      if (ks == 0) S = __builtin_amdgcn_mfma_f32_32x32x16_bf16(kfr[ks], qf[ks], negm, 0, 0, 0); else S = __builtin_amdgcn_mfma_f32_32x32x16_bf16(kfr[ks], qf[ks], S, 0, 0, 0); } \
      \
    __builtin_amdgcn_sched_group_barrier(0x100, 5, 0); \
    _Pragma("unroll") for (int i = 0; i < 5; ++i) { __builtin_amdgcn_sched_group_barrier(0x008, 1, 0); __builtin_amdgcn_sched_group_barrier(0x100, 1, 0); } \
    __builtin_amdgcn_sched_group_barrier(0x008, 5, 0); } while (0)
#define MLA_SMPV(S, OTHER, VT, KB, T) do { \
    if (((T) == nt - 1) && (nkeys & 63)) { _Pragma("unroll") for (int j = 0; j < 16; ++j) if ((T) * 64 + (KB) * 32 + crow(j, h) >= nkeys) S[j] = -1e30f; } \
    float mx = S[0]; _Pragma("unroll") for (int j = 1; j < 16; ++j) mx = fmaxf(mx, S[j]); \
    if (first || __builtin_amdgcn_ballot_w64(mx > 8.f) != 0ull) { \
      mx = fmaxf(mx, __shfl_xor(mx, 32)); \
      const float d = first ? mx : fmaxf(mx, 0.f); \
      if (!first) { const float alpha = __builtin_amdgcn_exp2f(-d); l_run *= alpha; \
        _Pragma("unroll") for (int cb = 0; cb < 4; ++cb) _Pragma("unroll") for (int j = 0; j < 16; ++j) O[cb][j] *= alpha; } \
      _Pragma("unroll") for (int j = 0; j < 16; ++j) { S[j] -= d; negm[j] -= d; OTHER[j] -= d; } \
      first = false; } \
    float ls = 0.f; _Pragma("unroll") for (int j = 0; j < 16; ++j) { S[j] = __builtin_amdgcn_exp2f(S[j]); ls += S[j]; } \
    l_run += ls; \
    bf16x8 pk[2]; \
    _Pragma("unroll") for (int s2 = 0; s2 < 2; ++s2) { const uint4 w = uint4{pk2(S[8 * s2], S[8 * s2 + 1]), pk2(S[8 * s2 + 2], S[8 * s2 + 3]), pk2(S[8 * s2 + 4], S[8 * s2 + 5]), pk2(S[8 * s2 + 6], S[8 * s2 + 7])}; pk[s2] = __builtin_bit_cast(bf16x8, w); } \
    bf16x8 vfr[4][2]; \
    _Pragma("unroll") for (int cb = 0; cb < 4; ++cb) _Pragma("unroll") for (int s2 = 0; s2 < 2; ++s2) vfr[cb][s2] = *(const bf16x8*)((VT) + (cb * 32 + r) * 144 + ((KB) * 32 + 16 * s2) * 2 + h * 16); \
    _Pragma("unroll") for (int cb = 0; cb < 4; ++cb) _Pragma("unroll") for (int s2 = 0; s2 < 2; ++s2) O[cb] = __builtin_amdgcn_mfma_f32_32x32x16_bf16(vfr[cb][s2], pk[s2], O[cb], 0, 0, 0); \
    __builtin_amdgcn_sched_group_barrier(0x100, 4, 0); \
    _Pragma("unroll") for (int i = 0; i < 4; ++i) { __builtin_amdgcn_sched_group_barrier(0x008, 1, 0); __builtin_amdgcn_sched_group_barrier(0x100, 1, 0); } \
    __builtin_amdgcn_sched_group_barrier(0x008, 4, 0); } while (0)
  MLA_ISSUE(0);
  if (nt > 1) MLA_ISSUE(1);
  asm volatile("s_waitcnt vmcnt(0)" ::: "memory");
  __builtin_amdgcn_s_barrier();
  f32x16 sA, sB, negm;
#pragma unroll
  for (int j = 0; j < 16; ++j) { negm[j] = 0.f; sB[j] = 0.f; }
  bool first = true;
  MLA_QK(sA, smem, 0);
  int cur = 0;
#pragma unroll 1
  for (int t = 0; t < nt; ++t) {
    const int nx1 = (cur == 2) ? 0 : cur + 1, nx2 = (cur == 0) ? 2 : cur - 1;
    if (t + 2 < nt) MLA_ISSUE(nx2);
    const unsigned char* Kt = smem + cur * 39936; const unsigned char* Vt = Kt + 21504;
    MLA_QK(sB, Kt, 1);
    MLA_SMPV(sA, sB, Vt, 0, t);
    if (t + 1 < nt) MLA_QK(sA, smem + nx1 * 39936, 0);
    MLA_SMPV(sB, sA, Vt, 1, t);
    asm volatile("s_waitcnt vmcnt(0)" ::: "memory");
    asm volatile("s_waitcnt lgkmcnt(0)" ::: "memory");
    __builtin_amdgcn_s_barrier();
    cur = nx1;
  }
  const float lt = l_run + __shfl_xor(l_run, 32); const float inv = 1.f / lt;
  if (r < nq) {
    u16* op = obase + (long)r * 1024 + hd * 128;
#pragma unroll
    for (int cb = 0; cb < 4; ++cb)
#pragma unroll
      for (int g = 0; g < 4; ++g) { uint2 o; o.x = pk2(O[cb][4 * g] * inv, O[cb][4 * g + 1] * inv); o.y = pk2(O[cb][4 * g + 2] * inv, O[cb][4 * g + 3] * inv);
        *(uint2*)(op + cb * 32 + 8 * g + 4 * h) = o; }
  }
}

DI void diff_task(const int TID, const u16* __restrict__ qbase, const u16* __restrict__ zbase, u16* __restrict__ obase, int nq, int qpos0,
                  const u16* __restrict__ kbase, long kstride, const u16* __restrict__ vT, int ldv, int nkeys_total,
                  float lam, float oml, float slope2, const float* __restrict__ subg) {
  const int tid = TID, lane = tid & 63, w = tid >> 6, r = lane & 31, h = lane >> 5;
  const int qw0 = w * 32;
  const bool wactive = qw0 < nq;
  const int qr = (qw0 + r < nq) ? qw0 + r : 0;
  const int wl = (nq - 1) >> 5;
  const int ntmax = (min(nkeys_total, ((qpos0 + wl * 32) / 64 + 1) * 64) + 63) >> 6;
  const int kvis = min(nkeys_total, ((qpos0 + qw0) / 64 + 1) * 64);
  const int ntw = wactive ? ((kvis + 63) >> 6) : 0;
  const u16* qp = qbase + (long)qr * NPJ;
  bf16x8 qf[2][2];
#pragma unroll
  for (int c = 0; c < 2; ++c)
#pragma unroll
    for (int ks = 0; ks < 2; ++ks) qf[c][ks] = *(const bf16x8*)(qp + c * 32 + ks * 16 + h * 8);
  f32x16 O[2][2];
#pragma unroll
  for (int c = 0; c < 2; ++c)
#pragma unroll
    for (int vb = 0; vb < 2; ++vb)
#pragma unroll
      for (int j = 0; j < 16; ++j) O[c][vb][j] = 0.f;
  float m_run[2] = {-1e30f, -1e30f}, l_run[2] = {0.f, 0.f};
  const float qposf = (float)(qpos0 + qw0 + r);
  const float b0q = slope2 * ((float)(4 * h) - qposf);
  const int sr = tid >> 3, sc = tid & 7;
  const unsigned oDK = (unsigned)(sr * (int)kstride * 2 + sc * 16), oDV = (unsigned)(sr * ldv * 2 + sc * 16);
  uint4 g0, g1;
#define DF_GLOAD(t) do { g0 = *(const uint4*)((const char*)(kbase + (long)(t) * 64 * kstride) + oDK); g1 = *(const uint4*)((const char*)(vT + (long)(t) * 64) + oDV); } while (0)
#define DF_LSTORE(s) do { unsigned char* Kt = smem + (s) * 18432; *(uint4*)(Kt + sr * 144 + sc * 16) = g0; *(uint4*)(Kt + 9216 + sr * 144 + sc * 16) = g1; } while (0)
  DF_GLOAD(ntmax - 1); DF_LSTORE((ntmax - 1) & 1);
  __syncthreads();
  for (int t = ntmax - 1; t >= 0; --t) {
    if (t > 0) DF_GLOAD(t - 1);
    if (t < ntw - 1) {
      const unsigned char* Kt = smem + (t & 1) * 18432; const unsigned char* Vt = Kt + 9216;
#pragma unroll 1
      for (int kb = 1; kb >= 0; --kb) {
        bf16x8 vf[2][2];
#pragma unroll
        for (int vb = 0; vb < 2; ++vb)
#pragma unroll
          for (int s2 = 0; s2 < 2; ++s2) vf[vb][s2] = *(const bf16x8*)(Vt + (vb * 32 + r) * 144 + (kb * 32 + 16 * s2) * 2 + h * 16);
        const float dl = slope2 * (float)(t * 64 + kb * 32);
        f32x16 sc[2];
#pragma unroll
        for (int c = 0; c < 2; ++c) { const float u = b0q + dl - m_run[c];
#pragma unroll
          for (int j = 0; j < 16; ++j) sc[c][j] = fmaf(slope2, (float)((j & 3) + 8 * (j >> 2)), u); }
        bf16x8 kfr[2][2];
#pragma unroll
        for (int ks = 0; ks < 2; ++ks)
#pragma unroll
          for (int c = 0; c < 2; ++c) kfr[ks][c] = *(const bf16x8*)(Kt + (kb * 32 + r) * 144 + (c * 32 + ks * 16 + h * 8) * 2);
#pragma unroll
        for (int ks = 0; ks < 2; ++ks)
#pragma unroll
          for (int c = 0; c < 2; ++c) sc[c] = __builtin_amdgcn_mfma_f32_32x32x16_bf16(kfr[ks][c], qf[c][ks], sc[c], 0, 0, 0);
        __builtin_amdgcn_sched_group_barrier(0x100, 8, 0);
        __builtin_amdgcn_sched_group_barrier(0x008, 4, 0);
#pragma unroll
        for (int c = 0; c < 2; ++c) {
          float mx = sc[c][0];
#pragma unroll
          for (int j = 1; j < 16; ++j) mx = fmaxf(mx, sc[c][j]);
          if (__builtin_amdgcn_ballot_w64(mx > 8.f) != 0ull) {
            mx = fmaxf(mx, __shfl_xor(mx, 32));
            const float d = fmaxf(mx, 0.f); const float alpha = __builtin_amdgcn_exp2f(-d); m_run[c] += d; l_run[c] *= alpha;
#pragma unroll
            for (int vb = 0; vb < 2; ++vb)
#pragma unroll
              for (int j = 0; j < 16; ++j) O[c][vb][j] *= alpha;
#pragma unroll
            for (int j = 0; j < 16; ++j) sc[c][j] -= d;
          }
          float ls = 0.f;
#pragma unroll
          for (int j = 0; j < 16; ++j) { sc[c][j] = __builtin_amdgcn_exp2f(sc[c][j]); ls += sc[c][j]; }
          l_run[c] += ls;
#pragma unroll
          for (int s2 = 0; s2 < 2; ++s2) { const uint4 wv = uint4{pk2(sc[c][8 * s2], sc[c][8 * s2 + 1]), pk2(sc[c][8 * s2 + 2], sc[c][8 * s2 + 3]), pk2(sc[c][8 * s2 + 4], sc[c][8 * s2 + 5]), pk2(sc[c][8 * s2 + 6], sc[c][8 * s2 + 7])};
            const bf16x8 pk = __builtin_bit_cast(bf16x8, wv);
#pragma unroll
            for (int vb = 0; vb < 2; ++vb) O[c][vb] = __builtin_amdgcn_mfma_f32_32x32x16_bf16(vf[vb][s2], pk, O[c][vb], 0, 0, 0); }
        }
      }
    } else if (t < ntw) {
      const unsigned char* Kt = smem + (t & 1) * 18432; const unsigned char* Vt = Kt + 9216;
      const bool partial = (t * 64 + 64 > kvis);
#pragma unroll 1
      for (int kb = 1; kb >= 0; --kb) {
        bf16x8 vf[2][2];
#pragma unroll
        for (int vb = 0; vb < 2; ++vb)
#pragma unroll
          for (int s2 = 0; s2 < 2; ++s2) vf[vb][s2] = *(const bf16x8*)(Vt + (vb * 32 + r) * 144 + (kb * 32 + 16 * s2) * 2 + h * 16);
        const float kb0 = (float)(t * 64 + kb * 32 + 4 * h) - qposf;
#pragma unroll
        for (int c = 0; c < 2; ++c) {
          f32x16 s;
#pragma unroll
          for (int j = 0; j < 16; ++j) s[j] = 0.f;
#pragma unroll
          for (int ks = 0; ks < 2; ++ks) { bf16x8 a = *(const bf16x8*)(Kt + (kb * 32 + r) * 144 + (c * 32 + ks * 16 + h * 8) * 2); s = __builtin_amdgcn_mfma_f32_32x32x16_bf16(a, qf[c][ks], s, 0, 0, 0); }
#pragma unroll
          for (int j = 0; j < 16; ++j) { const float dk = kb0 + (float)((j & 3) + 8 * (j >> 2)); s[j] = fmaf(-slope2, fabsf(dk), s[j]); }
          if (partial) {
#pragma unroll
            for (int j = 0; j < 16; ++j) if (t * 64 + kb * 32 + crow(j, h) >= kvis) s[j] = -1e30f; }
          float mx = s[0];
#pragma unroll
          for (int j = 1; j < 16; ++j) mx = fmaxf(mx, s[j]);
          if (__builtin_amdgcn_ballot_w64(mx > m_run[c] + 8.f) != 0ull) {
            mx = fmaxf(mx, __shfl_xor(mx, 32));
            const float m_new = fmaxf(m_run[c], mx); const float alpha = __builtin_amdgcn_exp2f(m_run[c] - m_new); m_run[c] = m_new;
            l_run[c] *= alpha;
#pragma unroll
            for (int vb = 0; vb < 2; ++vb)
#pragma unroll
              for (int j = 0; j < 16; ++j) O[c][vb][j] *= alpha;
          }
          float ls = 0.f;
#pragma unroll
          for (int j = 0; j < 16; ++j) { s[j] = __builtin_amdgcn_exp2f(s[j] - m_run[c]); ls += s[j]; }
          l_run[c] += ls;
#pragma unroll
          for (int s2 = 0; s2 < 2; ++s2) { u32 w0 = pk2(s[8 * s2], s[8 * s2 + 1]), w1 = pk2(s[8 * s2 + 2], s[8 * s2 + 3]), w2 = pk2(s[8 * s2 + 4], s[8 * s2 + 5]), w3 = pk2(s[8 * s2 + 6], s[8 * s2 + 7]);
            uint4 wv = uint4{w0, w1, w2, w3}; bf16x8 pk = __builtin_bit_cast(bf16x8, wv);
#pragma unroll
            for (int vb = 0; vb < 2; ++vb) O[c][vb] = __builtin_amdgcn_mfma_f32_32x32x16_bf16(vf[vb][s2], pk, O[c][vb], 0, 0, 0); }
          __builtin_amdgcn_sched_barrier(0);
        }
      }
    }
    if (t > 0) DF_LSTORE((t - 1) & 1);
    __syncthreads();
  }
  if (wactive) {
    const float i0 = 1.f / (l_run[0] + __shfl_xor(l_run[0], 32)); const float i1 = lam / (l_run[1] + __shfl_xor(l_run[1], 32));
    float ss = 0.f;
#pragma unroll
    for (int vb = 0; vb < 2; ++vb)
#pragma unroll
      for (int j = 0; j < 16; ++j) { float o = O[0][vb][j] * i0 - O[1][vb][j] * i1; O[0][vb][j] = o; ss += o * o; }
    ss += __shfl_xor(ss, 32);
    const float rsd = rsqrtf(ss * (1.f / 64) + EPS) * oml;
    if (qw0 + r < nq) {
      const u16* zp = zbase + (long)(qw0 + r) * NPJ; u16* op = obase + (long)(qw0 + r) * NPJ;
#pragma unroll
      for (int vb = 0; vb < 2; ++vb)
#pragma unroll
        for (int g = 0; g < 4; ++g) { const int v0 = vb * 32 + 8 * g + 4 * h;
          uint2 z = *(const uint2*)(zp + v0); float4 gg = *(const float4*)(subg + v0);
          float y0 = O[0][vb][4 * g] * rsd * gg.x * silu(lo2f(z.x)), y1 = O[0][vb][4 * g + 1] * rsd * gg.y * silu(hi2f(z.x));
          float y2 = O[0][vb][4 * g + 2] * rsd * gg.z * silu(lo2f(z.y)), y3 = O[0][vb][4 * g + 3] * rsd * gg.w * silu(hi2f(z.y));
          uint2 o; o.x = pk2(y0, y1); o.y = pk2(y2, y3); *(uint2*)(op + v0) = o; }
    }
  }
}

DI void attn_phase(const int TID, KP p, int l, unsigned* ctr) {
  unsigned char* ws = p->ws;
  u16* proj = (u16*)(ws + WS_PROJ);
  const u16* qm = (const u16*)(ws + WS_QMLA);
  u16* olat = (u16*)(ws + WS_XN);
  const float* sc = (const float*)(ws + WS_CTL + 1024);
  const float* subg = p->in[19] + l * 64;
  volatile int* s_task = (volatile int*)(smem + TASK_OFF);
  for (;;) {
    int tid = TID; asm volatile("" : "+v"(tid));
    if (tid == 0) *s_task = (int)atomicAdd(ctr, 1u);
    __syncthreads();
    const int ti = *s_task;
    __syncthreads();
    if (ti >= g_tab.n) break;
    const u32 e = g_tab.t[ti]; const int ty = e >> 16, idx = e & 0xffff;
    if (ty == 0 || ty == 2) {
      const bool pr = (ty == 0);
      const int j = idx >> 5, b = pr ? ((idx >> 3) & 3) : (idx >> 3), hh = idx & 7;
      const long row0 = pr ? (long)b * TP + j * 256 : (long)MP + b * 16;
      const u16* kb = pr ? proj + (long)b * TP * NPJ + PC_KD + hh * 64 : (const u16*)(ws + WS_KDS) + (long)b * SKP * 512 + hh * 64;
      const u16* vt = pr ? (const u16*)(ws + WS_VDTP) + ((long)b * 512 + hh * 64) * TP : (const u16*)(ws + WS_VDTS) + ((long)b * 512 + hh * 64) * SKP;
      const float lam = sc[l * 2], oml = 1.f - sc[l * 2 + 1];
      for (int rep = 0; rep < REP_DIFF; ++rep) {
        diff_task(tid, proj + row0 * NPJ + PC_QD + hh * 64, proj + row0 * NPJ + PC_ZD + hh * 64, proj + row0 * NPJ + PC_VD + hh * 64, pr ? 256 : 16, pr ? j * 256 : PAST,
                kb, pr ? (long)NPJ : 512L, vt, pr ? TP : SKP, pr ? TP : SK, lam, oml, LOG2E * exp2f(-(float)(hh + 1)), subg);
        __syncthreads(); }
    } else if (ty == 1 || ty == 3) {
      const bool pr = (ty == 1);
      const int q32 = idx >> 2, b = pr ? (idx & 3) : idx;
      const long row0 = pr ? (long)b * TP + q32 * 32 : (long)MP + b * 16;
      const u16* kc = pr ? (const u16*)(ws + WS_CKVP) + (long)b * TP * 128 : (const u16*)(ws + WS_CKVS) + (long)b * SKP * 128;
      const u16* kr = pr ? (const u16*)(ws + WS_KRP) + (long)b * TP * 32 : (const u16*)(ws + WS_KRS) + (long)b * SKP * 32;
      const u16* vt = pr ? (const u16*)(ws + WS_CKVTP) + (long)b * 128 * TP : (const u16*)(ws + WS_CKVTS) + (long)b * 128 * SKP;
      for (int rep = 0; rep < REP_MLA; ++rep) {
        mla_task(tid, qm + row0 * 1280, pr ? 32 : 16, kc, kr, vt, pr ? TP : SKP, pr ? (q32 / 2 + 1) * 64 : SK, olat + row0 * 1024);
        __syncthreads(); }
    } else {
      const int b = idx >> 6, c = idx & 63; const long row0 = (long)b * TP + c * 64;
      const float* ab = (const float*)(ws + WS_A) + row0 * 512 + tid; const float* bb = (const float*)(ws + WS_B) + row0 * 512 + tid;
      float A = 1.f, B = 0.f;
#pragma unroll 16
      for (int i = 0; i < 64; ++i) { float a = ab[i * 512], x = bb[i * 512]; B = a * B + x; A *= a; }
      ((float2*)(ws + WS_SCAN))[(long)idx * 512 + tid] = float2{A, B};
    }
    __syncthreads();
  }
}

DI void uvscan_phase(const int TID_in, KP p, int l, int vid) {
  const int wv = __builtin_amdgcn_readfirstlane(TID_in >> 6);
  unsigned char* ws = p->ws;
  u16* proj = (u16*)(ws + WS_PROJ);
  f32x4 acc[2][2][4][2];
  for (int it = vid; it < 64 * 2 + 258 + 16; it += gridDim.x) {
    if (it < 64 * 2) {
      int pm, pn; tile_coords(it, 64, 2, pm, pn);
      const int brow = pm * 256, bcol = pn * 256;
      gemm_kloop8(fresh_tid(wv), (const u16*)(ws + WS_XN) + (long)brow * 1024 + pn * 512, 1024, (const u16*)(ws + WS_WUV) + (long)bcol * 512, 512, 8, acc);
      const int TID = fresh_tid(wv);
      GEMM_IDS
      const int oz = opaque_zero(); const int browz = brow + oz;
      u16* pz = proj + oz;
#pragma unroll
      for (int ai = 0; ai < 2; ++ai) {
        ACC_TO_LDS(ai);
        __syncthreads();
        EPI_ROWS_BEGIN(ai)
          u16* q = pz + (long)row * NPJ + PC_ZMLA + col; const uint2 z = *(const uint2*)q;
          *(uint2*)(q + (PC_QD - PC_ZMLA)) = pk4(v.x * silu(lo2f(z.x)), v.y * silu(hi2f(z.x)), v.z * silu(lo2f(z.y)), v.w * silu(hi2f(z.y)));
        EPI_ROWS_END
        __syncthreads();
      }
    } else {
      const int TID = fresh_tid(wv);
      GEMM_IDS
      const int s = it - 64 * 2;
      if (s >= 258) {
        const int q = s - 258; const int rg = q & 7, pn = q >> 3; const int row0 = MP + rg * 16, bcol = pn * 256;
        f32x4 c0, c1;
        sgemm16(lane, (const u16*)(ws + WS_XN) + (long)row0 * 1024 + pn * 512, 1024, (const u16*)(ws + WS_WUV) + (long)bcol * 512, 512, 512, wid * 32, wid * 32 + 16, c0, c1);
#pragma unroll
        for (int j = 0; j < 4; ++j) { const long row = row0 + fq * 4 + j; u16* q0 = proj + row * NPJ + PC_ZMLA + bcol + wid * 32 + fr;
          q0[PC_QD - PC_ZMLA] = f2bf(c0[j] * silu(bf2f(q0[0]))); q0[PC_QD - PC_ZMLA + 16] = f2bf(c1[j] * silu(bf2f(q0[16]))); }
        continue;
      }
      float hh; long row0; int nsteps; float* hout;
      if (s < 256) { const int b = s >> 6, c = s & 63; row0 = (long)b * TP + c * 64; nsteps = 64; hh = 0.f;
        const float2* sm = (const float2*)(ws + WS_SCAN) + (long)(b * 64) * 512 + tid;
        { int cc = 0;
          for (; cc + 16 <= c; cc += 16) { float2 t[16];
#pragma unroll
            for (int q = 0; q < 16; ++q) t[q] = sm[(long)(cc + q) * 512];
#pragma unroll
            for (int q = 0; q < 16; ++q) hh = t[q].x * hh + t[q].y; }
          for (; cc < c; ++cc) { float2 ab2 = sm[(long)cc * 512]; hh = ab2.x * hh + ab2.y; } }
        hout = (c == 63) ? p->out + O_PH + ((long)l * 4 + b) * 512 + tid : nullptr;
      } else { const int sb = (s - 256) * 4 + 0; (void)sb; row0 = 0; nsteps = 0; hh = 0.f; hout = nullptr; }
      if (s < 256) {
        const float* ab = (const float*)(ws + WS_A) + row0 * 512 + tid; const float* bb = (const float*)(ws + WS_B) + row0 * 512 + tid;
        u16* zp = proj + row0 * NPJ + PC_ZL + tid;
#pragma unroll 16
        for (int i = 0; i < nsteps; ++i) { float a = ab[(long)i * 512], x = bb[(long)i * 512]; float z = bf2f(zp[(long)i * NPJ]); hh = a * hh + x; zp[(long)i * NPJ + (PC_KD - PC_ZL)] = f2bf(hh * silu(z)); }
        if (hout) *hout = hh;
      } else {
        for (int q = 0; q < 4; ++q) { const int sb = (s - 256) * 4 + q; const long r0 = MP + sb * 16;
          float h2 = p->in[6][((long)l * 8 + sb) * 512 + tid];
          const float* ab = (const float*)(ws + WS_A) + r0 * 512 + tid; const float* bb = (const float*)(ws + WS_B) + r0 * 512 + tid;
          u16* zp = proj + r0 * NPJ + PC_ZL + tid;
#pragma unroll 16
          for (int i = 0; i < 16; ++i) { float a = ab[(long)i * 512], x = bb[(long)i * 512]; float z = bf2f(zp[(long)i * NPJ]); h2 = a * h2 + x; zp[(long)i * NPJ + (PC_KD - PC_ZL)] = f2bf(h2 * silu(z)); }
          p->out[O_SH + ((long)l * 8 + sb) * 512 + tid] = h2; }
      }
    }
  }
}

DI void oproj_phase(const int TID, KP p, int l, int vid) {
  GEMM_IDS
  unsigned char* ws = p->ws;
  f32x4 acc[1][2][4][2];
  for (int tile = vid; tile < 128 * 4; tile += gridDim.x) {
    int pm, pn; tile_coords(tile, 128, 4, pm, pn);
    const int brow = pm * 128, bcol = pn * 256;
    float4 mreg[16];
#pragma unroll
    for (int i = 0; i < 16; ++i) mreg[i] = float4{0.f, 0.f, 0.f, 0.f};
#pragma unroll 1
    for (int b = 0; b < 3; ++b) {
      const int acol = (b == 0) ? PC_QD : (b == 1) ? PC_VD : PC_KD;
      gemm_kloop_r3(TID, (const u16*)(ws + WS_PROJ) + (long)brow * NPJ + acol, NPJ, (const u16*)(ws + WS_WO) + ((long)b * 1024 + bcol) * 512, 512, 8, acc);
      const int oz = opaque_zero(); const int browz = brow + oz;
      const u16* gp = (const u16*)(ws + WS_PROJ) + oz + PC_G + b * 1024 + bcol;
      ACC_TO_LDS(0);
      __syncthreads();
#pragma unroll
      for (int it = 0; it < 16; ++it) { const int idx = it * 512 + tid; const int rl = idx >> 6, cl = (idx & 63) * 4;
        const float4 v = *(const float4*)((const float*)smem + rl * EP_LD + cl);
        const uint2 g = *(const uint2*)(gp + (long)(browz + rl) * NPJ + cl);
        mreg[it].x += lo2f(g.x) * v.x; mreg[it].y += hi2f(g.x) * v.y; mreg[it].z += lo2f(g.y) * v.z; mreg[it].w += hi2f(g.y) * v.w; }
      __syncthreads();
    }
    { const int oz = opaque_zero(); u16* mg = (u16*)(ws + WS_XN) + oz;
#pragma unroll
      for (int it = 0; it < 16; ++it) { const int idx = it * 512 + tid; const int rl = idx >> 6, cl = (idx & 63) * 4;
        *(uint2*)(mg + (long)(brow + rl) * 1024 + bcol + cl) = pk4(mreg[it].x, mreg[it].y, mreg[it].z, mreg[it].w); } }
  }
  for (int it = (int)gridDim.x - 1 - vid; it < 8 * 4; it += gridDim.x) {
    const int rg = it & 7, pn = it >> 3; const int row0 = MP + rg * 16, bcol = pn * 256;
    const u16* proj = (const u16*)(ws + WS_PROJ); u16* mg = (u16*)(ws + WS_XN);
    float m0[4] = {0.f, 0.f, 0.f, 0.f}, m1[4] = {0.f, 0.f, 0.f, 0.f};
#pragma unroll 1
    for (int b = 0; b < 3; ++b) {
      const int acol = (b == 0) ? PC_QD : (b == 1) ? PC_VD : PC_KD;
      f32x4 c0, c1;
      sgemm16(lane, proj + (long)row0 * NPJ + acol, NPJ, (const u16*)(ws + WS_WO) + ((long)b * 1024 + bcol) * 512, 512, 512, wid * 32, wid * 32 + 16, c0, c1);
#pragma unroll
      for (int j = 0; j < 4; ++j) { const long row = row0 + fq * 4 + j; const u16* g = proj + row * NPJ + PC_G + b * 1024 + bcol + wid * 32 + fr;
        m0[j] += bf2f(g[0]) * c0[j]; m1[j] += bf2f(g[16]) * c1[j]; }
    }
#pragma unroll
    for (int j = 0; j < 4; ++j) { const long row = row0 + fq * 4 + j; u16* q = mg + row * 1024 + bcol + wid * 32 + fr; q[0] = f2bf(m0[j]); q[16] = f2bf(m1[j]); }
  }
}

DI void wout_phase(const int TID_in, KP p, int l, int vid, float* outp) {
  const int wv = __builtin_amdgcn_readfirstlane(TID_in >> 6);
  unsigned char* ws = p->ws;
  f32x4 acc[2][2][4][2];
  for (int tile = vid; tile < 64 * 4; tile += gridDim.x) {
    int pm, pn; tile_coords(tile, 64, 4, pm, pn);
    const int brow = pm * 256, bcol = pn * 256;
    gemm_kloop8(fresh_tid(wv), (const u16*)(ws + WS_XN) + (long)brow * 1024, 1024, (const u16*)(ws + WS_WOUT) + (long)bcol * 1024, 1024, 16, acc);
    const int TID = fresh_tid(wv);
    GEMM_IDS
    const int oz = opaque_zero(); const int browz = brow + oz;
    float* out = outp + oz;
#pragma unroll
    for (int ai = 0; ai < 2; ++ai) {
      ACC_TO_LDS(ai);
      __syncthreads();
      EPI_ROWS_BEGIN(ai)
        if (row < M) { const float4 xo = (l == 0) ? (row < MP ? *(const float4*)(p->in[0] + (long)row * D + col) : *(const float4*)(p->in[1] + (long)(row - MP) * D + col)) : *(const float4*)(out + (long)row * D + col);
          *(float4*)(out + (long)row * D + col) = float4{xo.x + v.x, xo.y + v.y, xo.z + v.z, xo.w + v.w}; }
      EPI_ROWS_END
      __syncthreads();
    }
  }
  const int TID = fresh_tid(wv);
  GEMM_IDS
  for (int it = (int)gridDim.x - 1 - vid; it < 8 * 4; it += gridDim.x) {
    const int rg = it & 7, pn = it >> 3; const int row0 = MP + rg * 16, bcol = pn * 256;
    f32x4 c0, c1;
    sgemm16(lane, (const u16*)(ws + WS_XN) + (long)row0 * 1024, 1024, (const u16*)(ws + WS_WOUT) + (long)bcol * 1024, 1024, 1024, wid * 32, wid * 32 + 16, c0, c1);
#pragma unroll
    for (int j = 0; j < 4; ++j) { const int row = row0 + fq * 4 + j; const int col = bcol + wid * 32 + fr;
      const float* xo = (l == 0) ? p->in[1] + (long)(row - MP) * D + col : outp + (long)row * D + col;
      const float x0 = xo[0], x1 = xo[16];
      outp[(long)row * D + col] = x0 + c0[j]; outp[(long)row * D + col + 16] = x1 + c1[j]; }
  }
}

DI void final_phase(const int TID, KP p) {
  const int lane = TID & 63, wid = TID >> 6;
  const float* g = p->in[31];
  for (int row = blockIdx.x * 8 + wid; row < M; row += gridDim.x * 8) {
    float* src = p->out + (long)row * D;
    float4 v[4]; float ss = 0.f;
#pragma unroll
    for (int i = 0; i < 4; ++i) { v[i] = *(const float4*)(src + i * 256 + lane * 4); ss += v[i].x * v[i].x + v[i].y * v[i].y + v[i].z * v[i].z + v[i].w * v[i].w; }
    ss = wsum(ss); const float rs = rsqrtf(ss * (1.f / D) + EPS);
#pragma unroll
    for (int i = 0; i < 4; ++i) { float4 gg = *(const float4*)(g + i * 256 + lane * 4);
      *(float4*)(src + i * 256 + lane * 4) = float4{v[i].x * rs * gg.x, v[i].y * rs * gg.y, v[i].z * rs * gg.z, v[i].w * rs * gg.w}; }
  }
}


#define XB_TMO      128
#define XB_XCNT(j)  (256  + 64 * (j))
#define XB_XSUB(j)  (1280 + 64 * (j))
#define XB_XGEN(j)  (2304 + 64 * (j))
#define XB_TOP      3328
#define XB_TOPGEN   3392
#define XCD_BAR_WORDS 3456
#define XB_SPIN_CAP (1u << 22)
#define LAS __attribute__((address_space(3)))
DI unsigned xb_ld(unsigned* p) { return __hip_atomic_load(p, __ATOMIC_RELAXED, __HIP_MEMORY_SCOPE_AGENT); }
DI unsigned xb_add(unsigned* p, unsigned v) { return __hip_atomic_fetch_add(p, v, __ATOMIC_RELAXED, __HIP_MEMORY_SCOPE_AGENT); }
DI unsigned xb_xcc_id() { return (unsigned)__builtin_amdgcn_s_getreg((3 << 11) | 20) & 0xFu; }
#define XB_SPIN(cond, bar) do { unsigned _sp = 0; while (cond) { __builtin_amdgcn_s_sleep(1); \
    if ((++_sp & 255u) == 0u) { if (xb_ld(&(bar)[XB_TMO])) break; if (_sp > XB_SPIN_CAP) { atomicAdd(&(bar)[XB_TMO], 1u); break; } } } } while (0)
DI void xcd_barrier_complete(unsigned* bar, unsigned x, unsigned& nloc, unsigned& nx) {
  const unsigned G = gridDim.x;
  unsigned sum, cnt, mine, sp = 0u;
  for (;;) {
    sum = 0u; cnt = 0u; mine = 0u;
#pragma unroll
    for (unsigned j = 0; j < 16; ++j) { const unsigned c = xb_ld(&bar[XB_XCNT(j)]); sum += c; cnt += (c > 0u) ? 1u : 0u; mine = (j == x) ? c : mine; }
    if (sum == G) break;
    __builtin_amdgcn_s_sleep(1);
    if ((++sp & 255u) == 0u) { if (xb_ld(&bar[XB_TMO])) break; if (sp > XB_SPIN_CAP) { atomicAdd(&bar[XB_TMO], 1u); break; } }
  }
  nloc = mine > 0u ? mine : 1u; nx = cnt > 0u ? cnt : 1u;
}
DI void xcd_barrier(const int TID, unsigned* bar, unsigned x) {
  volatile LAS unsigned* st = (volatile LAS unsigned*)(smem + TASK_OFF + 16);
  asm volatile("s_waitcnt vmcnt(0)" ::: "memory");
  __syncthreads();
  if (TID == 0) {
    __builtin_amdgcn_s_waitcnt(0);
    unsigned nloc = st[0], nx = st[1];
    if (nloc == 0u) { xcd_barrier_complete(bar, x, nloc, nx); st[0] = nloc; st[1] = nx; }
    const unsigned old = xb_add(&bar[XB_XSUB(x)], 1u);
    const unsigned gen = old / nloc;
    if (old + 1u == (gen + 1u) * nloc) {
      __builtin_amdgcn_fence(__ATOMIC_RELEASE, "agent");
      asm volatile("s_waitcnt vmcnt(0)" ::: "memory");
      const unsigned og = xb_add(&bar[XB_TOP], 1u);
      const unsigned tg = og / nx;
      if (og + 1u == (tg + 1u) * nx) xb_add(&bar[XB_TOPGEN], 1u);
      else XB_SPIN(xb_ld(&bar[XB_TOPGEN]) == tg, bar);
      __builtin_amdgcn_fence(__ATOMIC_ACQUIRE, "agent");
      xb_add(&bar[XB_XGEN(x)], 1u);
      asm volatile("s_waitcnt vmcnt(0)" ::: "memory");
    } else {
      XB_SPIN(xb_ld(&bar[XB_XGEN(x)]) == gen, bar);
      __builtin_amdgcn_fence(__ATOMIC_ACQUIRE, "agent");
      asm volatile("s_waitcnt vmcnt(0)" ::: "memory");
    }
  }
  __syncthreads();
}

__global__ void __launch_bounds__(512, 2) mega(Params p_) {
  const int wave_s = __builtin_amdgcn_readfirstlane((int)(__builtin_amdgcn_workitem_id_x() >> 6));
  const int G = gridDim.x, bx = blockIdx.x;
  const int vid = (G % 8 == 0) ? (bx % 8) * (G / 8) + bx / 8 : bx;
  const int ph_lo = p_.ph_lo, ph_hi = p_.ph_hi;
  const unsigned xcc = xb_xcc_id();
  { const int t0 = __builtin_amdgcn_workitem_id_x(); if (t0 < 4) ((volatile LAS unsigned*)(smem + TASK_OFF))[4 + t0] = 0u; __syncthreads();
    if (t0 == 0) (void)xb_add((unsigned*)(p_.ws + WS_BAR) + XB_XCNT(xcc), 1u); }
  if (ph_hi - ph_lo > 1) cg::this_grid().sync();
  for (int ph = ph_lo; ph < ph_hi; ++ph) {
    int TID; asm volatile("v_mbcnt_lo_u32_b32 %0, -1, 0\n\tv_mbcnt_hi_u32_b32 %0, -1, %0" : "=v"(TID)); TID += wave_s * 64;
    KP p = (KP)__builtin_amdgcn_kernarg_segment_ptr(); asm volatile("" : "+s"(p));
    unsigned* ctrs = (unsigned*)(p->ws + WS_CTL);
    if (ph == NPH - 1) final_phase(TID, p);
    else {
      const int l = ph >> 3, s = ph & 7;
      switch (s) {
        case 0: for (int rep = 0; rep < REP_PREP; ++rep) { prep_phase(TID, p, l); __syncthreads(); } break;
        case 1: for (int rep = 0; rep < REP_INPROJ; ++rep) { inproj_phase(TID, p, l, vid); __syncthreads(); } break;
        case 2: mid_phase(TID, p, l); break;
        case 3: for (int rep = 0; rep < REP_QLRU; ++rep) { qlru_phase(TID, p, l, vid); __syncthreads(); } break;
        case 4: for (int rep = 0; rep < REP_ATTN; ++rep) { attn_phase(TID, p, l, ctrs + ph + 64 * rep); __syncthreads(); } break;
        case 5: for (int rep = 0; rep < REP_UVSCAN; ++rep) { uvscan_phase(TID, p, l, vid); __syncthreads(); } break;
        case 6: for (int rep = 0; rep < REP_OPROJ; ++rep) { oproj_phase(TID, p, l, vid); __syncthreads(); } break;
        default: wout_phase(TID, p, l, vid, p->out); break;
      }
    }
    if (TAIL_PHASE >= 0 && ph == NPH - 1) {
      for (int rep = 0; rep < TAIL_REPS; ++rep) {
        xcd_barrier(TID, (unsigned*)(p->ws + WS_BAR), xcc);
        if (TAIL_PHASE == 2) mid_phase(TID, p, 3);
        else if (TAIL_PHASE == 7) wout_phase(TID, p, 3, vid, (float*)(p->ws + WS_PROJ));
        else if (TAIL_PHASE == 1) inproj_phase(TID, p, 3, vid);
        else if (TAIL_PHASE == 6) oproj_phase(TID, p, 3, vid);
        else if (TAIL_PHASE == 8) final_phase(TID, p);
        __syncthreads();
      }
    }
    if (ph + 1 < ph_hi) {
      xcd_barrier(TID, (unsigned*)(p->ws + WS_BAR), xcc);
      for (int e = 0; e < EXTRA_SYNC; ++e) xcd_barrier(TID, (unsigned*)(p->ws + WS_BAR), xcc);
    }
  }
}

extern "C" void kernel_launch(void* const* d_in, const int* in_sizes, int n_in, void* d_out, int out_size, void* d_ws, size_t ws_size, hipStream_t stream) {
  static int grid = 0;
  if (grid == 0) {
    if (n_in != 32 || (long)out_size != O_END || ws_size < WS_END) { fprintf(stderr, "kernel_launch: unexpected shapes (n_in %d out %d ws %zu need %zu)\n", n_in, out_size, ws_size, (size_t)WS_END); grid = -1; return; }
    int dev = 0, cus = 0, per_cu = 0;
    (void)hipGetDevice(&dev); (void)hipDeviceGetAttribute(&cus, hipDeviceAttributeMultiprocessorCount, dev);
    if (hipFuncSetAttribute((const void*)mega, hipFuncAttributeMaxDynamicSharedMemorySize, LDS_BYTES) != hipSuccess) { fprintf(stderr, "hipFuncSetAttribute failed\n"); grid = -1; return; }
    if (hipOccupancyMaxActiveBlocksPerMultiprocessor(&per_cu, (const void*)mega, 512, LDS_BYTES) != hipSuccess || per_cu < 1) { fprintf(stderr, "occupancy query failed (%d)\n", per_cu); per_cu = 1; }
    (void)hipGetLastError();
    grid = cus;
  }
  if (grid < 0) return;
  (void)hipMemsetAsync((char*)d_ws + WS_CTL, 0, WS_ROPE, stream);
  Params p{};
  for (int i = 0; i < 32; ++i) p.in[i] = (const float*)d_in[i];
  p.out = (float*)d_out; p.ws = (unsigned char*)d_ws;
#if ONE_LAUNCH
  p.ph_lo = 0; p.ph_hi = NPH;
  void* args[] = {&p};
  hipError_t e = hipLaunchCooperativeKernel((const void*)mega, dim3(grid), dim3(512), args, LDS_BYTES, stream);
  if (e != hipSuccess) fprintf(stderr, "cooperative launch failed: %s\n", hipGetErrorString(e));
#else
  for (int ph = 0; ph < NPH; ++ph) { p.ph_lo = ph; p.ph_hi = ph + 1; hipLaunchKernelGGL(mega, dim3(grid), dim3(512), LDS_BYTES, stream, p); }
#endif
}
```

```cpp
#include <hip/hip_runtime.h>
#include <hip/hip_cooperative_groups.h>
#include <cstdio>
namespace cg = cooperative_groups;

#ifndef ONE_LAUNCH
#define ONE_LAUNCH 1
#endif
#define REP_PREP 1
#define REP_INPROJ 1
#define REP_QLRU 1
#define REP_ATTN 1
#define REP_OPROJ 1
#define REP_UVSCAN 1
#define TAIL_PHASE -1
#define TAIL_REPS 4
#define REP_MLA 1
#define REP_DIFF 1
#define EXTRA_SYNC 0

typedef unsigned short u16;
typedef unsigned int u32;
using bf16x8 = __attribute__((ext_vector_type(8))) short;
using s16x4  = __attribute__((ext_vector_type(4))) short;
using f32x4  = __attribute__((ext_vector_type(4))) float;
using f32x16 = __attribute__((ext_vector_type(16))) float;
typedef float f32x2 __attribute__((ext_vector_type(2)));
typedef __bf16 bf16x2 __attribute__((ext_vector_type(2)));
#define DI __device__ __forceinline__

constexpr int D = 1024, TP = 4096, MP = 16384, TS = 16, MS = 128, M = MP + MS, MT = 65, MPAD = MT * 256;
constexpr int PAST = 2048, SK = PAST + TS, SKP = 2112;
constexpr int NIN = 7072, NPJ = 7168, DEPTH = 4;
constexpr float EPS = 1e-6f;
constexpr float LOG2E = 1.4426950408889634f;
constexpr float QM_SCALE = 0.10206207261596575f * LOG2E;
constexpr float QD_SCALE = 0.17677669529663687f * LOG2E;
constexpr int PC_CQ = 0, PC_CKV = 256, PC_KR = 384, PC_ZMLA = 512, PC_QD = 1024, PC_KD = 1536, PC_VD = 2048, PC_ZD = 2560,
              PC_XL = 3072, PC_ZL = 3584, PC_G = 4096;
constexpr long O_YP = 0, O_YS = O_YP + (long)MP * D, O_PCKV = O_YS + (long)MS * D, O_PKR = O_PCKV + 4L * MP * 128,
               O_PDK = O_PKR + 4L * MP * 32, O_PDV = O_PDK + 4L * MP * 512, O_PH = O_PDV + 4L * MP * 512, O_PCV = O_PH + 4L * 4 * 512,
               O_SCKV = O_PCV + 4L * 4 * 3 * 512, O_SKR = O_SCKV + 4L * MS * 128, O_SDK = O_SKR + 4L * MS * 32, O_SDV = O_SDK + 4L * MS * 512,
               O_SH = O_SDV + 4L * MS * 512, O_SCV = O_SH + 4L * 8 * 512, O_END = O_SCV + 4L * 8 * 3 * 512;
constexpr size_t al(size_t x) { return (x + 255) & ~(size_t)255; }
constexpr size_t WS_CTL = 0, WS_BAR = 4096, WS_ROPE = 20480, WS_WIN = WS_ROPE + al(4096 * 16 * 8), WS_WQ = WS_WIN + al((size_t)NPJ * 1024 * 2),
                 WS_WUV = WS_WQ + al(1280 * 256 * 2), WS_WO = WS_WUV + al(512 * 512 * 2), WS_WOUT = WS_WO + al(3 * 1024 * 512 * 2),
                 WS_WLRU = WS_WOUT + al(1024 * 1024 * 2), WS_XN = WS_WLRU + al(1024 * 256 * 2), WS_PROJ = WS_XN + al((size_t)MPAD * 1024 * 2),
                 WS_QMLA = WS_PROJ + al((size_t)MPAD * NPJ * 2), WS_XC = WS_QMLA + al((size_t)MPAD * 1280 * 2), WS_A = WS_XC + al((size_t)MPAD * 512 * 2),
                 WS_B = WS_A + al((size_t)M * 512 * 4), WS_SCAN = WS_B + al((size_t)M * 512 * 4), WS_CKVP = WS_SCAN + al(4 * 64 * 512 * 8),
                 WS_CKVTP = WS_CKVP + al((size_t)MP * 128 * 2), WS_KRP = WS_CKVTP + al((size_t)MP * 128 * 2), WS_VDTP = WS_KRP + al((size_t)MP * 32 * 2),
                 WS_CKVS = WS_VDTP + al((size_t)MP * 512 * 2), WS_CKVTS = WS_CKVS + al(8 * SKP * 128 * 2), WS_KRS = WS_CKVTS + al(8 * SKP * 128 * 2),
                 WS_KDS = WS_KRS + al(8 * SKP * 32 * 2), WS_VDTS = WS_KDS + al((size_t)8 * SKP * 512 * 2), WS_END = WS_VDTS + al((size_t)8 * SKP * 512 * 2);
constexpr int EP_LD = 260;
constexpr int LDS_BYTES = 147456 + 256;
constexpr int TASK_OFF = 147456;
constexpr int NPH = 33;

struct Params { const float* in[32]; float* out; unsigned char* ws; int ph_lo, ph_hi; };
typedef const Params __attribute__((address_space(4)))* KP;

extern __shared__ __attribute__((aligned(16))) unsigned char smem[];

DI float bf2f(u16 v) { return __uint_as_float((u32)v << 16); }
DI u32 pk2(float a, float b) { f32x2 v = {a, b}; bf16x2 r = __builtin_convertvector(v, bf16x2); return __builtin_bit_cast(u32, r); }
DI u16 f2bf(float a) { return (u16)(pk2(a, 0.f) & 0xffffu); }
DI float lo2f(u32 v) { return __uint_as_float(v << 16); }
DI float hi2f(u32 v) { return __uint_as_float(v & 0xffff0000u); }
DI float sigm(float x) { return 1.f / (1.f + __expf(-x)); }
DI float silu(float x) { return x / (1.f + __expf(-x)); }
DI float softplus_f(float x) { return fmaxf(x, 0.f) + __logf(1.f + __expf(-fabsf(x))); }
DI float neg_expm1(float x) { const float t = x * (1.f + x * (0.5f + x * (0.16666667f + x * 0.041666668f))); return (x > -0.1f) ? -t : 1.f - __expf(x); }
DI float wsum(float v) { for (int o = 32; o; o >>= 1) v += __shfl_xor(v, o); return v; }
DI int kperm(int k) { int q = (k >> 2) & 3; q = (q == 1) ? 2 : (q == 2) ? 1 : q; return (k & ~15) | (q << 2) | (k & 3); }
DI int crow(int reg, int h) { return (reg & 3) + 8 * (reg >> 2) + 4 * h; }
DI int row_pos(int row) { return row < MP ? (row & (TP - 1)) : PAST + ((row - MP) & 15); }

struct TaskTab { int n; u32 t[1408]; };
constexpr TaskTab make_tab() {
  TaskTab x{}; int n = 0;
  for (int i = 0; i < 64; ++i) x.t[n++] = (2u << 16) | i;
  for (int i = 0; i < 8; ++i) x.t[n++] = (3u << 16) | i;
  for (int L = 144; L >= 1; --L) {
    for (int j = 0; j < 16; ++j) if (9 * (j + 1) == L) for (int i = 0; i < 32; ++i) x.t[n++] = (0u << 16) | (j * 32 + i);
    for (int q = 0; q < 128; ++q) if (q / 2 + 1 == L) for (int b = 0; b < 4; ++b) x.t[n++] = (1u << 16) | (q * 4 + b);
  }
  for (int i = 0; i < 256; ++i) x.t[n++] = (4u << 16) | i;
  x.n = n; return x;
}
__device__ const TaskTab g_tab = make_tab();
__device__ const float g_invf[16] = {1.0f, 0.5623413251903491f, 0.31622776601683794f, 0.1778279410038923f, 0.1f, 0.05623413251903491f,
  0.031622776601683794f, 0.01778279410038923f, 0.01f, 0.005623413251903491f, 0.0031622776601683794f, 0.001778279410038923f, 0.001f,
  0.0005623413251903491f, 0.00031622776601683794f, 0.0001778279410038923f};

DI int lds_byte(int r, int c) { int st = (r >> 4) * 2 + (c >> 5), rr = r & 15, cc = c & 31, ob = rr * 64 + cc * 2; return st * 1024 + (ob ^ (((ob >> 9) & 1) << 5)); }
DI void stage_rc(int b, int& R, int& C) { int st = b >> 10, sb = b & 1023, swz = sb ^ (((sb >> 9) & 1) << 5); R = (st >> 1) * 16 + (swz >> 6); C = (st & 1) * 32 + ((swz & 63) >> 1); }

#define SA(b, h) (smem + ((b) * 2 + (h)) * 16384)
#define SB(b, h) (smem + (4 + (b) * 2 + (h)) * 16384)
#define STAGE_A(P, half, kt) do { const u16* _g = A + (long)(half) * 128 * lda + (long)(kt) * 64; \
    __builtin_amdgcn_global_load_lds((const unsigned*)(_g + offA0), (unsigned*)((P) + wbase), 16, 0, 0); \
    __builtin_amdgcn_global_load_lds((const unsigned*)(_g + 64 * lda + offA0), (unsigned*)((P) + wbase + 8192), 16, 0, 0); } while (0)
#define STAGE_B(P, half, kt) do { const u16* _g = Bt + (long)(half) * 128 * ldb + (long)(kt) * 64; \
    __builtin_amdgcn_global_load_lds((const unsigned*)(_g + offB0), (unsigned*)((P) + wbase), 16, 0, 0); \
    __builtin_amdgcn_global_load_lds((const unsigned*)(_g + 64 * ldb + offB0), (unsigned*)((P) + wbase + 8192), 16, 0, 0); } while (0)
#define LDA(dst, b, h) _Pragma("unroll") for (int m = 0; m < 4; ++m) _Pragma("unroll") for (int k = 0; k < 2; ++k) \
    dst[m][k] = *reinterpret_cast<const bf16x8*>(SA(b, h) + lds_byte(wr * 64 + m * 16 + fr, k * 32 + fq * 8))
#define LDB(dst, b, h) _Pragma("unroll") for (int n = 0; n < 2; ++n) _Pragma("unroll") for (int k = 0; k < 2; ++k) \
    dst[n][k] = *reinterpret_cast<const bf16x8*>(SB(b, h) + lds_byte(wc * 32 + n * 16 + fr, k * 32 + fq * 8))
#define MMA(ai, bj, At, Bx) do { __builtin_amdgcn_s_setprio(1); \
    _Pragma("unroll") for (int m = 0; m < 4; ++m) _Pragma("unroll") for (int n = 0; n < 2; ++n) _Pragma("unroll") for (int k = 0; k < 2; ++k) \
      acc[ai][bj][m][n] = __builtin_amdgcn_mfma_f32_16x16x32_bf16(At[m][k], Bx[n][k], acc[ai][bj][m][n], 0, 0, 0); \
    __builtin_amdgcn_s_setprio(0); } while (0)
#define WAIT_V(n) asm volatile("s_waitcnt vmcnt(" #n ")" ::: "memory")
#define WAIT_L(n) asm volatile("s_waitcnt lgkmcnt(" #n ")" ::: "memory")
#define BAR __builtin_amdgcn_s_barrier()
#define SCHED __builtin_amdgcn_sched_barrier(0)

template <int NA> DI void gemm_kloop(const int TID, const u16* __restrict__ A, int lda, const u16* __restrict__ Bt, int ldb, int nt, f32x4 (&acc)[NA][2][4][2]) {
  const int tid = TID, wid = tid >> 6, lane = tid & 63, wr = wid >> 2, wc = wid & 3, fr = lane & 15, fq = lane >> 4;
  unsigned offA0, offB0;
  { int r, c; stage_rc(tid * 16, r, c); offA0 = r * lda + c; offB0 = r * ldb + c; }
  const int wbase = __builtin_amdgcn_readfirstlane(wid) * 1024;
#pragma unroll
  for (int a = 0; a < NA; ++a)
#pragma unroll
    for (int b = 0; b < 2; ++b)
#pragma unroll
      for (int m = 0; m < 4; ++m)
#pragma unroll
        for (int n = 0; n < 2; ++n) acc[a][b][m][n] = f32x4{0.f, 0.f, 0.f, 0.f};
  STAGE_B(SB(0, 0), 0, 0); STAGE_A(SA(0, 0), 0, 0); STAGE_B(SB(0, 1), 1, 0); if (NA == 2) STAGE_A(SA(0, 1), 1, 0);
  WAIT_V(0); __syncthreads();
#pragma unroll 1
  for (int t = 0; t < nt; ++t) {
    const int cb = t & 1, nb = cb ^ 1;
    if (t + 1 < nt) { STAGE_B(SB(nb, 0), 0, t + 1); STAGE_A(SA(nb, 0), 0, t + 1); STAGE_B(SB(nb, 1), 1, t + 1); if (NA == 2) STAGE_A(SA(nb, 1), 1, t + 1); }
#pragma unroll 1
    for (int k = 0; k < 2; ++k) {
      bf16x8 Bf[2][2];
#pragma unroll
      for (int bj = 0; bj < 2; ++bj)
#pragma unroll
        for (int n = 0; n < 2; ++n) Bf[bj][n] = *reinterpret_cast<const bf16x8*>(SB(cb, bj) + lds_byte(wc * 32 + n * 16 + fr, k * 32 + fq * 8));
#pragma unroll
      for (int ai = 0; ai < NA; ++ai) {
        bf16x8 Af[4];
#pragma unroll
        for (int m = 0; m < 4; ++m) Af[m] = *reinterpret_cast<const bf16x8*>(SA(cb, ai) + lds_byte(wr * 64 + m * 16 + fr, k * 32 + fq * 8));
#pragma unroll
        for (int bj = 0; bj < 2; ++bj)
#pragma unroll
          for (int m = 0; m < 4; ++m)
#pragma unroll
            for (int n = 0; n < 2; ++n) acc[ai][bj][m][n] = __builtin_amdgcn_mfma_f32_16x16x32_bf16(Af[m], Bf[bj][n], acc[ai][bj][m][n], 0, 0, 0);
      }
    }
    WAIT_V(0); __syncthreads();
  }
}

#define LDA8(dst, b, h) _Pragma("unroll") for (int m = 0; m < 4; ++m) _Pragma("unroll") for (int k = 0; k < 2; ++k) \
    dst[m][k] = *reinterpret_cast<const bf16x8*>(SA(b, h) + lds_byte(wr * 64 + m * 16 + fr, k * 32 + fq * 8))
#define LDB8(dst, b, h) _Pragma("unroll") for (int n = 0; n < 2; ++n) _Pragma("unroll") for (int k = 0; k < 2; ++k) \
    dst[n][k] = *reinterpret_cast<const bf16x8*>(SB(b, h) + lds_byte(wc * 32 + n * 16 + fr, k * 32 + fq * 8))
#define MMA8(ai, bj, At, Bx) do { __builtin_amdgcn_s_setprio(1); \
    _Pragma("unroll") for (int m = 0; m < 4; ++m) _Pragma("unroll") for (int n = 0; n < 2; ++n) _Pragma("unroll") for (int k = 0; k < 2; ++k) \
      acc[ai][bj][m][n] = __builtin_amdgcn_mfma_f32_16x16x32_bf16(At[m][k], Bx[n][k], acc[ai][bj][m][n], 0, 0, 0); \
    __builtin_amdgcn_s_setprio(0); } while (0)
DI void gemm_kloop8(const int TID, const u16* __restrict__ A, int lda, const u16* __restrict__ Bt, int ldb, int nt, f32x4 (&acc)[2][2][4][2]) {
  const int tid = TID, wid = tid >> 6, lane = tid & 63, wr = wid >> 2, wc = wid & 3, fr = lane & 15, fq = lane >> 4;
  unsigned offA0, offB0;
  { int r, c; stage_rc(tid * 16, r, c); offA0 = r * lda + c; offB0 = r * ldb + c; }
  const int wbase = __builtin_amdgcn_readfirstlane(wid) * 1024;
#pragma unroll
  for (int a = 0; a < 2; ++a)
#pragma unroll
    for (int b = 0; b < 2; ++b)
#pragma unroll
      for (int m = 0; m < 4; ++m)
#pragma unroll
        for (int n = 0; n < 2; ++n) acc[a][b][m][n] = f32x4{0.f, 0.f, 0.f, 0.f};
  bf16x8 At[4][2], B0[2][2], B1[2][2];
  STAGE_B(SB(0, 0), 0, 0); STAGE_A(SA(0, 0), 0, 0);
  STAGE_B(SB(0, 1), 1, 0); STAGE_A(SA(0, 1), 1, 0);
  if (wr == 1) BAR;
  WAIT_V(4); BAR;
  STAGE_B(SB(1, 0), 0, 1); STAGE_A(SA(1, 0), 0, 1); STAGE_B(SB(1, 1), 1, 1);
  WAIT_V(6); BAR;
#pragma unroll 1
  for (int t = 0; t < nt - 2; t += 2) {
    LDB8(B0, 0, 0); SCHED; LDA8(At, 0, 0); STAGE_A(SA(1, 1), 1, t + 1);
    WAIT_L(8); BAR; WAIT_L(0); MMA8(0, 0, At, B0); BAR; SCHED;
    LDB8(B1, 0, 1); STAGE_B(SB(0, 0), 0, t + 2);
    BAR; WAIT_L(0); MMA8(0, 1, At, B1); BAR;
    LDA8(At, 0, 1); STAGE_A(SA(0, 0), 0, t + 2);
    BAR; WAIT_L(0); MMA8(1, 0, At, B0); BAR; SCHED;
    STAGE_B(SB(0, 1), 1, t + 2);
    WAIT_V(6); BAR; MMA8(1, 1, At, B1); BAR;
    LDB8(B0, 1, 0); SCHED; LDA8(At, 1, 0); STAGE_A(SA(0, 1), 1, t + 2);
    WAIT_L(8); BAR; WAIT_L(0); MMA8(0, 0, At, B0); BAR; SCHED;
    LDB8(B1, 1, 1); STAGE_B(SB(1, 0), 0, t + 3);
    BAR; WAIT_L(0); MMA8(0, 1, At, B1); BAR;
    LDA8(At, 1, 1); STAGE_A(SA(1, 0), 0, t + 3);
    BAR; WAIT_L(0); MMA8(1, 0, At, B0); BAR; SCHED;
    STAGE_B(SB(1, 1), 1, t + 3);
    WAIT_V(6); BAR; MMA8(1, 1, At, B1); BAR;
  }
  { LDB8(B0, 0, 0); LDA8(At, 0, 0); STAGE_A(SA(1, 1), 1, nt - 1);
    BAR; WAIT_L(0); MMA8(0, 0, At, B0); BAR;
    LDB8(B1, 0, 1); BAR; WAIT_L(0); MMA8(0, 1, At, B1); BAR;
    LDA8(At, 0, 1); WAIT_V(4); BAR; WAIT_L(0); MMA8(1, 0, At, B0); MMA8(1, 1, At, B1); BAR; }
  { LDB8(B0, 1, 0); LDA8(At, 1, 0); WAIT_V(2); BAR; WAIT_L(0); MMA8(0, 0, At, B0); BAR;
    LDB8(B1, 1, 1); WAIT_V(0); BAR; WAIT_L(0); MMA8(0, 1, At, B1); BAR;
    LDA8(At, 1, 1); BAR; WAIT_L(0); MMA8(1, 0, At, B0); MMA8(1, 1, At, B1); BAR; }
  if (wr == 0) BAR;
  __syncthreads();
}

DI void gemm_kloop_r3(const int TID, const u16* __restrict__ A, int lda, const u16* __restrict__ Bt, int ldb, int nt, f32x4 (&acc)[1][2][4][2]) {
  const int tid = TID, wid = tid >> 6, lane = tid & 63, wr = wid >> 2, wc = wid & 3, fr = lane & 15, fq = lane >> 4;
  unsigned offA0, offB0;
  { int r, c; stage_rc(tid * 16, r, c); offA0 = r * lda + c; offB0 = r * ldb + c; }
  const int wbase = __builtin_amdgcn_readfirstlane(wid) * 1024;
#pragma unroll
  for (int b = 0; b < 2; ++b)
#pragma unroll
    for (int m = 0; m < 4; ++m)
#pragma unroll
      for (int n = 0; n < 2; ++n) acc[0][b][m][n] = f32x4{0.f, 0.f, 0.f, 0.f};
#define R3A(i) (smem + (i) * 49152)
#define R3B(i, h) (smem + (i) * 49152 + 16384 + (h) * 16384)
#define R3_STAGE(i, kt) do { STAGE_B(R3B(i, 0), 0, kt); STAGE_A(R3A(i), 0, kt); STAGE_B(R3B(i, 1), 1, kt); } while (0)
  R3_STAGE(0, 0); R3_STAGE(1, 1);
  WAIT_V(6); BAR;
  int cur = 0;
#pragma unroll 1
  for (int t = 0; t < nt; ++t) {
    const int nx1 = (cur == 2) ? 0 : cur + 1, nx2 = (cur == 0) ? 2 : cur - 1;
    if (t + 2 < nt) R3_STAGE(nx2, t + 2);
#pragma unroll
    for (int k = 0; k < 2; ++k) {
      bf16x8 Bf[2][2], Af[4];
#pragma unroll
      for (int bj = 0; bj < 2; ++bj)
#pragma unroll
        for (int n = 0; n < 2; ++n) Bf[bj][n] = *reinterpret_cast<const bf16x8*>(R3B(cur, bj) + lds_byte(wc * 32 + n * 16 + fr, k * 32 + fq * 8));
#pragma unroll
      for (int m = 0; m < 4; ++m) Af[m] = *reinterpret_cast<const bf16x8*>(R3A(cur) + lds_byte(wr * 64 + m * 16 + fr, k * 32 + fq * 8));
#pragma unroll
      for (int bj = 0; bj < 2; ++bj)
#pragma unroll
        for (int m = 0; m < 4; ++m)
#pragma unroll
          for (int n = 0; n < 2; ++n) acc[0][bj][m][n] = __builtin_amdgcn_mfma_f32_16x16x32_bf16(Af[m], Bf[bj][n], acc[0][bj][m][n], 0, 0, 0);
    }
    if (t + 2 < nt) WAIT_V(6); else WAIT_V(0);
    WAIT_L(0); BAR;
    cur = nx1;
  }
}

DI void tile_coords(int tile, int nM, int nN, int& pm, int& pn) {
  int nig = 8 * nN, gid = tile / nig, fm = gid * 8, gsz = min(nM - fm, 8), loc = tile % nig;
  pm = fm + loc % gsz; pn = loc / gsz;
}

#define GEMM_IDS const int tid = TID, wid = tid >> 6, lane = tid & 63, wr = wid >> 2, wc = wid & 3, fr = lane & 15, fq = lane >> 4; (void)tid; (void)wr; (void)wc; (void)fr; (void)fq; (void)lane;
DI int fresh_tid(int wv) { int l; asm volatile("v_mbcnt_lo_u32_b32 %0, -1, 0\n\tv_mbcnt_hi_u32_b32 %0, -1, %0" : "=v"(l)); return wv * 64 + l; }
DI int opaque_zero() { int z; asm volatile("s_mov_b32 %0, 0" : "=s"(z)); return z; }
#define ACC_TO_LDS(ai) do { float* _e = (float*)smem; \
  _Pragma("unroll") for (int bj = 0; bj < 2; ++bj) _Pragma("unroll") for (int m = 0; m < 4; ++m) _Pragma("unroll") for (int n = 0; n < 2; ++n) _Pragma("unroll") for (int j = 0; j < 4; ++j) \
    _e[(wr * 64 + m * 16 + fq * 4 + j) * EP_LD + bj * 128 + wc * 32 + n * 16 + fr] = acc[ai][bj][m][n][j]; } while (0)
#define EPI_ROWS_BEGIN(ai) _Pragma("unroll 4") for (int _it = 0; _it < 16; ++_it) { const int _idx = _it * 512 + tid; const int rl = _idx >> 6, cl = (_idx & 63) * 4; \
    const float4 v = *(const float4*)((const float*)smem + rl * EP_LD + cl); const int row = browz + (ai) * 128 + rl; const int col = bcol + cl; (void)row; (void)col;
#define EPI_ROWS_END }
DI uint2 pk4(float a, float b, float c, float d) { uint2 o; o.x = pk2(a, b); o.y = pk2(c, d); return o; }

DI void sgemm16(const int lane, const u16* __restrict__ A, int lda, const u16* __restrict__ Bt, int ldb, int K, int bc0, int bc1, f32x4& c0, f32x4& c1) {
  const int fr = lane & 15, fq = lane >> 4;
  const u16* ap = A + (long)fr * lda + fq * 8;
  const u16* b0 = Bt + (long)(bc0 + fr) * ldb + fq * 8; const u16* b1 = Bt + (long)(bc1 + fr) * ldb + fq * 8;
  c0 = f32x4{0.f, 0.f, 0.f, 0.f}; c1 = c0;
#pragma unroll 8
  for (int k = 0; k < K; k += 32) { const bf16x8 a = *(const bf16x8*)(ap + k), x = *(const bf16x8*)(b0 + k), y = *(const bf16x8*)(b1 + k);
    c0 = __builtin_amdgcn_mfma_f32_16x16x32_bf16(a, x, c0, 0, 0, 0); c1 = __builtin_amdgcn_mfma_f32_16x16x32_bf16(a, y, c1, 0, 0, 0); }
}
DI void inproj_store_s(KP p, int l, int row, int col, float v) {
  unsigned char* ws = p->ws; u16* proj = (u16*)(ws + WS_PROJ);
  const int rs = row - MP;
  if (col >= PC_G) proj[(long)row * NPJ + col] = f2bf(sigm(v));
  else if (col >= PC_QD && col < PC_KD) proj[(long)row * NPJ + col] = f2bf(v * QD_SCALE);
  else if (col >= PC_KD && col < PC_VD) { const int hv = col - PC_KD; p->out[O_SDK + (long)l * MS * 512 + rs * 512 + hv] = v;
    ((u16*)(ws + WS_KDS))[((long)(rs >> 4) * SKP + PAST + (rs & 15)) * 512 + hv] = f2bf(v); }
  else if (col >= PC_VD && col < PC_ZD) { const int hv = col - PC_VD; p->out[O_SDV + (long)l * MS * 512 + rs * 512 + hv] = v;
    ((u16*)(ws + WS_VDTS))[((long)(rs >> 4) * 512 + hv) * SKP + kperm(PAST + (rs & 15))] = f2bf(v); }
  else proj[(long)row * NPJ + col] = f2bf(v);
}

template <bool PERM> DI void transpose_tile(const int TID, const float* __restrict__ src, long ld_s, u16* __restrict__ dst, long ld_d, int r0, int c0, int drow0) {
  u16* tl = (u16*)smem;
  const int tid = TID;
  { int rr = tid >> 3, cc = (tid & 7) * 4; float4 v = *(const float4*)(src + (long)(r0 + rr) * ld_s + c0 + cc);
    tl[(cc + 0) * 72 + rr] = f2bf(v.x); tl[(cc + 1) * 72 + rr] = f2bf(v.y); tl[(cc + 2) * 72 + rr] = f2bf(v.z); tl[(cc + 3) * 72 + rr] = f2bf(v.w); }
  __syncthreads();
  if (tid < 256) { int cc = tid >> 3, rr = (tid & 7) * 8; uint4 v = *(const uint4*)(tl + cc * 72 + rr);
    if (PERM) { u16* d = dst + (long)(drow0 + cc) * ld_d; *(uint2*)(d + kperm(r0 + rr)) = uint2{v.x, v.y}; *(uint2*)(d + kperm(r0 + rr + 4)) = uint2{v.z, v.w}; }
    else *(uint4*)(dst + (long)(drow0 + cc) * ld_d + r0 + rr) = v; }
  __syncthreads();
}

DI void rmsnorm_rows_to_bf16(const int TID, KP p, int l) {
  const int lane = TID & 63, wid = TID >> 6;
  const float* g = p->in[8] + l * D;
  u16* xn = (u16*)(p->ws + WS_XN);
  for (int row = blockIdx.x * 8 + wid; row < M; row += gridDim.x * 8) {
    const float* src = (l == 0) ? (row < MP ? p->in[0] + (long)row * D : p->in[1] + (long)(row - MP) * D) : p->out + (long)row * D;
    float4 v[4]; float ss = 0.f;
#pragma unroll
    for (int i = 0; i < 4; ++i) { v[i] = *(const float4*)(src + i * 256 + lane * 4); ss += v[i].x * v[i].x + v[i].y * v[i].y + v[i].z * v[i].z + v[i].w * v[i].w; }
    ss = wsum(ss); const float rs = rsqrtf(ss * (1.f / D) + EPS);
#pragma unroll
    for (int i = 0; i < 4; ++i) { float4 gg = *(const float4*)(g + i * 256 + lane * 4);
      uint2 o; o.x = pk2(v[i].x * rs * gg.x, v[i].y * rs * gg.y); o.y = pk2(v[i].z * rs * gg.z, v[i].w * rs * gg.w);
      *(uint2*)(xn + (long)row * D + i * 256 + lane * 4) = o; }
  }
}

DI void prep_phase(const int TID, KP p, int l) {
  const int tid = TID, G = gridDim.x, bx = blockIdx.x;
  const long gtid = (long)bx * 512 + tid, gn = (long)G * 512;
  unsigned char* ws = p->ws;
  rmsnorm_rows_to_bf16(TID, p, l);
  { const float* w = p->in[9] + (long)l * 1024 * NIN; u16* d = (u16*)(ws + WS_WIN);
    for (int i = bx; i < 16 * 221; i += G) { int kt = i & 15, ct = i >> 4, c0 = ct * 32; transpose_tile<false>(TID, w, NIN, d, 1024, kt * 64, c0, c0 < 416 ? c0 : c0 + 96); }
    for (long i = gtid; i < 96 * 1024 / 8; i += gn) { const unsigned z = (unsigned)TID >> 31; ((uint4*)(d + 416 * 1024))[i] = uint4{z, z, z, z}; } }
  for (int b = 0; b < 3; ++b) { const float* w = p->in[27 + b] + (long)l * 512 * 1024; u16* d = (u16*)(ws + WS_WO) + (long)b * 1024 * 512;
    for (int i = bx; i < 8 * 32; i += G) { int rt = i & 7, ct = i >> 3; transpose_tile<false>(TID, w, 1024, d, 512, rt * 64, ct * 32, ct * 32); } }
  { const float* w = p->in[30] + (long)l * 1024 * 1024; u16* d = (u16*)(ws + WS_WOUT);
    for (int i = bx; i < 16 * 32; i += G) { int rt = i & 15, ct = i >> 4; transpose_tile<false>(TID, w, 1024, d, 1024, rt * 64, ct * 32, ct * 32); } }
  { const float* c = p->in[2] + (long)l * 8 * PAST * 128; u16* d = (u16*)(ws + WS_CKVTS);
    for (int i = bx; i < 8 * 32 * 4; i += G) { int sb = i >> 7, r = i & 127, rt = r & 31, ct = r >> 5;
      transpose_tile<true>(TID, c + (long)sb * PAST * 128, 128, d + (long)sb * 128 * SKP, SKP, rt * 64, ct * 32, ct * 32); } }
  { const float* c = p->in[5] + (long)l * 8 * PAST * 512; u16* d = (u16*)(ws + WS_VDTS);
    for (int i = bx; i < 8 * 32 * 16; i += G) { int sb = i >> 9, r = i & 511, rt = r & 31, ct = r >> 5;
      transpose_tile<true>(TID, c + (long)sb * PAST * 512, 512, d + (long)sb * 512 * SKP, SKP, rt * 64, ct * 32, ct * 32); } }
  { const float* c = p->in[2] + (long)l * 8 * PAST * 128; u16* d = (u16*)(ws + WS_CKVS);
    for (long i = gtid; i < 8L * PAST * 128 / 4; i += gn) { long e = i * 4; int sb = (int)(e / (PAST * 128)); long r = e - (long)sb * PAST * 128;
      float4 v = *(const float4*)(c + e); uint2 o; o.x = pk2(v.x, v.y); o.y = pk2(v.z, v.w); *(uint2*)(d + (long)sb * SKP * 128 + r) = o; } }
  { const float* c = p->in[3] + (long)l * 8 * PAST * 32; u16* d = (u16*)(ws + WS_KRS);
    for (long i = gtid; i < 8L * PAST * 32 / 4; i += gn) { long e = i * 4; int sb = (int)(e / (PAST * 32)); long r = e - (long)sb * PAST * 32;
      float4 v = *(const float4*)(c + e); uint2 o; o.x = pk2(v.x, v.y); o.y = pk2(v.z, v.w); *(uint2*)(d + (long)sb * SKP * 32 + r) = o; } }
  { const float* c = p->in[4] + (long)l * 8 * PAST * 512; u16* d = (u16*)(ws + WS_KDS);
    for (long i = gtid; i < 8L * PAST * 512 / 4; i += gn) { long e = i * 4; int sb = (int)(e / (PAST * 512)); long r = e - (long)sb * PAST * 512;
      float4 v = *(const float4*)(c + e); uint2 o; o.x = pk2(v.x, v.y); o.y = pk2(v.z, v.w); *(uint2*)(d + (long)sb * SKP * 512 + r) = o; } }
  for (long i = gtid; i < 8L * 48 * 128; i += gn) { int sb = (int)(i / (48 * 128)); int r = (int)(i % (48 * 128)); ((u16*)(ws + WS_CKVS))[((long)sb * SKP + SK) * 128 + r] = 0; }
  for (long i = gtid; i < 8L * 48 * 32; i += gn) { int sb = (int)(i / (48 * 32)); int r = (int)(i % (48 * 32)); ((u16*)(ws + WS_KRS))[((long)sb * SKP + SK) * 32 + r] = 0; }
  for (long i = gtid; i < 8L * 48 * 512; i += gn) { int sb = (int)(i / (48 * 512)); int r = (int)(i % (48 * 512)); ((u16*)(ws + WS_KDS))[((long)sb * SKP + SK) * 512 + r] = 0; }
  for (long i = gtid; i < 8L * 128 * 48; i += gn) { int rw = (int)(i / 48), k = (int)(i % 48); ((u16*)(ws + WS_CKVTS))[(long)rw * SKP + SK + k] = 0; }
  for (long i = gtid; i < 8L * 512 * 48; i += gn) { int rw = (int)(i / 48), k = (int)(i % 48); ((u16*)(ws + WS_VDTS))[(long)rw * SKP + SK + k] = 0; }
  { const float* uq = p->in[12] + (long)l * 256 * 768; const float* uk = p->in[13] + (long)l * 128 * 512; u16* d = (u16*)(ws + WS_WQ);
    for (long i = gtid; i < 1280L * 256; i += gn) { int n = (int)(i >> 8), r = (int)(i & 255); float s;
      if (n < 1024) { int hd = n >> 7, c = n & 127; const float* a = uq + r * 768 + hd * 96; const float* b = uk + c * 512 + hd * 64; s = 0.f;
        for (int dd = 0; dd < 64; dd += 4) { float4 x = *(const float4*)(a + dd), y = *(const float4*)(b + dd); s += x.x * y.x + x.y * y.y + x.z * y.z + x.w * y.w; } }
      else { int hd = (n - 1024) >> 5, j = (n - 1024) & 31; s = uq[r * 768 + hd * 96 + 64 + j]; }
      d[i] = f2bf(s); } }
  { const float* uv = p->in[14] + (long)l * 128 * 512; u16* d = (u16*)(ws + WS_WUV);
    for (long i = gtid; i < 512L * 512; i += gn) { int n = (int)(i >> 9), kk = (int)(i & 511); int hd = n >> 6, v = n & 63, hk = (n >> 8) * 4 + (kk >> 7), c = kk & 127;
      d[i] = (hk == hd) ? f2bf(uv[c * 512 + hd * 64 + v]) : (u16)0; } }
  { const float* wa = p->in[22] + (long)l * 8 * 4096; const float* wx = p->in[24] + (long)l * 8 * 4096; u16* d = (u16*)(ws + WS_WLRU);
    for (long i = gtid; i < 1024L * 256; i += gn) { int nn = (int)(i >> 8), kk = (int)(i & 255); int pn = nn >> 8, nl = nn & 255; int f = pn * 128 + (nl & 127);
      int blk = f >> 6, o = f & 63, bk = (pn >> 1) * 4 + (kk >> 6), ii = kk & 63; const float* w = (nl < 128) ? wa : wx;
      d[i] = (bk == blk) ? f2bf(w[blk * 4096 + ii * 64 + o]) : (u16)0; } }
  if (bx == 0 && tid == 0) {
    float s1 = 0.f, s2 = 0.f;
    for (int i = 0; i < 32; ++i) { s1 += p->in[15][l * 32 + i] * p->in[16][l * 32 + i]; s2 += p->in[17][l * 32 + i] * p->in[18][l * 32 + i]; }
    const float lam_init = 0.8f - 0.6f * expf(-0.3f * (float)l);
    float* sc = (float*)(ws + WS_CTL + 1024);
    sc[l * 2 + 0] = expf(s1) - expf(s2) + lam_init; sc[l * 2 + 1] = lam_init;
  }
  if (l == 0) {
    float2* tab = (float2*)(ws + WS_ROPE);
    for (long i = gtid; i < 4096 * 16; i += gn) { int pos = (int)(i >> 4), j = (int)(i & 15);
      const float a = (float)pos * g_invf[j];
      const float k = rintf(a * 0.63661977236758134f);
      float y = fmaf(-k, 1.5707963109016418f, a); y = fmaf(-k, 1.5893254712295857e-08f, y); y = fmaf(-k, 6.0770999344e-16f, y);
      const float y2 = y * y;
      const float sn = y * (1.f + y2 * (-1.6666667163e-01f + y2 * (8.3333337680e-03f + y2 * (-1.9841270114e-04f + y2 * 2.7557314297e-06f))));
      const float cs = 1.f + y2 * (-0.5f + y2 * (4.1666667908e-02f + y2 * (-1.3888889225e-03f + y2 * (2.4801587642e-05f + y2 * -2.7557314297e-07f))));
      const int q = ((int)k) & 3;
      const float c2 = (q == 0) ? cs : (q == 1) ? -sn : (q == 2) ? -cs : sn;
      const float s2 = (q == 0) ? sn : (q == 1) ? cs : (q == 2) ? -sn : -cs;
      tab[i] = float2{c2, s2}; }
  }
}

DI void inproj_phase(const int TID_in, KP p, int l, int vid) {
  const int wv = __builtin_amdgcn_readfirstlane(TID_in >> 6);
  unsigned char* ws = p->ws;
  f32x4 acc[2][2][4][2];
  for (int tile = vid; tile < 64 * 28; tile += gridDim.x) {
    int pm, pn; tile_coords(tile, 64, 28, pm, pn);
    const int brow = pm * 256, bcol = pn * 256;
    gemm_kloop8(fresh_tid(wv), (const u16*)(ws + WS_XN) + (long)brow * 1024, 1024, (const u16*)(ws + WS_WIN) + (long)bcol * 1024, 1024, 16, acc);
    const int TID = fresh_tid(wv);
    GEMM_IDS
    const int oz = opaque_zero(); const int browz = brow + oz;
    u16* proj = (u16*)(ws + WS_PROJ) + oz;
#pragma unroll
    for (int ai = 0; ai < 2; ++ai) {
      ACC_TO_LDS(ai);
      __syncthreads();
      if (pn >= 16) {
        EPI_ROWS_BEGIN(ai) *(uint2*)(proj + (long)row * NPJ + col) = pk4(sigm(v.x), sigm(v.y), sigm(v.z), sigm(v.w)); EPI_ROWS_END
      } else if (pn == 4 || pn == 5) {
        EPI_ROWS_BEGIN(ai) *(uint2*)(proj + (long)row * NPJ + col) = pk4(v.x * QD_SCALE, v.y * QD_SCALE, v.z * QD_SCALE, v.w * QD_SCALE); EPI_ROWS_END
      } else if (pn == 6 || pn == 7) {
        u16* kds = (u16*)(ws + WS_KDS) + oz;
        EPI_ROWS_BEGIN(ai)
          const int hv = col - PC_KD; const uint2 pk = pk4(v.x, v.y, v.z, v.w);
          *(uint2*)(proj + (long)row * NPJ + col) = pk;
          if (row < MP) *(float4*)(p->out + O_PDK + (long)l * MP * 512 + (long)row * 512 + hv) = v;
          else if (row < M) { const int rs = row - MP; *(float4*)(p->out + O_SDK + (long)l * MS * 512 + rs * 512 + hv) = v;
            *(uint2*)(kds + ((long)(rs >> 4) * SKP + PAST + (rs & 15)) * 512 + hv) = pk; }
        EPI_ROWS_END
      } else if (pn == 8 || pn == 9) {
        EPI_ROWS_BEGIN(ai)
          const int hv = col - PC_VD;
          if (row < MP) *(float4*)(p->out + O_PDV + (long)l * MP * 512 + (long)row * 512 + hv) = v;
          else if (row < M) *(float4*)(p->out + O_SDV + (long)l * MS * 512 + (row - MP) * 512 + hv) = v;
        EPI_ROWS_END
        u16* vtp = (u16*)(ws + WS_VDTP) + oz; u16* vts = (u16*)(ws + WS_VDTS) + oz;
#pragma unroll 4
        for (int it = 0; it < 16; ++it) { const int idx = it * 512 + tid; const int cl = idx & 255, r4 = (idx >> 8) * 4;
          const float* e = (const float*)smem + r4 * EP_LD + cl;
          const uint2 pk = pk4(e[0], e[EP_LD], e[2 * EP_LD], e[3 * EP_LD]);
          const int row0 = browz + ai * 128 + r4, hv = bcol + cl - PC_VD;
          if (row0 < MP) *(uint2*)(vtp + ((long)(row0 >> 12) * 512 + hv) * TP + kperm(row0 & (TP - 1))) = pk;
          else if (row0 < M) { const int rs = row0 - MP; *(uint2*)(vts + ((long)(rs >> 4) * 512 + hv) * SKP + kperm(PAST + (rs & 15))) = pk; } }
      } else {
        EPI_ROWS_BEGIN(ai) *(uint2*)(proj + (long)row * NPJ + col) = pk4(v.x, v.y, v.z, v.w); EPI_ROWS_END
      }
      __syncthreads();
    }
  }
  const int TID = fresh_tid(wv);
  GEMM_IDS
  for (int it = (int)gridDim.x - 1 - vid; it < 8 * 28; it += gridDim.x) {
    const int rg = it & 7, pn = it >> 3; const int row0 = MP + rg * 16, bcol = pn * 256;
    f32x4 c0, c1;
    sgemm16(lane, (const u16*)(ws + WS_XN) + (long)row0 * 1024, 1024, (const u16*)(ws + WS_WIN) + (long)bcol * 1024, 1024, 1024, wid * 32, wid * 32 + 16, c0, c1);
#pragma unroll
    for (int j = 0; j < 4; ++j) { const int row = row0 + fq * 4 + j; inproj_store_s(p, l, row, bcol + wid * 32 + fr, c0[j]); inproj_store_s(p, l, row, bcol + wid * 32 + 16 + fr, c1[j]); }
  }
}

template <int NR> DI void mid_unit(const int TID, KP p, int l, const int r0) {
  const int tid = TID, lane = tid & 63, wid = tid >> 6;
  unsigned char* ws = p->ws;
  u16* proj = (u16*)(ws + WS_PROJ);
  u16* tl = (u16*)smem;
  const float* gq = p->in[10] + l * 256; const float* gkv = p->in[11] + l * 128;
  const float2* rope = (const float2*)(ws + WS_ROPE);
  const float* cw = p->in[20] + l * 4 * 512; const float* cb = p->in[21] + l * 512;
  u16* xc = (u16*)(ws + WS_XC);
  const int rw0 = r0 + wid * NR;
  const bool pr = rw0 < MP; const int rs0 = rw0 - MP;
  const int b = pr ? (rw0 >> 12) : (rs0 >> 4), t0 = pr ? (rw0 & (TP - 1)) : (rs0 & 15);
  u16* prow0 = proj + (long)rw0 * NPJ;
  {
    uint2 vq[NR]; u32 vk[NR]; float x1[NR], x2[NR];
#pragma unroll
    for (int i = 0; i < NR; ++i) { const u16* pw = prow0 + (long)i * NPJ; vq[i] = *(const uint2*)(pw + PC_CQ + lane * 4); vk[i] = *(const u32*)(pw + PC_CKV + lane * 2);
      x1[i] = bf2f(pw[PC_KR + (lane & 15)]); x2[i] = bf2f(pw[PC_KR + 16 + (lane & 15)]); }
    const float4 g4 = *(const float4*)(gq + lane * 4); const float2 g2 = *(const float2*)(gkv + lane * 2);
#pragma unroll
    for (int i = 0; i < NR; ++i) {
      const int row = rw0 + i, t = t0 + i, pos = pr ? t : PAST + t; const int rs = row - MP;
      u16* prow = prow0 + (long)i * NPJ;
      { float a0 = lo2f(vq[i].x), a1 = hi2f(vq[i].x), a2 = lo2f(vq[i].y), a3 = hi2f(vq[i].y);
        float ss = wsum(a0 * a0 + a1 * a1 + a2 * a2 + a3 * a3); float rsd = rsqrtf(ss * (1.f / 256) + EPS);
        *(uint2*)(prow + PC_CQ + lane * 4) = pk4(a0 * rsd * g4.x, a1 * rsd * g4.y, a2 * rsd * g4.z, a3 * rsd * g4.w); }
      { float a0 = lo2f(vk[i]), a1 = hi2f(vk[i]);
        float ss = wsum(a0 * a0 + a1 * a1); float rsd = rsqrtf(ss * (1.f / 128) + EPS);
        float y0 = a0 * rsd * g2.x, y1 = a1 * rsd * g2.y;
        float* so = pr ? p->out + O_PCKV + (long)l * MP * 128 + (long)row * 128 : p->out + O_SCKV + (long)l * MS * 128 + rs * 128;
        *(float2*)(so + lane * 2) = float2{y0, y1};
        u32 pk = pk2(y0, y1);
        u16* kb = pr ? (u16*)(ws + WS_CKVP) + (long)row * 128 : (u16*)(ws + WS_CKVS) + ((long)b * SKP + PAST + t) * 128;
        *(u32*)(kb + lane * 2) = pk;
        tl[(lane * 2) * 72 + wid * NR + i] = (u16)(pk & 0xffff); tl[(lane * 2 + 1) * 72 + wid * NR + i] = (u16)(pk >> 16); }
      if (lane < 16) {
        float2 cs = rope[pos * 16 + lane];
        float o1 = x1[i] * cs.x - x2[i] * cs.y, o2 = x2[i] * cs.x + x1[i] * cs.y;
        float* so = pr ? p->out + O_PKR + (long)l * MP * 32 + (long)row * 32 : p->out + O_SKR + (long)l * MS * 32 + rs * 32;
        so[lane] = o1; so[lane + 16] = o2;
        u16* kb = pr ? (u16*)(ws + WS_KRP) + (long)row * 32 : (u16*)(ws + WS_KRS) + ((long)b * SKP + PAST + t) * 32;
        kb[lane] = f2bf(o1); kb[lane + 16] = f2bf(o2); }
    }
  }
  {
    const int f = lane * 8;
    uint4 xin[NR + 3];
#pragma unroll
    for (int k = 0; k < NR + 3; ++k) {
      const int tt = t0 + k - 3;
      if (tt >= 0) xin[k] = *(const uint4*)(prow0 + (long)(k - 3) * NPJ + PC_XL + f);
      else if (!pr) { const float* c0 = p->in[7] + (((long)l * 8 + b) * 3 + (tt + 3)) * 512 + f; float4 u0 = *(const float4*)c0, u1 = *(const float4*)(c0 + 4);
        xin[k] = uint4{pk2(u0.x, u0.y), pk2(u0.z, u0.w), pk2(u1.x, u1.y), pk2(u1.z, u1.w)}; }
      else xin[k] = uint4{0u, 0u, 0u, 0u};
    }
    float4 w[4][2];
#pragma unroll
    for (int k = 0; k < 4; ++k) { w[k][0] = *(const float4*)(cw + k * 512 + f); w[k][1] = *(const float4*)(cw + k * 512 + f + 4); }
    const float4 b0 = *(const float4*)(cb + f), b1 = *(const float4*)(cb + f + 4);
    const int T = pr ? TP : TS;
#pragma unroll
    for (int i = 0; i < NR; ++i) {
      float a[8] = {b0.x, b0.y, b0.z, b0.w, b1.x, b1.y, b1.z, b1.w};
#pragma unroll
      for (int k = 0; k < 4; ++k) { const uint4 v = xin[i + k];
        a[0] += lo2f(v.x) * w[k][0].x; a[1] += hi2f(v.x) * w[k][0].y; a[2] += lo2f(v.y) * w[k][0].z; a[3] += hi2f(v.y) * w[k][0].w;
        a[4] += lo2f(v.z) * w[k][1].x; a[5] += hi2f(v.z) * w[k][1].y; a[6] += lo2f(v.w) * w[k][1].z; a[7] += hi2f(v.w) * w[k][1].w; }
      *(uint4*)(xc + (long)(rw0 + i) * 512 + f) = uint4{pk2(a[0], a[1]), pk2(a[2], a[3]), pk2(a[4], a[5]), pk2(a[6], a[7])};
      const int t = t0 + i;
      if (t >= T - 3) { const uint4 v = xin[i + 3];
        float* so = pr ? p->out + O_PCV + (((long)l * 4 + b) * 3 + (t - (T - 3))) * 512 + f : p->out + O_SCV + (((long)l * 8 + b) * 3 + (t - (T - 3))) * 512 + f;
        *(float4*)so = float4{lo2f(v.x), hi2f(v.x), lo2f(v.y), hi2f(v.y)}; *(float4*)(so + 4) = float4{lo2f(v.z), hi2f(v.z), lo2f(v.w), hi2f(v.w)}; }
    }
  }
  __syncthreads();
  for (int id = tid; id < 128 * NR; id += 512) { const int c = id / NR, rg = id % NR; const int row = r0 + rg * 8;
    uint4 v = *(const uint4*)(tl + c * 72 + rg * 8);
    u16* dbase = (row < MP) ? (u16*)(ws + WS_CKVTP) + ((long)(row >> 12) * 128 + c) * TP : (u16*)(ws + WS_CKVTS) + ((long)((row - MP) >> 4) * 128 + c) * SKP;
    const int key = (row < MP) ? (row & (TP - 1)) : PAST + ((row - MP) & 15);
    *(uint2*)(dbase + kperm(key)) = uint2{v.x, v.y}; *(uint2*)(dbase + kperm(key + 4)) = uint2{v.z, v.w}; }
  __syncthreads();
}
DI void mid_phase(const int TID, KP p, int l) {
  for (int u = blockIdx.x; u < 256 + 16; u += gridDim.x) {
    if (u < 256) mid_unit<8>(TID, p, l, u * 64);
    else mid_unit<1>(TID, p, l, MP + (u - 256) * 8);
  }
}

DI void qlru_phase(const int TID_in, KP p, int l, int vid) {
  const int wv = __builtin_amdgcn_readfirstlane(TID_in >> 6);
  unsigned char* ws = p->ws;
  f32x4 acc[2][2][4][2];
  for (int tile = vid; tile < 64 * 9; tile += gridDim.x) {
    if (tile < 64 * 5) {
      int pm, pn; tile_coords(tile, 64, 5, pm, pn);
      const int brow = pm * 256, bcol = pn * 256;
      gemm_kloop8(fresh_tid(wv), (const u16*)(ws + WS_PROJ) + (long)brow * NPJ + PC_CQ, NPJ, (const u16*)(ws + WS_WQ) + (long)bcol * 256, 256, 4, acc);
      const int TID = fresh_tid(wv);
      GEMM_IDS
      const int oz = opaque_zero(); const int browz = brow + oz;
      u16* qm = (u16*)(ws + WS_QMLA) + oz;
#pragma unroll
      for (int ai = 0; ai < 2; ++ai) {
        ACC_TO_LDS(ai);
        __syncthreads();
        if (pn < 4) {
          EPI_ROWS_BEGIN(ai) *(uint2*)(qm + (long)row * 1280 + col) = pk4(v.x * QM_SCALE, v.y * QM_SCALE, v.z * QM_SCALE, v.w * QM_SCALE); EPI_ROWS_END
        } else {
          const float2* rope = (const float2*)(ws + WS_ROPE) + oz;
#pragma unroll 2
          for (int it = 0; it < 8; ++it) { const int idx = it * 512 + tid; const int rl = idx >> 5, hd = (idx >> 2) & 7, j4 = (idx & 3) * 4;
            const int row = browz + ai * 128 + rl;
            if (row < M) {
              const float* e = (const float*)smem + rl * EP_LD + hd * 32 + j4;
              const float4 x1 = *(const float4*)e, x2 = *(const float4*)(e + 16);
              const float4 c01 = *(const float4*)(rope + row_pos(row) * 16 + j4), c23 = *(const float4*)(rope + row_pos(row) * 16 + j4 + 2);
              u16* q = qm + (long)row * 1280 + 1024 + hd * 32 + j4;
              *(uint2*)q = pk4((x1.x * c01.x - x2.x * c01.y) * QM_SCALE, (x1.y * c01.z - x2.y * c01.w) * QM_SCALE, (x1.z * c23.x - x2.z * c23.y) * QM_SCALE, (x1.w * c23.z - x2.w * c23.w) * QM_SCALE);
              *(uint2*)(q + 16) = pk4((x2.x * c01.x + x1.x * c01.y) * QM_SCALE, (x2.y * c01.z + x1.y * c01.w) * QM_SCALE, (x2.z * c23.x + x1.z * c23.y) * QM_SCALE, (x2.w * c23.z + x1.w * c23.w) * QM_SCALE); } }
        }
        __syncthreads();
      }
    } else {
      int pm, pn; tile_coords(tile - 64 * 5, 64, 4, pm, pn);
      const int brow = pm * 256;
      gemm_kloop8(fresh_tid(wv), (const u16*)(ws + WS_XC) + (long)brow * 512 + (pn >> 1) * 256, 512, (const u16*)(ws + WS_WLRU) + (long)pn * 256 * 256, 256, 4, acc);
      const int TID = fresh_tid(wv);
      GEMM_IDS
      const int oz = opaque_zero(); const int browz = brow + oz;
      const u16* xc = (const u16*)(ws + WS_XC) + oz;
      float* ab = (float*)(ws + WS_A) + oz; float* bb = (float*)(ws + WS_B) + oz;
      float spv[4], baa[4], bxa[4];
      { const int f = pn * 128 + (tid & 31) * 4;
        const float4 lb = *(const float4*)(p->in[26] + l * 512 + f), bav = *(const float4*)(p->in[23] + l * 512 + f), bxv = *(const float4*)(p->in[25] + l * 512 + f);
        spv[0] = softplus_f(-lb.x); spv[1] = softplus_f(-lb.y); spv[2] = softplus_f(-lb.z); spv[3] = softplus_f(-lb.w);
        baa[0] = bav.x; baa[1] = bav.y; baa[2] = bav.z; baa[3] = bav.w; bxa[0] = bxv.x; bxa[1] = bxv.y; bxa[2] = bxv.z; bxa[3] = bxv.w; }
#pragma unroll
      for (int ai = 0; ai < 2; ++ai) {
        ACC_TO_LDS(ai);
        __syncthreads();
#pragma unroll 2
        for (int it = 0; it < 8; ++it) { const int idx = it * 512 + tid; const int rl = idx >> 5, f4 = (idx & 31) * 4;
          const int row = browz + ai * 128 + rl;
          if (row < M) {
            const float* e = (const float*)smem + rl * EP_LD + f4;
            const float4 ra = *(const float4*)e, rx = *(const float4*)(e + 128);
            const int f = pn * 128 + f4;
            const uint2 xv = *(const uint2*)(xc + (long)row * 512 + f);
            const bool first = (row < MP) && ((row & (TP - 1)) == 0);
            float av[4], bv[4];
            const float raa[4] = {ra.x, ra.y, ra.z, ra.w}, rxa[4] = {rx.x, rx.y, rx.z, rx.w};
            const float xca[4] = {lo2f(xv.x), hi2f(xv.x), lo2f(xv.y), hi2f(xv.y)};
#pragma unroll
            for (int k = 0; k < 4; ++k) { const float sp = spv[k];
              const float r = sigm(raa[k] + baa[k]), ii = sigm(rxa[k] + bxa[k]); const float la = -8.f * r * sp;
              av[k] = __expf(la); const float mult = first ? 1.f : sqrtf(neg_expm1(2.f * la)); bv[k] = mult * ii * xca[k]; }
            *(float4*)(ab + (long)row * 512 + f) = float4{av[0], av[1], av[2], av[3]};
            *(float4*)(bb + (long)row * 512 + f) = float4{bv[0], bv[1], bv[2], bv[3]}; } }
        __syncthreads();
      }
    }
  }
  const int TID = fresh_tid(wv);
  GEMM_IDS
  for (int it = (int)gridDim.x - 1 - vid; it < 8 * 9; it += gridDim.x) {
    const int rg = it & 7, pn = it >> 3; const int row0 = MP + rg * 16;
    f32x4 c0, c1;
    if (pn < 5) {
      const int bcol = pn * 256;
      sgemm16(lane, (const u16*)(ws + WS_PROJ) + (long)row0 * NPJ + PC_CQ, NPJ, (const u16*)(ws + WS_WQ) + (long)bcol * 256, 256, 256, wid * 32, wid * 32 + 16, c0, c1);
      u16* qm = (u16*)(ws + WS_QMLA);
      if (pn < 4) {
#pragma unroll
        for (int j = 0; j < 4; ++j) { const long row = row0 + fq * 4 + j; qm[row * 1280 + bcol + wid * 32 + fr] = f2bf(c0[j] * QM_SCALE); qm[row * 1280 + bcol + wid * 32 + 16 + fr] = f2bf(c1[j] * QM_SCALE); }
      } else {
        const float2* rope = (const float2*)(ws + WS_ROPE);
#pragma unroll
        for (int j = 0; j < 4; ++j) { const int row = row0 + fq * 4 + j; const float2 cs = rope[row_pos(row) * 16 + fr];
          qm[(long)row * 1280 + 1024 + wid * 32 + fr] = f2bf((c0[j] * cs.x - c1[j] * cs.y) * QM_SCALE);
          qm[(long)row * 1280 + 1024 + wid * 32 + 16 + fr] = f2bf((c1[j] * cs.x + c0[j] * cs.y) * QM_SCALE); }
      }
    } else {
      const int pl = pn - 5;
      const u16* xc = (const u16*)(ws + WS_XC);
      sgemm16(lane, xc + (long)row0 * 512 + (pl >> 1) * 256, 512, (const u16*)(ws + WS_WLRU) + (long)pl * 256 * 256, 256, 256, wid * 16, 128 + wid * 16, c0, c1);
      const int f = pl * 128 + wid * 16 + fr;
      const float nl = -(p->in[26][l * 512 + f]); const float sp = softplus_f(nl);
      const float bav = p->in[23][l * 512 + f], bxv = p->in[25][l * 512 + f];
      float* ab = (float*)(ws + WS_A); float* bb = (float*)(ws + WS_B);
#pragma unroll
      for (int j = 0; j < 4; ++j) { const long row = row0 + fq * 4 + j;
        const float r = sigm(c0[j] + bav), ii = sigm(c1[j] + bxv); const float la = -8.f * r * sp;
        ab[row * 512 + f] = __expf(la); bb[row * 512 + f] = sqrtf(neg_expm1(2.f * la)) * ii * bf2f(xc[row * 512 + f]); }
    }
  }
}

DI void mla_task(const int TID, const u16* __restrict__ qbase, int nq, const u16* __restrict__ kck, const u16* __restrict__ kkr, const u16* __restrict__ vT, int ldv, int nkeys, u16* __restrict__ obase) {
  const int tid = TID, lane = tid & 63, hd = tid >> 6, r = lane & 31, h = lane >> 5;
  const u16* qp = qbase + (long)(r & (nq - 1)) * 1280;
  bf16x8 qf[10];
#pragma unroll
  for (int ks = 0; ks < 8; ++ks) qf[ks] = *(const bf16x8*)(qp + hd * 128 + ks * 16 + h * 8);
#pragma unroll
  for (int ks = 0; ks < 2; ++ks) qf[8 + ks] = *(const bf16x8*)(qp + 1024 + hd * 32 + ks * 16 + h * 8);
  f32x16 O[4];
#pragma unroll
  for (int i = 0; i < 4; ++i)
#pragma unroll
    for (int j = 0; j < 16; ++j) O[i][j] = 0.f;
  float m_run = -1e30f, l_run = 0.f;
  const int nt = (nkeys + 63) >> 6;
  const int wv = __builtin_amdgcn_readfirstlane(hd);
  const char* gp[5]; unsigned ginc[5];
#pragma unroll
  for (int i = 0; i < 5; ++i) {
    int g = wv + 8 * i; if (g > 38) g = 38;
    if (g < 21) { const int o = g * 1024 + lane * 16; const int row = o / 336, wi = o - row * 336;
      if (wi >= 256 && wi < 320) { gp[i] = (const char*)kkr + row * 64 + (wi - 256); ginc[i] = 64 * 64; }
      else { gp[i] = (const char*)kck + row * 256 + (wi < 256 ? wi : 0); ginc[i] = 64 * 256; } }
    else { const int o = (g - 21) * 1024 + lane * 16; const int row = o / 144, wi = o - row * 144;
      gp[i] = (const char*)vT + (long)row * ldv * 2 + (wi < 128 ? wi : 0); ginc[i] = 128; }
  }
#define MLA_ISSUE(buf) do { _Pragma("unroll") for (int i = 0; i < 5; ++i) { int g = wv + 8 * i; if (g > 38) g = 38; \
    __builtin_amdgcn_global_load_lds((const unsigned*)gp[i], (unsigned*)(smem + (buf) * 39936 + g * 1024), 16, 0, 0); gp[i] += ginc[i]; } } while (0)
#define MLA_QK(S, KT, KB) do { bf16x8 kfr[10]; \
    _Pragma("unroll") for (int ks = 0; ks < 10; ++ks) kfr[ks] = *(const bf16x8*)((KT) + ((KB) * 32 + r) * 336 + ks * 32 + h * 16); \
    _Pragma("unroll") for (int ks = 0; ks < 10; ++ks) { \
      if (ks == 0) S = __builtin_amdgcn_mfma_f32_32x32x16_bf16(kfr[ks], qf[ks], negm, 0, 0, 0); else S = __builtin_amdgcn_mfma_f32_32x32x16_bf16(kfr[ks], qf[ks], S, 0, 0, 0); } \
      \
    __builtin_amdgcn_sched_group_barrier(0x100, 5, 0); \
    _Pragma("unroll") for (int i = 0; i < 5; ++i) { __builtin_amdgcn_sched_group_barrier(0x008, 1, 0); __builtin_amdgcn_sched_group_barrier(0x100, 1, 0); } \
    __builtin_amdgcn_sched_group_barrier(0x008, 5, 0); } while (0)
#define MLA_SMPV(S, OTHER, VT, KB, T) do { \
    if (((T) == nt - 1) && (nkeys & 63)) { _Pragma("unroll") for (int j = 0; j < 16; ++j) if ((T) * 64 + (KB) * 32 + crow(j, h) >= nkeys) S[j] = -1e30f; } \
    float mx = S[0]; _Pragma("unroll") for (int j = 1; j < 16; ++j) mx = fmaxf(mx, S[j]); \
    if (first || __builtin_amdgcn_ballot_w64(mx > 8.f) != 0ull) { \
      mx = fmaxf(mx, __shfl_xor(mx, 32)); \
      const float d = first ? mx : fmaxf(mx, 0.f); \
      if (!first) { const float alpha = __builtin_amdgcn_exp2f(-d); l_run *= alpha; \
        _Pragma("unroll") for (int cb = 0; cb < 4; ++cb) _Pragma("unroll") for (int j = 0; j < 16; ++j) O[cb][j] *= alpha; } \
      _Pragma("unroll") for (int j = 0; j < 16; ++j) { S[j] -= d; negm[j] -= d; OTHER[j] -= d; } \
      first = false; } \
    float ls = 0.f; _Pragma("unroll") for (int j = 0; j < 16; ++j) { S[j] = __builtin_amdgcn_exp2f(S[j]); ls += S[j]; } \
    l_run += ls; \
    bf16x8 pk[2]; \
    _Pragma("unroll") for (int s2 = 0; s2 < 2; ++s2) { const uint4 w = uint4{pk2(S[8 * s2], S[8 * s2 + 1]), pk2(S[8 * s2 + 2], S[8 * s2 + 3]), pk2(S[8 * s2 + 4], S[8 * s2 + 5]), pk2(S[8 * s2 + 6], S[8 * s2 + 7])}; pk[s2] = __builtin_bit_cast(bf16x8, w); } \
    bf16x8 vfr[4][2]; \
    _Pragma("unroll") for (int cb = 0; cb < 4; ++cb) _Pragma("unroll") for (int s2 = 0; s2 < 2; ++s2) vfr[cb][s2] = *(const bf16x8*)((VT) + (cb * 32 + r) * 144 + ((KB) * 32 + 16 * s2) * 2 + h * 16); \
    _Pragma("unroll") for (int cb = 0; cb < 4; ++cb) _Pragma("unroll") for (int s2 = 0; s2 < 2; ++s2) O[cb] = __builtin_amdgcn_mfma_f32_32x32x16_bf16(vfr[cb][s2], pk[s2], O[cb], 0, 0, 0); \
    __builtin_amdgcn_sched_group_barrier(0x100, 4, 0); \
    _Pragma("unroll") for (int i = 0; i < 4; ++i) { __builtin_amdgcn_sched_group_barrier(0x008, 1, 0); __builtin_amdgcn_sched_group_barrier(0x100, 1, 0); } \
    __builtin_amdgcn_sched_group_barrier(0x008, 4, 0); } while (0)
  MLA_ISSUE(0);
  if (nt > 1) MLA_ISSUE(1);
  asm volatile("s_waitcnt vmcnt(0)" ::: "memory");
  __builtin_amdgcn_s_barrier();
  f32x16 sA, sB, negm;
#pragma unroll
  for (int j = 0; j < 16; ++j) { negm[j] = 0.f; sB[j] = 0.f; }
  bool first = true;
  MLA_QK(sA, smem, 0);
  int cur = 0;
#pragma unroll 1
  for (int t = 0; t < nt; ++t) {
    const int nx1 = (cur == 2) ? 0 : cur + 1, nx2 = (cur == 0) ? 2 : cur - 1;
    if (t + 2 < nt) MLA_ISSUE(nx2);
    const unsigned char* Kt = smem + cur * 39936; const unsigned char* Vt = Kt + 21504;
    MLA_QK(sB, Kt, 1);
    MLA_SMPV(sA, sB, Vt, 0, t);
    if (t + 1 < nt) MLA_QK(sA, smem + nx1 * 39936, 0);
    MLA_SMPV(sB, sA, Vt, 1, t);
    asm volatile("s_waitcnt vmcnt(0)" ::: "memory");
    asm volatile("s_waitcnt lgkmcnt(0)" ::: "memory");
    __builtin_amdgcn_s_barrier();
    cur = nx1;
  }
  const float lt = l_run + __shfl_xor(l_run, 32); const float inv = 1.f / lt;
  if (r < nq) {
    u16* op = obase + (long)r * 1024 + hd * 128;
#pragma unroll
    for (int cb = 0; cb < 4; ++cb)
#pragma unroll
      for (int g = 0; g < 4; ++g) { uint2 o; o.x = pk2(O[cb][4 * g] * inv, O[cb][4 * g + 1] * inv); o.y = pk2(O[cb][4 * g + 2] * inv, O[cb][4 * g + 3] * inv);
        *(uint2*)(op + cb * 32 + 8 * g + 4 * h) = o; }
  }
}

DI void diff_task(const int TID, const u16* __restrict__ qbase, const u16* __restrict__ zbase, u16* __restrict__ obase, int nq, int qpos0,
                  const u16* __restrict__ kbase, long kstride, const u16* __restrict__ vT, int ldv, int nkeys_total,
                  float lam, float oml, float slope2, const float* __restrict__ subg) {
  const int tid = TID, lane = tid & 63, w = tid >> 6, r = lane & 31, h = lane >> 5;
  const int qw0 = w * 32;
  const bool wactive = qw0 < nq;
  const int qr = (qw0 + r < nq) ? qw0 + r : 0;
  const int wl = (nq - 1) >> 5;
  const int ntmax = (min(nkeys_total, ((qpos0 + wl * 32) / 64 + 1) * 64) + 63) >> 6;
  const int kvis = min(nkeys_total, ((qpos0 + qw0) / 64 + 1) * 64);
  const int ntw = wactive ? ((kvis + 63) >> 6) : 0;
  const u16* qp = qbase + (long)qr * NPJ;
  bf16x8 qf[2][2];
#pragma unroll
  for (int c = 0; c < 2; ++c)
#pragma unroll
    for (int ks = 0; ks < 2; ++ks) qf[c][ks] = *(const bf16x8*)(qp + c * 32 + ks * 16 + h * 8);
  f32x16 O[2][2];
#pragma unroll
  for (int c = 0; c < 2; ++c)
#pragma unroll
    for (int vb = 0; vb < 2; ++vb)
#pragma unroll
      for (int j = 0; j < 16; ++j) O[c][vb][j] = 0.f;
  float m_run[2] = {-1e30f, -1e30f}, l_run[2] = {0.f, 0.f};
  const float qposf = (float)(qpos0 + qw0 + r);
  const float b0q = slope2 * ((float)(4 * h) - qposf);
  const int sr = tid >> 3, sc = tid & 7;
  const unsigned oDK = (unsigned)(sr * (int)kstride * 2 + sc * 16), oDV = (unsigned)(sr * ldv * 2 + sc * 16);
  uint4 g0, g1;
#define DF_GLOAD(t) do { g0 = *(const uint4*)((const char*)(kbase + (long)(t) * 64 * kstride) + oDK); g1 = *(const uint4*)((const char*)(vT + (long)(t) * 64) + oDV); } while (0)
#define DF_LSTORE(s) do { unsigned char* Kt = smem + (s) * 18432; *(uint4*)(Kt + sr * 144 + sc * 16) = g0; *(uint4*)(Kt + 9216 + sr * 144 + sc * 16) = g1; } while (0)
  DF_GLOAD(ntmax - 1); DF_LSTORE((ntmax - 1) & 1);
  __syncthreads();
  for (int t = ntmax - 1; t >= 0; --t) {
    if (t > 0) DF_GLOAD(t - 1);
    if (t < ntw - 1) {
      const unsigned char* Kt = smem + (t & 1) * 18432; const unsigned char* Vt = Kt + 9216;
#pragma unroll 1
      for (int kb = 1; kb >= 0; --kb) {
        bf16x8 vf[2][2];
#pragma unroll
        for (int vb = 0; vb < 2; ++vb)
#pragma unroll
          for (int s2 = 0; s2 < 2; ++s2) vf[vb][s2] = *(const bf16x8*)(Vt + (vb * 32 + r) * 144 + (kb * 32 + 16 * s2) * 2 + h * 16);
        const float dl = slope2 * (float)(t * 64 + kb * 32);
        f32x16 sc[2];
#pragma unroll
        for (int c = 0; c < 2; ++c) { const float u = b0q + dl - m_run[c];
#pragma unroll
          for (int j = 0; j < 16; ++j) sc[c][j] = fmaf(slope2, (float)((j & 3) + 8 * (j >> 2)), u); }
        bf16x8 kfr[2][2];
#pragma unroll
        for (int ks = 0; ks < 2; ++ks)
#pragma unroll
          for (int c = 0; c < 2; ++c) kfr[ks][c] = *(const bf16x8*)(Kt + (kb * 32 + r) * 144 + (c * 32 + ks * 16 + h * 8) * 2);
#pragma unroll
        for (int ks = 0; ks < 2; ++ks)
#pragma unroll
          for (int c = 0; c < 2; ++c) sc[c] = __builtin_amdgcn_mfma_f32_32x32x16_bf16(kfr[ks][c], qf[c][ks], sc[c], 0, 0, 0);
        __builtin_amdgcn_sched_group_barrier(0x100, 8, 0);
        __builtin_amdgcn_sched_group_barrier(0x008, 4, 0);
#pragma unroll
        for (int c = 0; c < 2; ++c) {
          float mx = sc[c][0];
#pragma unroll
          for (int j = 1; j < 16; ++j) mx = fmaxf(mx, sc[c][j]);
          if (__builtin_amdgcn_ballot_w64(mx > 8.f) != 0ull) {
            mx = fmaxf(mx, __shfl_xor(mx, 32));
            const float d = fmaxf(mx, 0.f); const float alpha = __builtin_amdgcn_exp2f(-d); m_run[c] += d; l_run[c] *= alpha;
#pragma unroll
            for (int vb = 0; vb < 2; ++vb)
#pragma unroll
              for (int j = 0; j < 16; ++j) O[c][vb][j] *= alpha;
#pragma unroll
            for (int j = 0; j < 16; ++j) sc[c][j] -= d;
          }
          float ls = 0.f;
#pragma unroll
          for (int j = 0; j < 16; ++j) { sc[c][j] = __builtin_amdgcn_exp2f(sc[c][j]); ls += sc[c][j]; }
          l_run[c] += ls;
#pragma unroll
          for (int s2 = 0; s2 < 2; ++s2) { const uint4 wv = uint4{pk2(sc[c][8 * s2], sc[c][8 * s2 + 1]), pk2(sc[c][8 * s2 + 2], sc[c][8 * s2 + 3]), pk2(sc[c][8 * s2 + 4], sc[c][8 * s2 + 5]), pk2(sc[c][8 * s2 + 6], sc[c][8 * s2 + 7])};
            const bf16x8 pk = __builtin_bit_cast(bf16x8, wv);
#pragma unroll
            for (int vb = 0; vb < 2; ++vb) O[c][vb] = __builtin_amdgcn_mfma_f32_32x32x16_bf16(vf[vb][s2], pk, O[c][vb], 0, 0, 0); }
        }
      }
    } else if (t < ntw) {
      const unsigned char* Kt = smem + (t & 1) * 18432; const unsigned char* Vt = Kt + 9216;
      const bool partial = (t * 64 + 64 > kvis);
#pragma unroll 1
      for (int kb = 1; kb >= 0; --kb) {
        bf16x8 vf[2][2];
#pragma unroll
        for (int vb = 0; vb < 2; ++vb)
#pragma unroll
          for (int s2 = 0; s2 < 2; ++s2) vf[vb][s2] = *(const bf16x8*)(Vt + (vb * 32 + r) * 144 + (kb * 32 + 16 * s2) * 2 + h * 16);
        const float kb0 = (float)(t * 64 + kb * 32 + 4 * h) - qposf;
#pragma unroll
        for (int c = 0; c < 2; ++c) {
          f32x16 s;
#pragma unroll
          for (int j = 0; j < 16; ++j) s[j] = 0.f;
#pragma unroll
          for (int ks = 0; ks < 2; ++ks) { bf16x8 a = *(const bf16x8*)(Kt + (kb * 32 + r) * 144 + (c * 32 + ks * 16 + h * 8) * 2); s = __builtin_amdgcn_mfma_f32_32x32x16_bf16(a, qf[c][ks], s, 0, 0, 0); }
#pragma unroll
          for (int j = 0; j < 16; ++j) { const float dk = kb0 + (float)((j & 3) + 8 * (j >> 2)); s[j] = fmaf(-slope2, fabsf(dk), s[j]); }
          if (partial) {
#pragma unroll
            for (int j = 0; j < 16; ++j) if (t * 64 + kb * 32 + crow(j, h) >= kvis) s[j] = -1e30f; }
          float mx = s[0];
#pragma unroll
          for (int j = 1; j < 16; ++j) mx = fmaxf(mx, s[j]);
          if (__builtin_amdgcn_ballot_w64(mx > m_run[c] + 8.f) != 0ull) {
            mx = fmaxf(mx, __shfl_xor(mx, 32));
            const float m_new = fmaxf(m_run[c], mx); const float alpha = __builtin_amdgcn_exp2f(m_run[c] - m_new); m_run[c] = m_new;
            l_run[c] *= alpha;
#pragma unroll
            for (int vb = 0; vb < 2; ++vb)
#pragma unroll
              for (int j = 0; j < 16; ++j) O[c][vb][j] *= alpha;
          }
          float ls = 0.f;
#pragma unroll
          for (int j = 0; j < 16; ++j) { s[j] = __builtin_amdgcn_exp2f(s[j] - m_run[c]); ls += s[j]; }
          l_run[c] += ls;
#pragma unroll
          for (int s2 = 0; s2 < 2; ++s2) { u32 w0 = pk2(s[8 * s2], s[8 * s2 + 1]), w1 = pk2(s[8 * s2 + 2], s[8 * s2 + 3]), w2 = pk2(s[8 * s2 + 4], s[8 * s2 + 5]), w3 = pk2(s[8 * s2 + 6], s[8 * s2 + 7]);
            uint4 wv = uint4{w0, w1, w2, w3}; bf16x8 pk = __builtin_bit_cast(bf16x8, wv);
#pragma unroll
            for (int vb = 0; vb < 2; ++vb) O[c][vb] = __builtin_amdgcn_mfma_f32_32x32x16_bf16(vf[vb][s2], pk, O[c][vb], 0, 0, 0); }
          __builtin_amdgcn_sched_barrier(0);
        }
      }
    }
    if (t > 0) DF_LSTORE((t - 1) & 1);
    __syncthreads();
  }
  if (wactive) {
    const float i0 = 1.f / (l_run[0] + __shfl_xor(l_run[0], 32)); const float i1 = lam / (l_run[1] + __shfl_xor(l_run[1], 32));
    float ss = 0.f;
#pragma unroll
    for (int vb = 0; vb < 2; ++vb)
#pragma unroll
      for (int j = 0; j < 16; ++j) { float o = O[0][vb][j] * i0 - O[1][vb][j] * i1; O[0][vb][j] = o; ss += o * o; }
    ss += __shfl_xor(ss, 32);
    const float rsd = rsqrtf(ss * (1.f / 64) + EPS) * oml;
    if (qw0 + r < nq) {
      const u16* zp = zbase + (long)(qw0 + r) * NPJ; u16* op = obase + (long)(qw0 + r) * NPJ;
#pragma unroll
      for (int vb = 0; vb < 2; ++vb)
#pragma unroll
        for (int g = 0; g < 4; ++g) { const int v0 = vb * 32 + 8 * g + 4 * h;
          uint2 z = *(const uint2*)(zp + v0); float4 gg = *(const float4*)(subg + v0);
          float y0 = O[0][vb][4 * g] * rsd * gg.x * silu(lo2f(z.x)), y1 = O[0][vb][4 * g + 1] * rsd * gg.y * silu(hi2f(z.x));
          float y2 = O[0][vb][4 * g + 2] * rsd * gg.z * silu(lo2f(z.y)), y3 = O[0][vb][4 * g + 3] * rsd * gg.w * silu(hi2f(z.y));
          uint2 o; o.x = pk2(y0, y1); o.y = pk2(y2, y3); *(uint2*)(op + v0) = o; }
    }
  }
}

DI void attn_phase(const int TID, KP p, int l, unsigned* ctr) {
  unsigned char* ws = p->ws;
  u16* proj = (u16*)(ws + WS_PROJ);
  const u16* qm = (const u16*)(ws + WS_QMLA);
  u16* olat = (u16*)(ws + WS_XN);
  const float* sc = (const float*)(ws + WS_CTL + 1024);
  const float* subg = p->in[19] + l * 64;
  volatile int* s_task = (volatile int*)(smem + TASK_OFF);
  for (;;) {
    int tid = TID; asm volatile("" : "+v"(tid));
    if (tid == 0) *s_task = (int)atomicAdd(ctr, 1u);
    __syncthreads();
    const int ti = *s_task;
    __syncthreads();
    if (ti >= g_tab.n) break;
    const u32 e = g_tab.t[ti]; const int ty = e >> 16, idx = e & 0xffff;
    if (ty == 0 || ty == 2) {
      const bool pr = (ty == 0);
      const int j = idx >> 5, b = pr ? ((idx >> 3) & 3) : (idx >> 3), hh = idx & 7;
      const long row0 = pr ? (long)b * TP + j * 256 : (long)MP + b * 16;
      const u16* kb = pr ? proj + (long)b * TP * NPJ + PC_KD + hh * 64 : (const u16*)(ws + WS_KDS) + (long)b * SKP * 512 + hh * 64;
      const u16* vt = pr ? (const u16*)(ws + WS_VDTP) + ((long)b * 512 + hh * 64) * TP : (const u16*)(ws + WS_VDTS) + ((long)b * 512 + hh * 64) * SKP;
      const float lam = sc[l * 2], oml = 1.f - sc[l * 2 + 1];
      for (int rep = 0; rep < REP_DIFF; ++rep) {
        diff_task(tid, proj + row0 * NPJ + PC_QD + hh * 64, proj + row0 * NPJ + PC_ZD + hh * 64, proj + row0 * NPJ + PC_VD + hh * 64, pr ? 256 : 16, pr ? j * 256 : PAST,
                kb, pr ? (long)NPJ : 512L, vt, pr ? TP : SKP, pr ? TP : SK, lam, oml, LOG2E * exp2f(-(float)(hh + 1)), subg);
        __syncthreads(); }
    } else if (ty == 1 || ty == 3) {
      const bool pr = (ty == 1);
      const int q32 = idx >> 2, b = pr ? (idx & 3) : idx;
      const long row0 = pr ? (long)b * TP + q32 * 32 : (long)MP + b * 16;
      const u16* kc = pr ? (const u16*)(ws + WS_CKVP) + (long)b * TP * 128 : (const u16*)(ws + WS_CKVS) + (long)b * SKP * 128;
      const u16* kr = pr ? (const u16*)(ws + WS_KRP) + (long)b * TP * 32 : (const u16*)(ws + WS_KRS) + (long)b * SKP * 32;
      const u16* vt = pr ? (const u16*)(ws + WS_CKVTP) + (long)b * 128 * TP : (const u16*)(ws + WS_CKVTS) + (long)b * 128 * SKP;
      for (int rep = 0; rep < REP_MLA; ++rep) {
        mla_task(tid, qm + row0 * 1280, pr ? 32 : 16, kc, kr, vt, pr ? TP : SKP, pr ? (q32 / 2 + 1) * 64 : SK, olat + row0 * 1024);
        __syncthreads(); }
    } else {
      const int b = idx >> 6, c = idx & 63; const long row0 = (long)b * TP + c * 64;
      const float* ab = (const float*)(ws + WS_A) + row0 * 512 + tid; const float* bb = (const float*)(ws + WS_B) + row0 * 512 + tid;
      float A = 1.f, B = 0.f;
#pragma unroll 16
      for (int i = 0; i < 64; ++i) { float a = ab[i * 512], x = bb[i * 512]; B = a * B + x; A *= a; }
      ((float2*)(ws + WS_SCAN))[(long)idx * 512 + tid] = float2{A, B};
    }
    __syncthreads();
  }
}

DI void uvscan_phase(const int TID_in, KP p, int l, int vid) {
  const int wv = __builtin_amdgcn_readfirstlane(TID_in >> 6);
  unsigned char* ws = p->ws;
  u16* proj = (u16*)(ws + WS_PROJ);
  f32x4 acc[2][2][4][2];
  for (int it = vid; it < 64 * 2 + 258 + 16; it += gridDim.x) {
    if (it < 64 * 2) {
      int pm, pn; tile_coords(it, 64, 2, pm, pn);
      const int brow = pm * 256, bcol = pn * 256;
      gemm_kloop8(fresh_tid(wv), (const u16*)(ws + WS_XN) + (long)brow * 1024 + pn * 512, 1024, (const u16*)(ws + WS_WUV) + (long)bcol * 512, 512, 8, acc);
      const int TID = fresh_tid(wv);
      GEMM_IDS
      const int oz = opaque_zero(); const int browz = brow + oz;
      u16* pz = proj + oz;
#pragma unroll
      for (int ai = 0; ai < 2; ++ai) {
        ACC_TO_LDS(ai);
        __syncthreads();
        EPI_ROWS_BEGIN(ai)
          u16* q = pz + (long)row * NPJ + PC_ZMLA + col; const uint2 z = *(const uint2*)q;
          *(uint2*)(q + (PC_QD - PC_ZMLA)) = pk4(v.x * silu(lo2f(z.x)), v.y * silu(hi2f(z.x)), v.z * silu(lo2f(z.y)), v.w * silu(hi2f(z.y)));
        EPI_ROWS_END
        __syncthreads();
      }
    } else {
      const int TID = fresh_tid(wv);
      GEMM_IDS
      const int s = it - 64 * 2;
      if (s >= 258) {
        const int q = s - 258; const int rg = q & 7, pn = q >> 3; const int row0 = MP + rg * 16, bcol = pn * 256;
        f32x4 c0, c1;
        sgemm16(lane, (const u16*)(ws + WS_XN) + (long)row0 * 1024 + pn * 512, 1024, (const u16*)(ws + WS_WUV) + (long)bcol * 512, 512, 512, wid * 32, wid * 32 + 16, c0, c1);
#pragma unroll
        for (int j = 0; j < 4; ++j) { const long row = row0 + fq * 4 + j; u16* q0 = proj + row * NPJ + PC_ZMLA + bcol + wid * 32 + fr;
          q0[PC_QD - PC_ZMLA] = f2bf(c0[j] * silu(bf2f(q0[0]))); q0[PC_QD - PC_ZMLA + 16] = f2bf(c1[j] * silu(bf2f(q0[16]))); }
        continue;
      }
      float hh; long row0; int nsteps; float* hout;
      if (s < 256) { const int b = s >> 6, c = s & 63; row0 = (long)b * TP + c * 64; nsteps = 64; hh = 0.f;
        const float2* sm = (const float2*)(ws + WS_SCAN) + (long)(b * 64) * 512 + tid;
        { int cc = 0;
          for (; cc + 16 <= c; cc += 16) { float2 t[16];
#pragma unroll
            for (int q = 0; q < 16; ++q) t[q] = sm[(long)(cc + q) * 512];
#pragma unroll
            for (int q = 0; q < 16; ++q) hh = t[q].x * hh + t[q].y; }
          for (; cc < c; ++cc) { float2 ab2 = sm[(long)cc * 512]; hh = ab2.x * hh + ab2.y; } }
        hout = (c == 63) ? p->out + O_PH + ((long)l * 4 + b) * 512 + tid : nullptr;
      } else { const int sb = (s - 256) * 4 + 0; (void)sb; row0 = 0; nsteps = 0; hh = 0.f; hout = nullptr; }
      if (s < 256) {
        const float* ab = (const float*)(ws + WS_A) + row0 * 512 + tid; const float* bb = (const float*)(ws + WS_B) + row0 * 512 + tid;
        u16* zp = proj + row0 * NPJ + PC_ZL + tid;
#pragma unroll 16
        for (int i = 0; i < nsteps; ++i) { float a = ab[(long)i * 512], x = bb[(long)i * 512]; float z = bf2f(zp[(long)i * NPJ]); hh = a * hh + x; zp[(long)i * NPJ + (PC_KD - PC_ZL)] = f2bf(hh * silu(z)); }
        if (hout) *hout = hh;
      } else {
        for (int q = 0; q < 4; ++q) { const int sb = (s - 256) * 4 + q; const long r0 = MP + sb * 16;
          float h2 = p->in[6][((long)l * 8 + sb) * 512 + tid];
          const float* ab = (const float*)(ws + WS_A) + r0 * 512 + tid; const float* bb = (const float*)(ws + WS_B) + r0 * 512 + tid;
          u16* zp = proj + r0 * NPJ + PC_ZL + tid;
#pragma unroll 16
          for (int i = 0; i < 16; ++i) { float a = ab[(long)i * 512], x = bb[(long)i * 512]; float z = bf2f(zp[(long)i * NPJ]); h2 = a * h2 + x; zp[(long)i * NPJ + (PC_KD - PC_ZL)] = f2bf(h2 * silu(z)); }
          p->out[O_SH + ((long)l * 8 + sb) * 512 + tid] = h2; }
      }
    }
  }
}

DI void oproj_phase(const int TID, KP p, int l, int vid) {
  GEMM_IDS
  unsigned char* ws = p->ws;
  f32x4 acc[1][2][4][2];
  for (int tile = vid; tile < 128 * 4; tile += gridDim.x) {
    int pm, pn; tile_coords(tile, 128, 4, pm, pn);
    const int brow = pm * 128, bcol = pn * 256;
    float4 mreg[16];
#pragma unroll
    for (int i = 0; i < 16; ++i) mreg[i] = float4{0.f, 0.f, 0.f, 0.f};
#pragma unroll 1
    for (int b = 0; b < 3; ++b) {
      const int acol = (b == 0) ? PC_QD : (b == 1) ? PC_VD : PC_KD;
      gemm_kloop_r3(TID, (const u16*)(ws + WS_PROJ) + (long)brow * NPJ + acol, NPJ, (const u16*)(ws + WS_WO) + ((long)b * 1024 + bcol) * 512, 512, 8, acc);
      const int oz = opaque_zero(); const int browz = brow + oz;
      const u16* gp = (const u16*)(ws + WS_PROJ) + oz + PC_G + b * 1024 + bcol;
      ACC_TO_LDS(0);
      __syncthreads();
#pragma unroll
      for (int it = 0; it < 16; ++it) { const int idx = it * 512 + tid; const int rl = idx >> 6, cl = (idx & 63) * 4;
        const float4 v = *(const float4*)((const float*)smem + rl * EP_LD + cl);
        const uint2 g = *(const uint2*)(gp + (long)(browz + rl) * NPJ + cl);
        mreg[it].x += lo2f(g.x) * v.x; mreg[it].y += hi2f(g.x) * v.y; mreg[it].z += lo2f(g.y) * v.z; mreg[it].w += hi2f(g.y) * v.w; }
      __syncthreads();
    }
    { const int oz = opaque_zero(); u16* mg = (u16*)(ws + WS_XN) + oz;
#pragma unroll
      for (int it = 0; it < 16; ++it) { const int idx = it * 512 + tid; const int rl = idx >> 6, cl = (idx & 63) * 4;
        *(uint2*)(mg + (long)(brow + rl) * 1024 + bcol + cl) = pk4(mreg[it].x, mreg[it].y, mreg[it].z, mreg[it].w); } }
  }
  for (int it = (int)gridDim.x - 1 - vid; it < 8 * 4; it += gridDim.x) {
    const int rg = it & 7, pn = it >> 3; const int row0 = MP + rg * 16, bcol = pn * 256;
    const u16* proj = (const u16*)(ws + WS_PROJ); u16* mg = (u16*)(ws + WS_XN);
    float m0[4] = {0.f, 0.f, 0.f, 0.f}, m1[4] = {0.f, 0.f, 0.f, 0.f};
#pragma unroll 1
    for (int b = 0; b < 3; ++b) {
      const int acol = (b == 0) ? PC_QD : (b == 1) ? PC_VD : PC_KD;
      f32x4 c0, c1;
      sgemm16(lane, proj + (long)row0 * NPJ + acol, NPJ, (const u16*)(ws + WS_WO) + ((long)b * 1024 + bcol) * 512, 512, 512, wid * 32, wid * 32 + 16, c0, c1);
#pragma unroll
      for (int j = 0; j < 4; ++j) { const long row = row0 + fq * 4 + j; const u16* g = proj + row * NPJ + PC_G + b * 1024 + bcol + wid * 32 + fr;
        m0[j] += bf2f(g[0]) * c0[j]; m1[j] += bf2f(g[16]) * c1[j]; }
    }
#pragma unroll
    for (int j = 0; j < 4; ++j) { const long row = row0 + fq * 4 + j; u16* q = mg + row * 1024 + bcol + wid * 32 + fr; q[0] = f2bf(m0[j]); q[16] = f2bf(m1[j]); }
  }
}

DI void wout_phase(const int TID_in, KP p, int l, int vid, float* outp) {
  const int wv = __builtin_amdgcn_readfirstlane(TID_in >> 6);
  unsigned char* ws = p->ws;
  f32x4 acc[2][2][4][2];
  for (int tile = vid; tile < 64 * 4; tile += gridDim.x) {
    int pm, pn; tile_coords(tile, 64, 4, pm, pn);
    const int brow = pm * 256, bcol = pn * 256;
    gemm_kloop8(fresh_tid(wv), (const u16*)(ws + WS_XN) + (long)brow * 1024, 1024, (const u16*)(ws + WS_WOUT) + (long)bcol * 1024, 1024, 16, acc);
    const int TID = fresh_tid(wv);
    GEMM_IDS
    const int oz = opaque_zero(); const int browz = brow + oz;
    float* out = outp + oz;
#pragma unroll
    for (int ai = 0; ai < 2; ++ai) {
      ACC_TO_LDS(ai);
      __syncthreads();
      EPI_ROWS_BEGIN(ai)
        if (row < M) { const float4 xo = (l == 0) ? (row < MP ? *(const float4*)(p->in[0] + (long)row * D + col) : *(const float4*)(p->in[1] + (long)(row - MP) * D + col)) : *(const float4*)(out + (long)row * D + col);
          *(float4*)(out + (long)row * D + col) = float4{xo.x + v.x, xo.y + v.y, xo.z + v.z, xo.w + v.w}; }
      EPI_ROWS_END
      __syncthreads();
    }
  }
  const int TID = fresh_tid(wv);
  GEMM_IDS
  for (int it = (int)gridDim.x - 1 - vid; it < 8 * 4; it += gridDim.x) {
    const int rg = it & 7, pn = it >> 3; const int row0 = MP + rg * 16, bcol = pn * 256;
    f32x4 c0, c1;
    sgemm16(lane, (const u16*)(ws + WS_XN) + (long)row0 * 1024, 1024, (const u16*)(ws + WS_WOUT) + (long)bcol * 1024, 1024, 1024, wid * 32, wid * 32 + 16, c0, c1);
#pragma unroll
    for (int j = 0; j < 4; ++j) { const int row = row0 + fq * 4 + j; const int col = bcol + wid * 32 + fr;
      const float* xo = (l == 0) ? p->in[1] + (long)(row - MP) * D + col : outp + (long)row * D + col;
      const float x0 = xo[0], x1 = xo[16];
      outp[(long)row * D + col] = x0 + c0[j]; outp[(long)row * D + col + 16] = x1 + c1[j]; }
  }
}

DI void final_phase(const int TID, KP p) {
  const int lane = TID & 63, wid = TID >> 6;
  const float* g = p->in[31];
  for (int row = blockIdx.x * 8 + wid; row < M; row += gridDim.x * 8) {
    float* src = p->out + (long)row * D;
    float4 v[4]; float ss = 0.f;
#pragma unroll
    for (int i = 0; i < 4; ++i) { v[i] = *(const float4*)(src + i * 256 + lane * 4); ss += v[i].x * v[i].x + v[i].y * v[i].y + v[i].z * v[i].z + v[i].w * v[i].w; }
    ss = wsum(ss); const float rs = rsqrtf(ss * (1.f / D) + EPS);
#pragma unroll
    for (int i = 0; i < 4; ++i) { float4 gg = *(const float4*)(g + i * 256 + lane * 4);
      *(float4*)(src + i * 256 + lane * 4) = float4{v[i].x * rs * gg.x, v[i].y * rs * gg.y, v[i].z * rs * gg.z, v[i].w * rs * gg.w}; }
  }
}


#define XB_TMO      128
#define XB_XCNT(j)  (256  + 64 * (j))
#define XB_XSUB(j)  (1280 + 64 * (j))
#define XB_XGEN(j)  (2304 + 64 * (j))
#define XB_TOP      3328
#define XB_TOPGEN   3392
#define XCD_BAR_WORDS 3456
#define XB_SPIN_CAP (1u << 22)
#define LAS __attribute__((address_space(3)))
DI unsigned xb_ld(unsigned* p) { return __hip_atomic_load(p, __ATOMIC_RELAXED, __HIP_MEMORY_SCOPE_AGENT); }
DI unsigned xb_add(unsigned* p, unsigned v) { return __hip_atomic_fetch_add(p, v, __ATOMIC_RELAXED, __HIP_MEMORY_SCOPE_AGENT); }
DI unsigned xb_xcc_id() { return (unsigned)__builtin_amdgcn_s_getreg((3 << 11) | 20) & 0xFu; }
#define XB_SPIN(cond, bar) do { unsigned _sp = 0; while (cond) { __builtin_amdgcn_s_sleep(1); \
    if ((++_sp & 255u) == 0u) { if (xb_ld(&(bar)[XB_TMO])) break; if (_sp > XB_SPIN_CAP) { atomicAdd(&(bar)[XB_TMO], 1u); break; } } } } while (0)
DI void xcd_barrier_complete(unsigned* bar, unsigned x, unsigned& nloc, unsigned& nx) {
  const unsigned G = gridDim.x;
  unsigned sum, cnt, mine, sp = 0u;
  for (;;) {
    sum = 0u; cnt = 0u; mine = 0u;
#pragma unroll
    for (unsigned j = 0; j < 16; ++j) { const unsigned c = xb_ld(&bar[XB_XCNT(j)]); sum += c; cnt += (c > 0u) ? 1u : 0u; mine = (j == x) ? c : mine; }
    if (sum == G) break;
    __builtin_amdgcn_s_sleep(1);
    if ((++sp & 255u) == 0u) { if (xb_ld(&bar[XB_TMO])) break; if (sp > XB_SPIN_CAP) { atomicAdd(&bar[XB_TMO], 1u); break; } }
  }
  nloc = mine > 0u ? mine : 1u; nx = cnt > 0u ? cnt : 1u;
}
DI void xcd_barrier(const int TID, unsigned* bar, unsigned x) {
  volatile LAS unsigned* st = (volatile LAS unsigned*)(smem + TASK_OFF + 16);
  asm volatile("s_waitcnt vmcnt(0)" ::: "memory");
  __syncthreads();
  if (TID == 0) {
    __builtin_amdgcn_s_waitcnt(0);
    unsigned nloc = st[0], nx = st[1];
    if (nloc == 0u) { xcd_barrier_complete(bar, x, nloc, nx); st[0] = nloc; st[1] = nx; }
    const unsigned old = xb_add(&bar[XB_XSUB(x)], 1u);
    const unsigned gen = old / nloc;
    if (old + 1u == (gen + 1u) * nloc) {
      __builtin_amdgcn_fence(__ATOMIC_RELEASE, "agent");
      asm volatile("s_waitcnt vmcnt(0)" ::: "memory");
      const unsigned og = xb_add(&bar[XB_TOP], 1u);
      const unsigned tg = og / nx;
      if (og + 1u == (tg + 1u) * nx) xb_add(&bar[XB_TOPGEN], 1u);
      else XB_SPIN(xb_ld(&bar[XB_TOPGEN]) == tg, bar);
      __builtin_amdgcn_fence(__ATOMIC_ACQUIRE, "agent");
      xb_add(&bar[XB_XGEN(x)], 1u);
      asm volatile("s_waitcnt vmcnt(0)" ::: "memory");
    } else {
      XB_SPIN(xb_ld(&bar[XB_XGEN(x)]) == gen, bar);
      __builtin_amdgcn_fence(__ATOMIC_ACQUIRE, "agent");
      asm volatile("s_waitcnt vmcnt(0)" ::: "memory");
    }
  }
  __syncthreads();
}

__global__ void __launch_bounds__(512, 2) mega(Params p_) {
  const int wave_s = __builtin_amdgcn_readfirstlane((int)(__builtin_amdgcn_workitem_id_x() >> 6));
  const int G = gridDim.x, bx = blockIdx.x;
  const int vid = (G % 8 == 0) ? (bx % 8) * (G / 8) + bx / 8 : bx;
  const int ph_lo = p_.ph_lo, ph_hi = p_.ph_hi;
  const unsigned xcc = xb_xcc_id();
  { const int t0 = __builtin_amdgcn_workitem_id_x(); if (t0 < 4) ((volatile LAS unsigned*)(smem + TASK_OFF))[4 + t0] = 0u; __syncthreads();
    if (t0 == 0) (void)xb_add((unsigned*)(p_.ws + WS_BAR) + XB_XCNT(xcc), 1u); }
  if (ph_hi - ph_lo > 1) cg::this_grid().sync();
  for (int ph = ph_lo; ph < ph_hi; ++ph) {
    int TID; asm volatile("v_mbcnt_lo_u32_b32 %0, -1, 0\n\tv_mbcnt_hi_u32_b32 %0, -1, %0" : "=v"(TID)); TID += wave_s * 64;
    KP p = (KP)__builtin_amdgcn_kernarg_segment_ptr(); asm volatile("" : "+s"(p));
    unsigned* ctrs = (unsigned*)(p->ws + WS_CTL);
    if (ph == NPH - 1) final_phase(TID, p);
    else {
      const int l = ph >> 3, s = ph & 7;
      switch (s) {
        case 0: for (int rep = 0; rep < REP_PREP; ++rep) { prep_phase(TID, p, l); __syncthreads(); } break;
        case 1: for (int rep = 0; rep < REP_INPROJ; ++rep) { inproj_phase(TID, p, l, vid); __syncthreads(); } break;
        case 2: mid_phase(TID, p, l); break;
        case 3: for (int rep = 0; rep < REP_QLRU; ++rep) { qlru_phase(TID, p, l, vid); __syncthreads(); } break;
        case 4: for (int rep = 0; rep < REP_ATTN; ++rep) { attn_phase(TID, p, l, ctrs + ph + 64 * rep); __syncthreads(); } break;
        case 5: for (int rep = 0; rep < REP_UVSCAN; ++rep) { uvscan_phase(TID, p, l, vid); __syncthreads(); } break;
        case 6: for (int rep = 0; rep < REP_OPROJ; ++rep) { oproj_phase(TID, p, l, vid); __syncthreads(); } break;
        default: wout_phase(TID, p, l, vid, p->out); break;
      }
    }
    if (TAIL_PHASE >= 0 && ph == NPH - 1) {
      for (int rep = 0; rep < TAIL_REPS; ++rep) {
        xcd_barrier(TID, (unsigned*)(p->ws + WS_BAR), xcc);
        if (TAIL_PHASE == 2) mid_phase(TID, p, 3);
        else if (TAIL_PHASE == 7) wout_phase(TID, p, 3, vid, (float*)(p->ws + WS_PROJ));
        else if (TAIL_PHASE == 1) inproj_phase(TID, p, 3, vid);
        else if (TAIL_PHASE == 6) oproj_phase(TID, p, 3, vid);
        else if (TAIL_PHASE == 8) final_phase(TID, p);
        __syncthreads();
      }
    }
    if (ph + 1 < ph_hi) {
      xcd_barrier(TID, (unsigned*)(p->ws + WS_BAR), xcc);
      for (int e = 0; e < EXTRA_SYNC; ++e) xcd_barrier(TID, (unsigned*)(p->ws + WS_BAR), xcc);
    }
  }
}

extern "C" void kernel_launch(void* const* d_in, const int* in_sizes, int n_in, void* d_out, int out_size, void* d_ws, size_t ws_size, hipStream_t stream) {
  static int grid = 0;
  if (grid == 0) {
    if (n_in != 32 || (long)out_size != O_END || ws_size < WS_END) { fprintf(stderr, "kernel_launch: unexpected shapes (n_in %d out %d ws %zu need %zu)\n", n_in, out_size, ws_size, (size_t)WS_END); grid = -1; return; }
    int dev = 0, cus = 0, per_cu = 0;
    (void)hipGetDevice(&dev); (void)hipDeviceGetAttribute(&cus, hipDeviceAttributeMultiprocessorCount, dev);
    if (hipFuncSetAttribute((const void*)mega, hipFuncAttributeMaxDynamicSharedMemorySize, LDS_BYTES) != hipSuccess) { fprintf(stderr, "hipFuncSetAttribute failed\n"); grid = -1; return; }
    if (hipOccupancyMaxActiveBlocksPerMultiprocessor(&per_cu, (const void*)mega, 512, LDS_BYTES) != hipSuccess || per_cu < 1) { fprintf(stderr, "occupancy query failed (%d)\n", per_cu); per_cu = 1; }
    (void)hipGetLastError();
    grid = cus;
  }
  if (grid < 0) return;
  (void)hipMemsetAsync((char*)d_ws + WS_CTL, 0, WS_ROPE, stream);
  Params p{};
  for (int i = 0; i < 32; ++i) p.in[i] = (const float*)d_in[i];
  p.out = (float*)d_out; p.ws = (unsigned char*)d_ws;
#if ONE_LAUNCH
  p.ph_lo = 0; p.ph_hi = NPH;
  void* args[] = {&p};
  hipError_t e = hipLaunchCooperativeKernel((const void*)mega, dim3(grid), dim3(512), args, LDS_BYTES, stream);
  if (e != hipSuccess) fprintf(stderr, "cooperative launch failed: %s\n", hipGetErrorString(e));
#else
  for (int ph = 0; ph < NPH; ++ph) { p.ph_lo = ph; p.ph_hi = ph + 1; hipLaunchKernelGGL(mega, dim3(grid), dim3(512), LDS_BYTES, stream, p); }
#endif
}
```

```cpp
#include <hip/hip_runtime.h>
#include <hip/hip_cooperative_groups.h>
#include <cstdio>
namespace cg = cooperative_groups;

#ifndef ONE_LAUNCH
#define ONE_LAUNCH 1
#endif
#define REP_PREP 1
#define REP_INPROJ 1
#define REP_QLRU 1
#define REP_ATTN 1
#define REP_OPROJ 1
#define REP_UVSCAN 1
#define TAIL_PHASE -1
#define TAIL_REPS 4
#define REP_MLA 1
#define REP_DIFF 1
#define EXTRA_SYNC 0

typedef unsigned short u16;
typedef unsigned int u32;
using bf16x8 = __attribute__((ext_vector_type(8))) short;
using s16x4  = __attribute__((ext_vector_type(4))) short;
using f32x4  = __attribute__((ext_vector_type(4))) float;
using f32x16 = __attribute__((ext_vector_type(16))) float;
typedef float f32x2 __attribute__((ext_vector_type(2)));
typedef __bf16 bf16x2 __attribute__((ext_vector_type(2)));
#define DI __device__ __forceinline__

constexpr int D = 1024, TP = 4096, MP = 16384, TS = 16, MS = 128, M = MP + MS, MT = 65, MPAD = MT * 256;
constexpr int PAST = 2048, SK = PAST + TS, SKP = 2112;
constexpr int NIN = 7072, NPJ = 7168, DEPTH = 4;
constexpr float EPS = 1e-6f;
constexpr float LOG2E = 1.4426950408889634f;
constexpr float QM_SCALE = 0.10206207261596575f * LOG2E;
constexpr float QD_SCALE = 0.17677669529663687f * LOG2E;
constexpr int PC_CQ = 0, PC_CKV = 256, PC_KR = 384, PC_ZMLA = 512, PC_QD = 1024, PC_KD = 1536, PC_VD = 2048, PC_ZD = 2560,
              PC_XL = 3072, PC_ZL = 3584, PC_G = 4096;
constexpr long O_YP = 0, O_YS = O_YP + (long)MP * D, O_PCKV = O_YS + (long)MS * D, O_PKR = O_PCKV + 4L * MP * 128,
               O_PDK = O_PKR + 4L * MP * 32, O_PDV = O_PDK + 4L * MP * 512, O_PH = O_PDV + 4L * MP * 512, O_PCV = O_PH + 4L * 4 * 512,
               O_SCKV = O_PCV + 4L * 4 * 3 * 512, O_SKR = O_SCKV + 4L * MS * 128, O_SDK = O_SKR + 4L * MS * 32, O_SDV = O_SDK + 4L * MS * 512,
               O_SH = O_SDV + 4L * MS * 512, O_SCV = O_SH + 4L * 8 * 512, O_END = O_SCV + 4L * 8 * 3 * 512;
constexpr size_t al(size_t x) { return (x + 255) & ~(size_t)255; }
constexpr size_t WS_CTL = 0, WS_BAR = 4096, WS_ROPE = 20480, WS_WIN = WS_ROPE + al(4096 * 16 * 8), WS_WQ = WS_WIN + al((size_t)NPJ * 1024 * 2),
                 WS_WUV = WS_WQ + al(1280 * 256 * 2), WS_WO = WS_WUV + al(512 * 512 * 2), WS_WOUT = WS_WO + al(3 * 1024 * 512 * 2),
                 WS_WLRU = WS_WOUT + al(1024 * 1024 * 2), WS_XN = WS_WLRU + al(1024 * 256 * 2), WS_PROJ = WS_XN + al((size_t)MPAD * 1024 * 2),
                 WS_QMLA = WS_PROJ + al((size_t)MPAD * NPJ * 2), WS_XC = WS_QMLA + al((size_t)MPAD * 1280 * 2), WS_A = WS_XC + al((size_t)MPAD * 512 * 2),
                 WS_B = WS_A + al((size_t)M * 512 * 4), WS_SCAN = WS_B + al((size_t)M * 512 * 4), WS_CKVP = WS_SCAN + al(4 * 64 * 512 * 8),
                 WS_CKVTP = WS_CKVP + al((size_t)MP * 128 * 2), WS_KRP = WS_CKVTP + al((size_t)MP * 128 * 2), WS_VDTP = WS_KRP + al((size_t)MP * 32 * 2),
                 WS_CKVS = WS_VDTP + al((size_t)MP * 512 * 2), WS_CKVTS = WS_CKVS + al(8 * SKP * 128 * 2), WS_KRS = WS_CKVTS + al(8 * SKP * 128 * 2),
                 WS_KDS = WS_KRS + al(8 * SKP * 32 * 2), WS_VDTS = WS_KDS + al((size_t)8 * SKP * 512 * 2), WS_END = WS_VDTS + al((size_t)8 * SKP * 512 * 2);
constexpr int EP_LD = 260;
constexpr int LDS_BYTES = 147456 + 256;
constexpr int TASK_OFF = 147456;
constexpr int NPH = 33;

struct Params { const float* in[32]; float* out; unsigned char* ws; int ph_lo, ph_hi; };
typedef const Params __attribute__((address_space(4)))* KP;

extern __shared__ __attribute__((aligned(16))) unsigned char smem[];

DI float bf2f(u16 v) { return __uint_as_float((u32)v << 16); }
DI u32 pk2(float a, float b) { f32x2 v = {a, b}; bf16x2 r = __builtin_convertvector(v, bf16x2); return __builtin_bit_cast(u32, r); }
DI u16 f2bf(float a) { return (u16)(pk2(a, 0.f) & 0xffffu); }
DI float lo2f(u32 v) { return __uint_as_float(v << 16); }
DI float hi2f(u32 v) { return __uint_as_float(v & 0xffff0000u); }
DI float sigm(float x) { return 1.f / (1.f + __expf(-x)); }
DI float silu(float x) { return x / (1.f + __expf(-x)); }
DI float softplus_f(float x) { return fmaxf(x, 0.f) + __logf(1.f + __expf(-fabsf(x))); }
DI float neg_expm1(float x) { const float t = x * (1.f + x * (0.5f + x * (0.16666667f + x * 0.041666668f))); return (x > -0.1f) ? -t : 1.f - __expf(x); }
DI float wsum(float v) { for (int o = 32; o; o >>= 1) v += __shfl_xor(v, o); return v; }
DI int kperm(int k) { int q = (k >> 2) & 3; q = (q == 1) ? 2 : (q == 2) ? 1 : q; return (k & ~15) | (q << 2) | (k & 3); }
DI int crow(int reg, int h) { return (reg & 3) + 8 * (reg >> 2) + 4 * h; }
DI int row_pos(int row) { return row < MP ? (row & (TP - 1)) : PAST + ((row - MP) & 15); }

struct TaskTab { int n; u32 t[1408]; };
constexpr TaskTab make_tab() {
  TaskTab x{}; int n = 0;
  for (int i = 0; i < 64; ++i) x.t[n++] = (2u << 16) | i;
  for (int i = 0; i < 8; ++i) x.t[n++] = (3u << 16) | i;
  for (int L = 144; L >= 1; --L) {
    for (int j = 0; j < 16; ++j) if (9 * (j + 1) == L) for (int i = 0; i < 32; ++i) x.t[n++] = (0u << 16) | (j * 32 + i);
    for (int q = 0; q < 128; ++q) if (q / 2 + 1 == L) for (int b = 0; b < 4; ++b) x.t[n++] = (1u << 16) | (q * 4 + b);
  }
  for (int i = 0; i < 256; ++i) x.t[n++] = (4u << 16) | i;
  x.n = n; return x;
}
__device__ const TaskTab g_tab = make_tab();
__device__ const float g_invf[16] = {1.0f, 0.5623413251903491f, 0.31622776601683794f, 0.1778279410038923f, 0.1f, 0.05623413251903491f,
  0.031622776601683794f, 0.01778279410038923f, 0.01f, 0.005623413251903491f, 0.0031622776601683794f, 0.001778279410038923f, 0.001f,
  0.0005623413251903491f, 0.00031622776601683794f, 0.0001778279410038923f};

DI int lds_byte(int r, int c) { int st = (r >> 4) * 2 + (c >> 5), rr = r & 15, cc = c & 31, ob = rr * 64 + cc * 2; return st * 1024 + (ob ^ (((ob >> 9) & 1) << 5)); }
DI void stage_rc(int b, int& R, int& C) { int st = b >> 10, sb = b & 1023, swz = sb ^ (((sb >> 9) & 1) << 5); R = (st >> 1) * 16 + (swz >> 6); C = (st & 1) * 32 + ((swz & 63) >> 1); }

#define SA(b, h) (smem + ((b) * 2 + (h)) * 16384)
#define SB(b, h) (smem + (4 + (b) * 2 + (h)) * 16384)
#define STAGE_A(P, half, kt) do { const u16* _g = A + (long)(half) * 128 * lda + (long)(kt) * 64; \
    __builtin_amdgcn_global_load_lds((const unsigned*)(_g + offA0), (unsigned*)((P) + wbase), 16, 0, 0); \
    __builtin_amdgcn_global_load_lds((const unsigned*)(_g + 64 * lda + offA0), (unsigned*)((P) + wbase + 8192), 16, 0, 0); } while (0)
#define STAGE_B(P, half, kt) do { const u16* _g = Bt + (long)(half) * 128 * ldb + (long)(kt) * 64; \
    __builtin_amdgcn_global_load_lds((const unsigned*)(_g + offB0), (unsigned*)((P) + wbase), 16, 0, 0); \
    __builtin_amdgcn_global_load_lds((const unsigned*)(_g + 64 * ldb + offB0), (unsigned*)((P) + wbase + 8192), 16, 0, 0); } while (0)
#define LDA(dst, b, h) _Pragma("unroll") for (int m = 0; m < 4; ++m) _Pragma("unroll") for (int k = 0; k < 2; ++k) \
    dst[m][k] = *reinterpret_cast<const bf16x8*>(SA(b, h) + lds_byte(wr * 64 + m * 16 + fr, k * 32 + fq * 8))
#define LDB(dst, b, h) _Pragma("unroll") for (int n = 0; n < 2; ++n) _Pragma("unroll") for (int k = 0; k < 2; ++k) \
    dst[n][k] = *reinterpret_cast<const bf16x8*>(SB(b, h) + lds_byte(wc * 32 + n * 16 + fr, k * 32 + fq * 8))
#define MMA(ai, bj, At, Bx) do { __builtin_amdgcn_s_setprio(1); \
    _Pragma("unroll") for (int m = 0; m < 4; ++m) _Pragma("unroll") for (int n = 0; n < 2; ++n) _Pragma("unroll") for (int k = 0; k < 2; ++k) \
      acc[ai][bj][m][n] = __builtin_amdgcn_mfma_f32_16x16x32_bf16(At[m][k], Bx[n][k], acc[ai][bj][m][n], 0, 0, 0); \
    __builtin_amdgcn_s_setprio(0); } while (0)
#define WAIT_V(n) asm volatile("s_waitcnt vmcnt(" #n ")" ::: "memory")
#define WAIT_L(n) asm volatile("s_waitcnt lgkmcnt(" #n ")" ::: "memory")
#define BAR __builtin_amdgcn_s_barrier()
#define SCHED __builtin_amdgcn_sched_barrier(0)

template <int NA> DI void gemm_kloop(const int TID, const u16* __restrict__ A, int lda, const u16* __restrict__ Bt, int ldb, int nt, f32x4 (&acc)[NA][2][4][2]) {
  const int tid = TID, wid = tid >> 6, lane = tid & 63, wr = wid >> 2, wc = wid & 3, fr = lane & 15, fq = lane >> 4;
  unsigned offA0, offB0;
  { int r, c; stage_rc(tid * 16, r, c); offA0 = r * lda + c; offB0 = r * ldb + c; }
  const int wbase = __builtin_amdgcn_readfirstlane(wid) * 1024;
#pragma unroll
  for (int a = 0; a < NA; ++a)
#pragma unroll
    for (int b = 0; b < 2; ++b)
#pragma unroll
      for (int m = 0; m < 4; ++m)
#pragma unroll
        for (int n = 0; n < 2; ++n) acc[a][b][m][n] = f32x4{0.f, 0.f, 0.f, 0.f};
  STAGE_B(SB(0, 0), 0, 0); STAGE_A(SA(0, 0), 0, 0); STAGE_B(SB(0, 1), 1, 0); if (NA == 2) STAGE_A(SA(0, 1), 1, 0);
  WAIT_V(0); __syncthreads();
#pragma unroll 1
  for (int t = 0; t < nt; ++t) {
    const int cb = t & 1, nb = cb ^ 1;
    if (t + 1 < nt) { STAGE_B(SB(nb, 0), 0, t + 1); STAGE_A(SA(nb, 0), 0, t + 1); STAGE_B(SB(nb, 1), 1, t + 1); if (NA == 2) STAGE_A(SA(nb, 1), 1, t + 1); }
#pragma unroll 1
    for (int k = 0; k < 2; ++k) {
      bf16x8 Bf[2][2];
#pragma unroll
      for (int bj = 0; bj < 2; ++bj)
#pragma unroll
        for (int n = 0; n < 2; ++n) Bf[bj][n] = *reinterpret_cast<const bf16x8*>(SB(cb, bj) + lds_byte(wc * 32 + n * 16 + fr, k * 32 + fq * 8));
#pragma unroll
      for (int ai = 0; ai < NA; ++ai) {
        bf16x8 Af[4];
#pragma unroll
        for (int m = 0; m < 4; ++m) Af[m] = *reinterpret_cast<const bf16x8*>(SA(cb, ai) + lds_byte(wr * 64 + m * 16 + fr, k * 32 + fq * 8));
#pragma unroll
        for (int bj = 0; bj < 2; ++bj)
#pragma unroll
          for (int m = 0; m < 4; ++m)
#pragma unroll
            for (int n = 0; n < 2; ++n) acc[ai][bj][m][n] = __builtin_amdgcn_mfma_f32_16x16x32_bf16(Af[m], Bf[bj][n], acc[ai][bj][m][n], 0, 0, 0);
      }
    }
    WAIT_V(0); __syncthreads();
  }
}

#define LDA8(dst, b, h) _Pragma("unroll") for (int m = 0; m < 4; ++m) _Pragma("unroll") for (int k = 0; k < 2; ++k) \
    dst[m][k] = *reinterpret_cast<const bf16x8*>(SA(b, h) + lds_byte(wr * 64 + m * 16 + fr, k * 32 + fq * 8))
#define LDB8(dst, b, h) _Pragma("unroll") for (int n = 0; n < 2; ++n) _Pragma("unroll") for (int k = 0; k < 2; ++k) \
    dst[n][k] = *reinterpret_cast<const bf16x8*>(SB(b, h) + lds_byte(wc * 32 + n * 16 + fr, k * 32 + fq * 8))
#define MMA8(ai, bj, At, Bx) do { __builtin_amdgcn_s_setprio(1); \
    _Pragma("unroll") for (int m = 0; m < 4; ++m) _Pragma("unroll") for (int n = 0; n < 2; ++n) _Pragma("unroll") for (int k = 0; k < 2; ++k) \
      acc[ai][bj][m][n] = __builtin_amdgcn_mfma_f32_16x16x32_bf16(At[m][k], Bx[n][k], acc[ai][bj][m][n], 0, 0, 0); \
    __builtin_amdgcn_s_setprio(0); } while (0)
DI void gemm_kloop8(const int TID, const u16* __restrict__ A, int lda, const u16* __restrict__ Bt, int ldb, int nt, f32x4 (&acc)[2][2][4][2]) {
  const int tid = TID, wid = tid >> 6, lane = tid & 63, wr = wid >> 2, wc = wid & 3, fr = lane & 15, fq = lane >> 4;
  unsigned offA0, offB0;
  { int r, c; stage_rc(tid * 16, r, c); offA0 = r * lda + c; offB0 = r * ldb + c; }
  const int wbase = __builtin_amdgcn_readfirstlane(wid) * 1024;
#pragma unroll
  for (int a = 0; a < 2; ++a)
#pragma unroll
    for (int b = 0; b < 2; ++b)
#pragma unroll
      for (int m = 0; m < 4; ++m)
#pragma unroll
        for (int n = 0; n < 2; ++n) acc[a][b][m][n] = f32x4{0.f, 0.f, 0.f, 0.f};
  bf16x8 At[4][2], B0[2][2], B1[2][2];
  STAGE_B(SB(0, 0), 0, 0); STAGE_A(SA(0, 0), 0, 0);
  STAGE_B(SB(0, 1), 1, 0); STAGE_A(SA(0, 1), 1, 0);
  if (wr == 1) BAR;
  WAIT_V(4); BAR;
  STAGE_B(SB(1, 0), 0, 1); STAGE_A(SA(1, 0), 0, 1); STAGE_B(SB(1, 1), 1, 1);
  WAIT_V(6); BAR;
#pragma unroll 1
  for (int t = 0; t < nt - 2; t += 2) {
    LDB8(B0, 0, 0); SCHED; LDA8(At, 0, 0); STAGE_A(SA(1, 1), 1, t + 1);
    WAIT_L(8); BAR; WAIT_L(0); MMA8(0, 0, At, B0); BAR; SCHED;
    LDB8(B1, 0, 1); STAGE_B(SB(0, 0), 0, t + 2);
    BAR; WAIT_L(0); MMA8(0, 1, At, B1); BAR;
    LDA8(At, 0, 1); STAGE_A(SA(0, 0), 0, t + 2);
    BAR; WAIT_L(0); MMA8(1, 0, At, B0); BAR; SCHED;
    STAGE_B(SB(0, 1), 1, t + 2);
    WAIT_V(6); BAR; MMA8(1, 1, At, B1); BAR;
    LDB8(B0, 1, 0); SCHED; LDA8(At, 1, 0); STAGE_A(SA(0, 1), 1, t + 2);
    WAIT_L(8); BAR; WAIT_L(0); MMA8(0, 0, At, B0); BAR; SCHED;
    LDB8(B1, 1, 1); STAGE_B(SB(1, 0), 0, t + 3);
    BAR; WAIT_L(0); MMA8(0, 1, At, B1); BAR;
    LDA8(At, 1, 1); STAGE_A(SA(1, 0), 0, t + 3);
    BAR; WAIT_L(0); MMA8(1, 0, At, B0); BAR; SCHED;
    STAGE_B(SB(1, 1), 1, t + 3);
    WAIT_V(6); BAR; MMA8(1, 1, At, B1); BAR;
  }
  { LDB8(B0, 0, 0); LDA8(At, 0, 0); STAGE_A(SA(1, 1), 1, nt - 1);
    BAR; WAIT_L(0); MMA8(0, 0, At, B0); BAR;
    LDB8(B1, 0, 1); BAR; WAIT_L(0); MMA8(0, 1, At, B1); BAR;
    LDA8(At, 0, 1); WAIT_V(4); BAR; WAIT_L(0); MMA8(1, 0, At, B0); MMA8(1, 1, At, B1); BAR; }
  { LDB8(B0, 1, 0); LDA8(At, 1, 0); WAIT_V(2); BAR; WAIT_L(0); MMA8(0, 0, At, B0); BAR;
    LDB8(B1, 1, 1); WAIT_V(0); BAR; WAIT_L(0); MMA8(0, 1, At, B1); BAR;
    LDA8(At, 1, 1); BAR; WAIT_L(0); MMA8(1, 0, At, B0); MMA8(1, 1, At, B1); BAR; }
  if (wr == 0) BAR;
  __syncthreads();
}

DI void gemm_kloop_r3(const int TID, const u16* __restrict__ A, int lda, const u16* __restrict__ Bt, int ldb, int nt, f32x4 (&acc)[1][2][4][2]) {
  const int tid = TID, wid = tid >> 6, lane = tid & 63, wr = wid >> 2, wc = wid & 3, fr = lane & 15, fq = lane >> 4;
  unsigned offA0, offB0;
  { int r, c; stage_rc(tid * 16, r, c); offA0 = r * lda + c; offB0 = r * ldb + c; }
  const int wbase = __builtin_amdgcn_readfirstlane(wid) * 1024;
#pragma unroll
  for (int b = 0; b < 2; ++b)
#pragma unroll
    for (int m = 0; m < 4; ++m)
#pragma unroll
      for (int n = 0; n < 2; ++n) acc[0][b][m][n] = f32x4{0.f, 0.f, 0.f, 0.f};
#define R3A(i) (smem + (i) * 49152)
#define R3B(i, h) (smem + (i) * 49152 + 16384 + (h) * 16384)
#define R3_STAGE(i, kt) do { STAGE_B(R3B(i, 0), 0, kt); STAGE_A(R3A(i), 0, kt); STAGE_B(R3B(i, 1), 1, kt); } while (0)
  R3_STAGE(0, 0); R3_STAGE(1, 1);
  WAIT_V(6); BAR;
  int cur = 0;
#pragma unroll 1
  for (int t = 0; t < nt; ++t) {
    const int nx1 = (cur == 2) ? 0 : cur + 1, nx2 = (cur == 0) ? 2 : cur - 1;
    if (t + 2 < nt) R3_STAGE(nx2, t + 2);
#pragma unroll
    for (int k = 0; k < 2; ++k) {
      bf16x8 Bf[2][2], Af[4];
#pragma unroll
      for (int bj = 0; bj < 2; ++bj)
#pragma unroll
        for (int n = 0; n < 2; ++n) Bf[bj][n] = *reinterpret_cast<const bf16x8*>(R3B(cur, bj) + lds_byte(wc * 32 + n * 16 + fr, k * 32 + fq * 8));
#pragma unroll
      for (int m = 0; m < 4; ++m) Af[m] = *reinterpret_cast<const bf16x8*>(R3A(cur) + lds_byte(wr * 64 + m * 16 + fr, k * 32 + fq * 8));
#pragma unroll
      for (int bj = 0; bj < 2; ++bj)
#pragma unroll
        for (int m = 0; m < 4; ++m)
#pragma unroll
          for (int n = 0; n < 2; ++n) acc[0][bj][m][n] = __builtin_amdgcn_mfma_f32_16x16x32_bf16(Af[m], Bf[bj][n], acc[0][bj][m][n], 0, 0, 0);
    }
    if (t + 2 < nt) WAIT_V(6); else WAIT_V(0);
    WAIT_L(0); BAR;
    cur = nx1;
  }
}

DI void tile_coords(int tile, int nM, int nN, int& pm, int& pn) {
  int nig = 8 * nN, gid = tile / nig, fm = gid * 8, gsz = min(nM - fm, 8), loc = tile % nig;
  pm = fm + loc % gsz; pn = loc / gsz;
}

#define GEMM_IDS const int tid = TID, wid = tid >> 6, lane = tid & 63, wr = wid >> 2, wc = wid & 3, fr = lane & 15, fq = lane >> 4; (void)tid; (void)wr; (void)wc; (void)fr; (void)fq; (void)lane;
DI int fresh_tid(int wv) { int l; asm volatile("v_mbcnt_lo_u32_b32 %0, -1, 0\n\tv_mbcnt_hi_u32_b32 %0, -1, %0" : "=v"(l)); return wv * 64 + l; }
DI int opaque_zero() { int z; asm volatile("s_mov_b32 %0, 0" : "=s"(z)); return z; }
#define ACC_TO_LDS(ai) do { float* _e = (float*)smem; \
  _Pragma("unroll") for (int bj = 0; bj < 2; ++bj) _Pragma("unroll") for (int m = 0; m < 4; ++m) _Pragma("unroll") for (int n = 0; n < 2; ++n) _Pragma("unroll") for (int j = 0; j < 4; ++j) \
    _e[(wr * 64 + m * 16 + fq * 4 + j) * EP_LD + bj * 128 + wc * 32 + n * 16 + fr] = acc[ai][bj][m][n][j]; } while (0)
#define EPI_ROWS_BEGIN(ai) _Pragma("unroll 4") for (int _it = 0; _it < 16; ++_it) { const int _idx = _it * 512 + tid; const int rl = _idx >> 6, cl = (_idx & 63) * 4; \
    const float4 v = *(const float4*)((const float*)smem + rl * EP_LD + cl); const int row = browz + (ai) * 128 + rl; const int col = bcol + cl; (void)row; (void)col;
#define EPI_ROWS_END }
DI uint2 pk4(float a, float b, float c, float d) { uint2 o; o.x = pk2(a, b); o.y = pk2(c, d); return o; }

DI void sgemm16(const int lane, const u16* __restrict__ A, int lda, const u16* __restrict__ Bt, int ldb, int K, int bc0, int bc1, f32x4& c0, f32x4& c1) {
  const int fr = lane & 15, fq = lane >> 4;
  const u16* ap = A + (long)fr * lda + fq * 8;
  const u16* b0 = Bt + (long)(bc0 + fr) * ldb + fq * 8; const u16* b1 = Bt + (long)(bc1 + fr) * ldb + fq * 8;
  c0 = f32x4{0.f, 0.f, 0.f, 0.f}; c1 = c0;
#pragma unroll 8
  for (int k = 0; k < K; k += 32) { const bf16x8 a = *(const bf16x8*)(ap + k), x = *(const bf16x8*)(b0 + k), y = *(const bf16x8*)(b1 + k);
    c0 = __builtin_amdgcn_mfma_f32_16x16x32_bf16(a, x, c0, 0, 0, 0); c1 = __builtin_amdgcn_mfma_f32_16x16x32_bf16(a, y, c1, 0, 0, 0); }
}
DI void inproj_store_s(KP p, int l, int row, int col, float v) {
  unsigned char* ws = p->ws; u16* proj = (u16*)(ws + WS_PROJ);
  const int rs = row - MP;
  if (col >= PC_G) proj[(long)row * NPJ + col] = f2bf(sigm(v));
  else if (col >= PC_QD && col < PC_KD) proj[(long)row * NPJ + col] = f2bf(v * QD_SCALE);
  else if (col >= PC_KD && col < PC_VD) { const int hv = col - PC_KD; p->out[O_SDK + (long)l * MS * 512 + rs * 512 + hv] = v;
    ((u16*)(ws + WS_KDS))[((long)(rs >> 4) * SKP + PAST + (rs & 15)) * 512 + hv] = f2bf(v); }
  else if (col >= PC_VD && col < PC_ZD) { const int hv = col - PC_VD; p->out[O_SDV + (long)l * MS * 512 + rs * 512 + hv] = v;
    ((u16*)(ws + WS_VDTS))[((long)(rs >> 4) * 512 + hv) * SKP + kperm(PAST + (rs & 15))] = f2bf(v); }
  else proj[(long)row * NPJ + col] = f2bf(v);
}

template <bool PERM> DI void transpose_tile(const int TID, const float* __restrict__ src, long ld_s, u16* __restrict__ dst, long ld_d, int r0, int c0, int drow0) {
  u16* tl = (u16*)smem;
  const int tid = TID;
  { int rr = tid >> 3, cc = (tid & 7) * 4; float4 v = *(const float4*)(src + (long)(r0 + rr) * ld_s + c0 + cc);
    tl[(cc + 0) * 72 + rr] = f2bf(v.x); tl[(cc + 1) * 72 + rr] = f2bf(v.y); tl[(cc + 2) * 72 + rr] = f2bf(v.z); tl[(cc + 3) * 72 + rr] = f2bf(v.w); }
  __syncthreads();
  if (tid < 256) { int cc = tid >> 3, rr = (tid & 7) * 8; uint4 v = *(const uint4*)(tl + cc * 72 + rr);
    if (PERM) { u16* d = dst + (long)(drow0 + cc) * ld_d; *(uint2*)(d + kperm(r0 + rr)) = uint2{v.x, v.y}; *(uint2*)(d + kperm(r0 + rr + 4)) = uint2{v.z, v.w}; }
    else *(uint4*)(dst + (long)(drow0 + cc) * ld_d + r0 + rr) = v; }
  __syncthreads();
}

DI void rmsnorm_rows_to_bf16(const int TID, KP p, int l) {
  const int lane = TID & 63, wid = TID >> 6;
  const float* g = p->in[8] + l * D;
  u16* xn = (u16*)(p->ws + WS_XN);
  for (int row = blockIdx.x * 8 + wid; row < M; row += gridDim.x * 8) {
    const float* src = (l == 0) ? (row < MP ? p->in[0] + (long)row * D : p->in[1] + (long)(row - MP) * D) : p->out + (long)row * D;
    float4 v[4]; float ss = 0.f;
#pragma unroll
    for (int i = 0; i < 4; ++i) { v[i] = *(const float4*)(src + i * 256 + lane * 4); ss += v[i].x * v[i].x + v[i].y * v[i].y + v[i].z * v[i].z + v[i].w * v[i].w; }
    ss = wsum(ss); const float rs = rsqrtf(ss * (1.f / D) + EPS);
#pragma unroll
    for (int i = 0; i < 4; ++i) { float4 gg = *(const float4*)(g + i * 256 + lane * 4);
      uint2 o; o.x = pk2(v[i].x * rs * gg.x, v[i].y * rs * gg.y); o.y = pk2(v[i].z * rs * gg.z, v[i].w * rs * gg.w);
      *(uint2*)(xn + (long)row * D + i * 256 + lane * 4) = o; }
  }
}

DI void prep_phase(const int TID, KP p, int l) {
  const int tid = TID, G = gridDim.x, bx = blockIdx.x;
  const long gtid = (long)bx * 512 + tid, gn = (long)G * 512;
  unsigned char* ws = p->ws;
  rmsnorm_rows_to_bf16(TID, p, l);
  { const float* w = p->in[9] + (long)l * 1024 * NIN; u16* d = (u16*)(ws + WS_WIN);
    for (int i = bx; i < 16 * 221; i += G) { int kt = i & 15, ct = i >> 4, c0 = ct * 32; transpose_tile<false>(TID, w, NIN, d, 1024, kt * 64, c0, c0 < 416 ? c0 : c0 + 96); }
    for (long i = gtid; i < 96 * 1024 / 8; i += gn) { const unsigned z = (unsigned)TID >> 31; ((uint4*)(d + 416 * 1024))[i] = uint4{z, z, z, z}; } }
  for (int b = 0; b < 3; ++b) { const float* w = p->in[27 + b] + (long)l * 512 * 1024; u16* d = (u16*)(ws + WS_WO) + (long)b * 1024 * 512;
    for (int i = bx; i < 8 * 32; i += G) { int rt = i & 7, ct = i >> 3; transpose_tile<false>(TID, w, 1024, d, 512, rt * 64, ct * 32, ct * 32); } }
  { const float* w = p->in[30] + (long)l * 1024 * 1024; u16* d = (u16*)(ws + WS_WOUT);
    for (int i = bx; i < 16 * 32; i += G) { int rt = i & 15, ct = i >> 4; transpose_tile<false>(TID, w, 1024, d, 1024, rt * 64, ct * 32, ct * 32); } }
  { const float* c = p->in[2] + (long)l * 8 * PAST * 128; u16* d = (u16*)(ws + WS_CKVTS);
    for (int i = bx; i < 8 * 32 * 4; i += G) { int sb = i >> 7, r = i & 127, rt = r & 31, ct = r >> 5;
      transpose_tile<true>(TID, c + (long)sb * PAST * 128, 128, d + (long)sb * 128 * SKP, SKP, rt * 64, ct * 32, ct * 32); } }
  { const float* c = p->in[5] + (long)l * 8 * PAST * 512; u16* d = (u16*)(ws + WS_VDTS);
    for (int i = bx; i < 8 * 32 * 16; i += G) { int sb = i >> 9, r = i & 511, rt = r & 31, ct = r >> 5;
      transpose_tile<true>(TID, c + (long)sb * PAST * 512, 512, d + (long)sb * 512 * SKP, SKP, rt * 64, ct * 32, ct * 32); } }
  { const float* c = p->in[2] + (long)l * 8 * PAST * 128; u16* d = (u16*)(ws + WS_CKVS);
    for (long i = gtid; i < 8L * PAST * 128 / 4; i += gn) { long e = i * 4; int sb = (int)(e / (PAST * 128)); long r = e - (long)sb * PAST * 128;
      float4 v = *(const float4*)(c + e); uint2 o; o.x = pk2(v.x, v.y); o.y = pk2(v.z, v.w); *(uint2*)(d + (long)sb * SKP * 128 + r) = o; } }
  { const float* c = p->in[3] + (long)l * 8 * PAST * 32; u16* d = (u16*)(ws + WS_KRS);
    for (long i = gtid; i < 8L * PAST * 32 / 4; i += gn) { long e = i * 4; int sb = (int)(e / (PAST * 32)); long r = e - (long)sb * PAST * 32;
      float4 v = *(const float4*)(c + e); uint2 o; o.x = pk2(v.x, v.y); o.y = pk2(v.z, v.w); *(uint2*)(d + (long)sb * SKP * 32 + r) = o; } }
  { const float* c = p->in[4] + (long)l * 8 * PAST * 512; u16* d = (u16*)(ws + WS_KDS);
    for (long i = gtid; i < 8L * PAST * 512 / 4; i += gn) { long e = i * 4; int sb = (int)(e / (PAST * 512)); long r = e - (long)sb * PAST * 512;
      float4 v = *(const float4*)(c + e); uint2 o; o.x = pk2(v.x, v.y); o.y = pk2(v.z, v.w); *(uint2*)(d + (long)sb * SKP * 512 + r) = o; } }
  for (long i = gtid; i < 8L * 48 * 128; i += gn) { int sb = (int)(i / (48 * 128)); int r = (int)(i % (48 * 128)); ((u16*)(ws + WS_CKVS))[((long)sb * SKP + SK) * 128 + r] = 0; }
  for (long i = gtid; i < 8L * 48 * 32; i += gn) { int sb = (int)(i / (48 * 32)); int r = (int)(i % (48 * 32)); ((u16*)(ws + WS_KRS))[((long)sb * SKP + SK) * 32 + r] = 0; }
  for (long i = gtid; i < 8L * 48 * 512; i += gn) { int sb = (int)(i / (48 * 512)); int r = (int)(i % (48 * 512)); ((u16*)(ws + WS_KDS))[((long)sb * SKP + SK) * 512 + r] = 0; }
  for (long i = gtid; i < 8L * 128 * 48; i += gn) { int rw = (int)(i / 48), k = (int)(i % 48); ((u16*)(ws + WS_CKVTS))[(long)rw * SKP + SK + k] = 0; }
  for (long i = gtid; i < 8L * 512 * 48; i += gn) { int rw = (int)(i / 48), k = (int)(i % 48); ((u16*)(ws + WS_VDTS))[(long)rw * SKP + SK + k] = 0; }
  { const float* uq = p->in[12] + (long)l * 256 * 768; const float* uk = p->in[13] + (long)l * 128 * 512; u16* d = (u16*)(ws + WS_WQ);
    for (long i = gtid; i < 1280L * 256; i += gn) { int n = (int)(i >> 8), r = (int)(i & 255); float s;
      if (n < 1024) { int hd = n >> 7, c = n & 127; const float* a = uq + r * 768 + hd * 96; const float* b = uk + c * 512 + hd * 64; s = 0.f;
        for (int dd = 0; dd < 64; dd += 4) { float4 x = *(const float4*)(a + dd), y = *(const float4*)(b + dd); s += x.x * y.x + x.y * y.y + x.z * y.z + x.w * y.w; } }
      else { int hd = (n - 1024) >> 5, j = (n - 1024) & 31; s = uq[r * 768 + hd * 96 + 64 + j]; }
      d[i] = f2bf(s); } }
  { const float* uv = p->in[14] + (long)l * 128 * 512; u16* d = (u16*)(ws + WS_WUV);
    for (long i = gtid; i < 512L * 512; i += gn) { int n = (int)(i >> 9), kk = (int)(i & 511); int hd = n >> 6, v = n & 63, hk = (n >> 8) * 4 + (kk >> 7), c = kk & 127;
      d[i] = (hk == hd) ? f2bf(uv[c * 512 + hd * 64 + v]) : (u16)0; } }
  { const float* wa = p->in[22] + (long)l * 8 * 4096; const float* wx = p->in[24] + (long)l * 8 * 4096; u16* d = (u16*)(ws + WS_WLRU);
    for (long i = gtid; i < 1024L * 256; i += gn) { int nn = (int)(i >> 8), kk = (int)(i & 255); int pn = nn >> 8, nl = nn & 255; int f = pn * 128 + (nl & 127);
      int blk = f >> 6, o = f & 63, bk = (pn >> 1) * 4 + (kk >> 6), ii = kk & 63; const float* w = (nl < 128) ? wa : wx;
      d[i] = (bk == blk) ? f2bf(w[blk * 4096 + ii * 64 + o]) : (u16)0; } }
  if (bx == 0 && tid == 0) {
    float s1 = 0.f, s2 = 0.f;
    for (int i = 0; i < 32; ++i) { s1 += p->in[15][l * 32 + i] * p->in[16][l * 32 + i]; s2 += p->in[17][l * 32 + i] * p->in[18][l * 32 + i]; }
    const float lam_init = 0.8f - 0.6f * expf(-0.3f * (float)l);
    float* sc = (float*)(ws + WS_CTL + 1024);
    sc[l * 2 + 0] = expf(s1) - expf(s2) + lam_init; sc[l * 2 + 1] = lam_init;
  }
  if (l == 0) {
    float2* tab = (float2*)(ws + WS_ROPE);
    for (long i = gtid; i < 4096 * 16; i += gn) { int pos = (int)(i >> 4), j = (int)(i & 15);
      const float a = (float)pos * g_invf[j];
      const float k = rintf(a * 0.63661977236758134f);
      float y = fmaf(-k, 1.5707963109016418f, a); y = fmaf(-k, 1.5893254712295857e-08f, y); y = fmaf(-k, 6.0770999344e-16f, y);
      const float y2 = y * y;
      const float sn = y * (1.f + y2 * (-1.6666667163e-01f + y2 * (8.3333337680e-03f + y2 * (-1.9841270114e-04f + y2 * 2.7557314297e-06f))));
      const float cs = 1.f + y2 * (-0.5f + y2 * (4.1666667908e-02f + y2 * (-1.3888889225e-03f + y2 * (2.4801587642e-05f + y2 * -2.7557314297e-07f))));
      const int q = ((int)k) & 3;
      const float c2 = (q == 0) ? cs : (q == 1) ? -sn : (q == 2) ? -cs : sn;
      const float s2 = (q == 0) ? sn : (q == 1) ? cs : (q == 2) ? -sn : -cs;
      tab[i] = float2{c2, s2}; }
  }
}

DI void inproj_phase(const int TID_in, KP p, int l, int vid) {
  const int wv = __builtin_amdgcn_readfirstlane(TID_in >> 6);
  unsigned char* ws = p->ws;
  f32x4 acc[2][2][4][2];
  for (int tile = vid; tile < 64 * 28; tile += gridDim.x) {
    int pm, pn; tile_coords(tile, 64, 28, pm, pn);
    const int brow = pm * 256, bcol = pn * 256;
    gemm_kloop8(fresh_tid(wv), (const u16*)(ws + WS_XN) + (long)brow * 1024, 1024, (const u16*)(ws + WS_WIN) + (long)bcol * 1024, 1024, 16, acc);
    const int TID = fresh_tid(wv);
    GEMM_IDS
    const int oz = opaque_zero(); const int browz = brow + oz;
    u16* proj = (u16*)(ws + WS_PROJ) + oz;
#pragma unroll
    for (int ai = 0; ai < 2; ++ai) {
      ACC_TO_LDS(ai);
      __syncthreads();
      if (pn >= 16) {
        EPI_ROWS_BEGIN(ai) *(uint2*)(proj + (long)row * NPJ + col) = pk4(sigm(v.x), sigm(v.y), sigm(v.z), sigm(v.w)); EPI_ROWS_END
      } else if (pn == 4 || pn == 5) {
        EPI_ROWS_BEGIN(ai) *(uint2*)(proj + (long)row * NPJ + col) = pk4(v.x * QD_SCALE, v.y * QD_SCALE, v.z * QD_SCALE, v.w * QD_SCALE); EPI_ROWS_END
      } else if (pn == 6 || pn == 7) {
        u16* kds = (u16*)(ws + WS_KDS) + oz;
        EPI_ROWS_BEGIN(ai)
          const int hv = col - PC_KD; const uint2 pk = pk4(v.x, v.y, v.z, v.w);
          *(uint2*)(proj + (long)row * NPJ + col) = pk;
          if (row < MP) *(float4*)(p->out + O_PDK + (long)l * MP * 512 + (long)row * 512 + hv) = v;
          else if (row < M) { const int rs = row - MP; *(float4*)(p->out + O_SDK + (long)l * MS * 512 + rs * 512 + hv) = v;
            *(uint2*)(kds + ((long)(rs >> 4) * SKP + PAST + (rs & 15)) * 512 + hv) = pk; }
        EPI_ROWS_END
      } else if (pn == 8 || pn == 9) {
        EPI_ROWS_BEGIN(ai)
          const int hv = col - PC_VD;
          if (row < MP) *(float4*)(p->out + O_PDV + (long)l * MP * 512 + (long)row * 512 + hv) = v;
          else if (row < M) *(float4*)(p->out + O_SDV + (long)l * MS * 512 + (row - MP) * 512 + hv) = v;
        EPI_ROWS_END
        u16* vtp = (u16*)(ws + WS_VDTP) + oz; u16* vts = (u16*)(ws + WS_VDTS) + oz;
#pragma unroll 4
        for (int it = 0; it < 16; ++it) { const int idx = it * 512 + tid; const int cl = idx & 255, r4 = (idx >> 8) * 4;
          const float* e = (const float*)smem + r4 * EP_LD + cl;
          const uint2 pk = pk4(e[0], e[EP_LD], e[2 * EP_LD], e[3 * EP_LD]);
          const int row0 = browz + ai * 128 + r4, hv = bcol + cl - PC_VD;
          if (row0 < MP) *(uint2*)(vtp + ((long)(row0 >> 12) * 512 + hv) * TP + kperm(row0 & (TP - 1))) = pk;
          else if (row0 < M) { const int rs = row0 - MP; *(uint2*)(vts + ((long)(rs >> 4) * 512 + hv) * SKP + kperm(PAST + (rs & 15))) = pk; } }
      } else {
        EPI_ROWS_BEGIN(ai) *(uint2*)(proj + (long)row * NPJ + col) = pk4(v.x, v.y, v.z, v.w); EPI_ROWS_END
      }
      __syncthreads();
    }
  }
  const int TID = fresh_tid(wv);
  GEMM_IDS
  for (int it = (int)gridDim.x - 1 - vid; it < 8 * 28; it += gridDim.x) {
    const int rg = it & 7, pn = it >> 3; const int row0 = MP + rg * 16, bcol = pn * 256;
    f32x4 c0, c1;
    sgemm16(lane, (const u16*)(ws + WS_XN) + (long)row0 * 1024, 1024, (const u16*)(ws + WS_WIN) + (long)bcol * 1024, 1024, 1024, wid * 32, wid * 32 + 16, c0, c1);
#pragma unroll
    for (int j = 0; j < 4; ++j) { const int row = row0 + fq * 4 + j; inproj_store_s(p, l, row, bcol + wid * 32 + fr, c0[j]); inproj_store_s(p, l, row, bcol + wid * 32 + 16 + fr, c1[j]); }
  }
}

template <int NR> DI void mid_unit(const int TID, KP p, int l, const int r0) {
  const int tid = TID, lane = tid & 63, wid = tid >> 6;
  unsigned char* ws = p->ws;
  u16* proj = (u16*)(ws + WS_PROJ);
  u16* tl = (u16*)smem;
  const float* gq = p->in[10] + l * 256; const float* gkv = p->in[11] + l * 128;
  const float2* rope = (const float2*)(ws + WS_ROPE);
  const float* cw = p->in[20] + l * 4 * 512; const float* cb = p->in[21] + l * 512;
  u16* xc = (u16*)(ws + WS_XC);
  const int rw0 = r0 + wid * NR;
  const bool pr = rw0 < MP; const int rs0 = rw0 - MP;
  const int b = pr ? (rw0 >> 12) : (rs0 >> 4), t0 = pr ? (rw0 & (TP - 1)) : (rs0 & 15);
  u16* prow0 = proj + (long)rw0 * NPJ;
  {
    uint2 vq[NR]; u32 vk[NR]; float x1[NR], x2[NR];
#pragma unroll
    for (int i = 0; i < NR; ++i) { const u16* pw = prow0 + (long)i * NPJ; vq[i] = *(const uint2*)(pw + PC_CQ + lane * 4); vk[i] = *(const u32*)(pw + PC_CKV + lane * 2);
      x1[i] = bf2f(pw[PC_KR + (lane & 15)]); x2[i] = bf2f(pw[PC_KR + 16 + (lane & 15)]); }
    const float4 g4 = *(const float4*)(gq + lane * 4); const float2 g2 = *(const float2*)(gkv + lane * 2);
#pragma unroll
    for (int i = 0; i < NR; ++i) {
      const int row = rw0 + i, t = t0 + i, pos = pr ? t : PAST + t; const int rs = row - MP;
      u16* prow = prow0 + (long)i * NPJ;
      { float a0 = lo2f(vq[i].x), a1 = hi2f(vq[i].x), a2 = lo2f(vq[i].y), a3 = hi2f(vq[i].y);
        float ss = wsum(a0 * a0 + a1 * a1 + a2 * a2 + a3 * a3); float rsd = rsqrtf(ss * (1.f / 256) + EPS);
        *(uint2*)(prow + PC_CQ + lane * 4) = pk4(a0 * rsd * g4.x, a1 * rsd * g4.y, a2 * rsd * g4.z, a3 * rsd * g4.w); }
      { float a0 = lo2f(vk[i]), a1 = hi2f(vk[i]);
        float ss = wsum(a0 * a0 + a1 * a1); float rsd = rsqrtf(ss * (1.f / 128) + EPS);
        float y0 = a0 * rsd * g2.x, y1 = a1 * rsd * g2.y;
        float* so = pr ? p->out + O_PCKV + (long)l * MP * 128 + (long)row * 128 : p->out + O_SCKV + (long)l * MS * 128 + rs * 128;
        *(float2*)(so + lane * 2) = float2{y0, y1};
        u32 pk = pk2(y0, y1);
        u16* kb = pr ? (u16*)(ws + WS_CKVP) + (long)row * 128 : (u16*)(ws + WS_CKVS) + ((long)b * SKP + PAST + t) * 128;
        *(u32*)(kb + lane * 2) = pk;
        tl[(lane * 2) * 72 + wid * NR + i] = (u16)(pk & 0xffff); tl[(lane * 2 + 1) * 72 + wid * NR + i] = (u16)(pk >> 16); }
      if (lane < 16) {
        float2 cs = rope[pos * 16 + lane];
        float o1 = x1[i] * cs.x - x2[i] * cs.y, o2 = x2[i] * cs.x + x1[i] * cs.y;
        float* so = pr ? p->out + O_PKR + (long)l * MP * 32 + (long)row * 32 : p->out + O_SKR + (long)l * MS * 32 + rs * 32;
        so[lane] = o1; so[lane + 16] = o2;
        u16* kb = pr ? (u16*)(ws + WS_KRP) + (long)row * 32 : (u16*)(ws + WS_KRS) + ((long)b * SKP + PAST + t) * 32;
        kb[lane] = f2bf(o1); kb[lane + 16] = f2bf(o2); }
    }
  }
  {
    const int f = lane * 8;
    uint4 xin[NR + 3];
#pragma unroll
    for (int k = 0; k < NR + 3; ++k) {
      const int tt = t0 + k - 3;
      if (tt >= 0) xin[k] = *(const uint4*)(prow0 + (long)(k - 3) * NPJ + PC_XL + f);
      else if (!pr) { const float* c0 = p->in[7] + (((long)l * 8 + b) * 3 + (tt + 3)) * 512 + f; float4 u0 = *(const float4*)c0, u1 = *(const float4*)(c0 + 4);
        xin[k] = uint4{pk2(u0.x, u0.y), pk2(u0.z, u0.w), pk2(u1.x, u1.y), pk2(u1.z, u1.w)}; }
      else xin[k] = uint4{0u, 0u, 0u, 0u};
    }
    float4 w[4][2];
#pragma unroll
    for (int k = 0; k < 4; ++k) { w[k][0] = *(const float4*)(cw + k * 512 + f); w[k][1] = *(const float4*)(cw + k * 512 + f + 4); }
    const float4 b0 = *(const float4*)(cb + f), b1 = *(const float4*)(cb + f + 4);
    const int T = pr ? TP : TS;
#pragma unroll
    for (int i = 0; i < NR; ++i) {
      float a[8] = {b0.x, b0.y, b0.z, b0.w, b1.x, b1.y, b1.z, b1.w};
#pragma unroll
      for (int k = 0; k < 4; ++k) { const uint4 v = xin[i + k];
        a[0] += lo2f(v.x) * w[k][0].x; a[1] += hi2f(v.x) * w[k][0].y; a[2] += lo2f(v.y) * w[k][0].z; a[3] += hi2f(v.y) * w[k][0].w;
        a[4] += lo2f(v.z) * w[k][1].x; a[5] += hi2f(v.z) * w[k][1].y; a[6] += lo2f(v.w) * w[k][1].z; a[7] += hi2f(v.w) * w[k][1].w; }
      *(uint4*)(xc + (long)(rw0 + i) * 512 + f) = uint4{pk2(a[0], a[1]), pk2(a[2], a[3]), pk2(a[4], a[5]), pk2(a[6], a[7])};
      const int t = t0 + i;
      if (t >= T - 3) { const uint4 v = xin[i + 3];
        float* so = pr ? p->out + O_PCV + (((long)l * 4 + b) * 3 + (t - (T - 3))) * 512 + f : p->out + O_SCV + (((long)l * 8 + b) * 3 + (t - (T - 3))) * 512 + f;
        *(float4*)so = float4{lo2f(v.x), hi2f(v.x), lo2f(v.y), hi2f(v.y)}; *(float4*)(so + 4) = float4{lo2f(v.z), hi2f(v.z), lo2f(v.w), hi2f(v.w)}; }
    }
  }
  __syncthreads();
  for (int id = tid; id < 128 * NR; id += 512) { const int c = id / NR, rg = id % NR; const int row = r0 + rg * 8;
    uint4 v = *(const uint4*)(tl + c * 72 + rg * 8);
    u16* dbase = (row < MP) ? (u16*)(ws + WS_CKVTP) + ((long)(row >> 12) * 128 + c) * TP : (u16*)(ws + WS_CKVTS) + ((long)((row - MP) >> 4) * 128 + c) * SKP;
    const int key = (row < MP) ? (row & (TP - 1)) : PAST + ((row - MP) & 15);
    *(uint2*)(dbase + kperm(key)) = uint2{v.x, v.y}; *(uint2*)(dbase + kperm(key + 4)) = uint2{v.z, v.w}; }
  __syncthreads();
}
DI void mid_phase(const int TID, KP p, int l) {
  for (int u = blockIdx.x; u < 256 + 16; u += gridDim.x) {
    if (u < 256) mid_unit<8>(TID, p, l, u * 64);
    else mid_unit<1>(TID, p, l, MP + (u - 256) * 8);
  }
}

DI void qlru_phase(const int TID_in, KP p, int l, int vid) {
  const int wv = __builtin_amdgcn_readfirstlane(TID_in >> 6);
  unsigned char* ws = p->ws;
  f32x4 acc[2][2][4][2];
  for (int tile = vid; tile < 64 * 9; tile += gridDim.x) {
    if (tile < 64 * 5) {
      int pm, pn; tile_coords(tile, 64, 5, pm, pn);
      const int brow = pm * 256, bcol = pn * 256;
      gemm_kloop8(fresh_tid(wv), (const u16*)(ws + WS_PROJ) + (long)brow * NPJ + PC_CQ, NPJ, (const u16*)(ws + WS_WQ) + (long)bcol * 256, 256, 4, acc);
      const int TID = fresh_tid(wv);
      GEMM_IDS
      const int oz = opaque_zero(); const int browz = brow + oz;
      u16* qm = (u16*)(ws + WS_QMLA) + oz;
#pragma unroll
      for (int ai = 0; ai < 2; ++ai) {
        ACC_TO_LDS(ai);
        __syncthreads();
        if (pn < 4) {
          EPI_ROWS_BEGIN(ai) *(uint2*)(qm + (long)row * 1280 + col) = pk4(v.x * QM_SCALE, v.y * QM_SCALE, v.z * QM_SCALE, v.w * QM_SCALE); EPI_ROWS_END
        } else {
          const float2* rope = (const float2*)(ws + WS_ROPE) + oz;
#pragma unroll 2
          for (int it = 0; it < 8; ++it) { const int idx = it * 512 + tid; const int rl = idx >> 5, hd = (idx >> 2) & 7, j4 = (idx & 3) * 4;
            const int row = browz + ai * 128 + rl;
            if (row < M) {
              const float* e = (const float*)smem + rl * EP_LD + hd * 32 + j4;
              const float4 x1 = *(const float4*)e, x2 = *(const float4*)(e + 16);
              const float4 c01 = *(const float4*)(rope + row_pos(row) * 16 + j4), c23 = *(const float4*)(rope + row_pos(row) * 16 + j4 + 2);
              u16* q = qm + (long)row * 1280 + 1024 + hd * 32 + j4;
              *(uint2*)q = pk4((x1.x * c01.x - x2.x * c01.y) * QM_SCALE, (x1.y * c01.z - x2.y * c01.w) * QM_SCALE, (x1.z * c23.x - x2.z * c23.y) * QM_SCALE, (x1.w * c23.z - x2.w * c23.w) * QM_SCALE);
              *(uint2*)(q + 16) = pk4((x2.x * c01.x + x1.x * c01.y) * QM_SCALE, (x2.y * c01.z + x1.y * c01.w) * QM_SCALE, (x2.z * c23.x + x1.z * c23.y) * QM_SCALE, (x2.w * c23.z + x1.w * c23.w) * QM_SCALE); } }
        }
        __syncthreads();
      }
    } else {
      int pm, pn; tile_coords(tile - 64 * 5, 64, 4, pm, pn);
      const int brow = pm * 256;
      gemm_kloop8(fresh_tid(wv), (const u16*)(ws + WS_XC) + (long)brow * 512 + (pn >> 1) * 256, 512, (const u16*)(ws + WS_WLRU) + (long)pn * 256 * 256, 256, 4, acc);
      const int TID = fresh_tid(wv);
      GEMM_IDS
      const int oz = opaque_zero(); const int browz = brow + oz;
      const u16* xc = (const u16*)(ws + WS_XC) + oz;
      float* ab = (float*)(ws + WS_A) + oz; float* bb = (float*)(ws + WS_B) + oz;
      float spv[4], baa[4], bxa[4];
      { const int f = pn * 128 + (tid & 31) * 4;
        const float4 lb = *(const float4*)(p->in[26] + l * 512 + f), bav = *(const float4*)(p->in[23] + l * 512 + f), bxv = *(const float4*)(p->in[25] + l * 512 + f);
        spv[0] = softplus_f(-lb.x); spv[1] = softplus_f(-lb.y); spv[2] = softplus_f(-lb.z); spv[3] = softplus_f(-lb.w);
        baa[0] = bav.x; baa[1] = bav.y; baa[2] = bav.z; baa[3] = bav.w; bxa[0] = bxv.x; bxa[1] = bxv.y; bxa[2] = bxv.z; bxa[3] = bxv.w; }
#pragma unroll
      for (int ai = 0; ai < 2; ++ai) {
        ACC_TO_LDS(ai);
        __syncthreads();
#pragma unroll 2
        for (int it = 0; it < 8; ++it) { const int idx = it * 512 + tid; const int rl = idx >> 5, f4 = (idx & 31) * 4;
          const int row = browz + ai * 128 + rl;
          if (row < M) {
            const float* e = (const float*)smem + rl * EP_LD + f4;
            const float4 ra = *(const float4*)e, rx = *(const float4*)(e + 128);
            const int f = pn * 128 + f4;
            const uint2 xv = *(const uint2*)(xc + (long)row * 512 + f);
            const bool first = (row < MP) && ((row & (TP - 1)) == 0);
            float av[4], bv[4];
            const float raa[4] = {ra.x, ra.y, ra.z, ra.w}, rxa[4] = {rx.x, rx.y, rx.z, rx.w};
            const float xca[4] = {lo2f(xv.x), hi2f(xv.x), lo2f(xv.y), hi2f(xv.y)};
#pragma unroll
            for (int k = 0; k < 4; ++k) { const float sp = spv[k];
              const float r = sigm(raa[k] + baa[k]), ii = sigm(rxa[k] + bxa[k]); const float la = -8.f * r * sp;
              av[k] = __expf(la); const float mult = first ? 1.f : sqrtf(neg_expm1(2.f * la)); bv[k] = mult * ii * xca[k]; }
            *(float4*)(ab + (long)row * 512 + f) = float4{av[0], av[1], av[2], av[3]};
            *(float4*)(bb + (long)row * 512 + f) = float4{bv[0], bv[1], bv[2], bv[3]}; } }
        __syncthreads();
      }
    }
  }
  const int TID = fresh_tid(wv);
  GEMM_IDS
  for (int it = (int)gridDim.x - 1 - vid; it < 8 * 9; it += gridDim.x) {
    const int rg = it & 7, pn = it >> 3; const int row0 = MP + rg * 16;
    f32x4 c0, c1;
    if (pn < 5) {
      const int bcol = pn * 256;
      sgemm16(lane, (const u16*)(ws + WS_PROJ) + (long)row0 * NPJ + PC_CQ, NPJ, (const u16*)(ws + WS_WQ) + (long)bcol * 256, 256, 256, wid * 32, wid * 32 + 16, c0, c1);
      u16* qm = (u16*)(ws + WS_QMLA);
      if (pn < 4) {
#pragma unroll
        for (int j = 0; j < 4; ++j) { const long row = row0 + fq * 4 + j; qm[row * 1280 + bcol + wid * 32 + fr] = f2bf(c0[j] * QM_SCALE); qm[row * 1280 + bcol + wid * 32 + 16 + fr] = f2bf(c1[j] * QM_SCALE); }
      } else {
        const float2* rope = (const float2*)(ws + WS_ROPE);
#pragma unroll
        for (int j = 0; j < 4; ++j) { const int row = row0 + fq * 4 + j; const float2 cs = rope[row_pos(row) * 16 + fr];
          qm[(long)row * 1280 + 1024 + wid * 32 + fr] = f2bf((c0[j] * cs.x - c1[j] * cs.y) * QM_SCALE);
          qm[(long)row * 1280 + 1024 + wid * 32 + 16 + fr] = f2bf((c1[j] * cs.x + c0[j] * cs.y) * QM_SCALE); }
      }
    } else {
      const int pl = pn - 5;
      const u16* xc = (const u16*)(ws + WS_XC);
      sgemm16(lane, xc + (long)row0 * 512 + (pl >> 1) * 256, 512, (const u16*)(ws + WS_WLRU) + (long)pl * 256 * 256, 256, 256, wid * 16, 128 + wid * 16, c0, c1);
      const int f = pl * 128 + wid * 16 + fr;
      const float nl = -(p->in[26][l * 512 + f]); const float sp = softplus_f(nl);
      const float bav = p->in[23][l * 512 + f], bxv = p->in[25][l * 512 + f];
      float* ab = (float*)(ws + WS_A); float* bb = (float*)(ws + WS_B);
#pragma unroll
      for (int j = 0; j < 4; ++j) { const long row = row0 + fq * 4 + j;
        const float r = sigm(c0[j] + bav), ii = sigm(c1[j] + bxv); const float la = -8.f * r * sp;
        ab[row * 512 + f] = __expf(la); bb[row * 512 + f] = sqrtf(neg_expm1(2.f * la)) * ii * bf2f(xc[row * 512 + f]); }
    }
  }
}

DI void mla_task(const int TID, const u16* __restrict__ qbase, int nq, const u16* __restrict__ kck, const u16* __restrict__ kkr, const u16* __restrict__ vT, int ldv, int nkeys, u16* __restrict__ obase) {
  const int tid = TID, lane = tid & 63, hd = tid >> 6, r = lane & 31, h = lane >> 5;
  const u16* qp = qbase + (long)(r & (nq - 1)) * 1280;
  bf16x8 qf[10];
#pragma unroll
  for (int ks = 0; ks < 8; ++ks) qf[ks] = *(const bf16x8*)(qp + hd * 128 + ks * 16 + h * 8);
#pragma unroll
  for (int ks = 0; ks < 2; ++ks) qf[8 + ks] = *(const bf16x8*)(qp + 1024 + hd * 32 + ks * 16 + h * 8);
  f32x16 O[4];
#pragma unroll
  for (int i = 0; i < 4; ++i)
#pragma unroll
    for (int j = 0; j < 16; ++j) O[i][j] = 0.f;
  float m_run = -1e30f, l_run = 0.f;
  const int nt = (nkeys + 63) >> 6;
  const int wv = __builtin_amdgcn_readfirstlane(hd);
  if (wv >= 4) __builtin_amdgcn_s_setprio(1);
  const char* gp[5]; unsigned ginc[5];
#pragma unroll
  for (int i = 0; i < 5; ++i) {
    int g = wv + 8 * i; if (g > 38) g = 38;
    if (g < 21) { const int o = g * 1024 + lane * 16; const int row = o / 336, wi = o - row * 336;
      if (wi >= 256 && wi < 320) { gp[i] = (const char*)kkr + row * 64 + (wi - 256); ginc[i] = 64 * 64; }
      else { gp[i] = (const char*)kck + row * 256 + (wi < 256 ? wi : 0); ginc[i] = 64 * 256; } }
    else { const int o = (g - 21) * 1024 + lane * 16; const int row = o / 144, wi = o - row * 144;
      gp[i] = (const char*)vT + (long)row * ldv * 2 + (wi < 128 ? wi : 0); ginc[i] = 128; }
  }
#define MLA_ISSUE(buf) do { _Pragma("unroll") for (int i = 0; i < 5; ++i) { int g = wv + 8 * i; if (g > 38) g = 38; \
    __builtin_amdgcn_global_load_lds((const unsigned*)gp[i], (unsigned*)(smem + (buf) * 39936 + g * 1024), 16, 0, 0); gp[i] += ginc[i]; } } while (0)
#define MLA_QK(S, KT, KB) do { bf16x8 kfr[10]; \
    _Pragma("unroll") for (int ks = 0; ks < 10; ++ks) kfr[ks] = *(const bf16x8*)((KT) + ((KB) * 32 + r) * 336 + ks * 32 + h * 16); \
    _Pragma("unroll") for (int ks = 0; ks < 10; ++ks) { \
      if (ks == 0) S = __builtin_amdgcn_mfma_f32_32x32x16_bf16(kfr[ks], qf[ks], negm, 0, 0, 0); else S = __builtin_amdgcn_mfma_f32_32x32x16_bf16(kfr[ks], qf[ks], S, 0, 0, 0); } \
      \
    __builtin_amdgcn_sched_group_barrier(0x100, 5, 0); \
    _Pragma("unroll") for (int i = 0; i < 5; ++i) { __builtin_amdgcn_sched_group_barrier(0x008, 1, 0); __builtin_amdgcn_sched_group_barrier(0x100, 1, 0); } \
    __builtin_amdgcn_sched_group_barrier(0x008, 5, 0); } while (0)
#define MLA_SMPV(S, OTHER, VT, KB, T) do { \
    if (((T) == nt - 1) && (nkeys & 63)) { _Pragma("unroll") for (int j = 0; j < 16; ++j) if ((T) * 64 + (KB) * 32 + crow(j, h) >= nkeys) S[j] = -1e30f; } \
    float mx = S[0]; _Pragma("unroll") for (int j = 1; j < 16; ++j) mx = fmaxf(mx, S[j]); \
    if (first || __builtin_amdgcn_ballot_w64(mx > 8.f) != 0ull) { \
      mx = fmaxf(mx, __shfl_xor(mx, 32)); \
      const float d = first ? mx : fmaxf(mx, 0.f); \
      if (!first) { const float alpha = __builtin_amdgcn_exp2f(-d); l_run *= alpha; \
        _Pragma("unroll") for (int cb = 0; cb < 4; ++cb) _Pragma("unroll") for (int j = 0; j < 16; ++j) O[cb][j] *= alpha; } \
      _Pragma("unroll") for (int j = 0; j < 16; ++j) { S[j] -= d; negm[j] -= d; OTHER[j] -= d; } \
      first = false; } \
    float ls = 0.f; _Pragma("unroll") for (int j = 0; j < 16; ++j) { S[j] = __builtin_amdgcn_exp2f(S[j]); ls += S[j]; } \
    l_run += ls; \
    bf16x8 pk[2]; \
    _Pragma("unroll") for (int s2 = 0; s2 < 2; ++s2) { const uint4 w = uint4{pk2(S[8 * s2], S[8 * s2 + 1]), pk2(S[8 * s2 + 2], S[8 * s2 + 3]), pk2(S[8 * s2 + 4], S[8 * s2 + 5]), pk2(S[8 * s2 + 6], S[8 * s2 + 7])}; pk[s2] = __builtin_bit_cast(bf16x8, w); } \
    bf16x8 vfr[4][2]; \
    _Pragma("unroll") for (int cb = 0; cb < 4; ++cb) _Pragma("unroll") for (int s2 = 0; s2 < 2; ++s2) vfr[cb][s2] = *(const bf16x8*)((VT) + (cb * 32 + r) * 144 + ((KB) * 32 + 16 * s2) * 2 + h * 16); \
    _Pragma("unroll") for (int cb = 0; cb < 4; ++cb) _Pragma("unroll") for (int s2 = 0; s2 < 2; ++s2) O[cb] = __builtin_amdgcn_mfma_f32_32x32x16_bf16(vfr[cb][s2], pk[s2], O[cb], 0, 0, 0); \
    __builtin_amdgcn_sched_group_barrier(0x100, 4, 0); \
    _Pragma("unroll") for (int i = 0; i < 4; ++i) { __builtin_amdgcn_sched_group_barrier(0x008, 1, 0); __builtin_amdgcn_sched_group_barrier(0x100, 1, 0); } \
    __builtin_amdgcn_sched_group_barrier(0x008, 4, 0); } while (0)
  MLA_ISSUE(0);
  if (nt > 1) MLA_ISSUE(1);
  asm volatile("s_waitcnt vmcnt(0)" ::: "memory");
  __builtin_amdgcn_s_barrier();
  f32x16 sA, sB, negm;
#pragma unroll
  for (int j = 0; j < 16; ++j) { negm[j] = 0.f; sB[j] = 0.f; }
  bool first = true;
  MLA_QK(sA, smem, 0);
  int cur = 0;
#pragma unroll 1
  for (int t = 0; t < nt; ++t) {
    const int nx1 = (cur == 2) ? 0 : cur + 1, nx2 = (cur == 0) ? 2 : cur - 1;
    if (t + 2 < nt) MLA_ISSUE(nx2);
    const unsigned char* Kt = smem + cur * 39936; const unsigned char* Vt = Kt + 21504;
    MLA_QK(sB, Kt, 1);
    MLA_SMPV(sA, sB, Vt, 0, t);
    if (t + 1 < nt) MLA_QK(sA, smem + nx1 * 39936, 0);
    MLA_SMPV(sB, sA, Vt, 1, t);
    asm volatile("s_waitcnt vmcnt(0)" ::: "memory");
    asm volatile("s_waitcnt lgkmcnt(0)" ::: "memory");
    __builtin_amdgcn_s_barrier();
    cur = nx1;
  }
  __builtin_amdgcn_s_setprio(0);
  const float lt = l_run + __shfl_xor(l_run, 32); const float inv = 1.f / lt;
  if (r < nq) {
    u16* op = obase + (long)r * 1024 + hd * 128;
#pragma unroll
    for (int cb = 0; cb < 4; ++cb)
#pragma unroll
      for (int g = 0; g < 4; ++g) { uint2 o; o.x = pk2(O[cb][4 * g] * inv, O[cb][4 * g + 1] * inv); o.y = pk2(O[cb][4 * g + 2] * inv, O[cb][4 * g + 3] * inv);
        *(uint2*)(op + cb * 32 + 8 * g + 4 * h) = o; }
  }
}

DI void diff_task(const int TID, const u16* __restrict__ qbase, const u16* __restrict__ zbase, u16* __restrict__ obase, int nq, int qpos0,
                  const u16* __restrict__ kbase, long kstride, const u16* __restrict__ vT, int ldv, int nkeys_total,
                  float lam, float oml, float slope2, const float* __restrict__ subg) {
  const int tid = TID, lane = tid & 63, w = tid >> 6, r = lane & 31, h = lane >> 5;
  const int qw0 = w * 32;
  const bool wactive = qw0 < nq;
  const int qr = (qw0 + r < nq) ? qw0 + r : 0;
  const int wl = (nq - 1) >> 5;
  const int ntmax = (min(nkeys_total, ((qpos0 + wl * 32) / 64 + 1) * 64) + 63) >> 6;
  const int kvis = min(nkeys_total, ((qpos0 + qw0) / 64 + 1) * 64);
  const int ntw = wactive ? ((kvis + 63) >> 6) : 0;
  const u16* qp = qbase + (long)qr * NPJ;
  bf16x8 qf[2][2];
#pragma unroll
  for (int c = 0; c < 2; ++c)
#pragma unroll
    for (int ks = 0; ks < 2; ++ks) qf[c][ks] = *(const bf16x8*)(qp + c * 32 + ks * 16 + h * 8);
  f32x16 O[2][2];
#pragma unroll
  for (int c = 0; c < 2; ++c)
#pragma unroll
    for (int vb = 0; vb < 2; ++vb)
#pragma unroll
      for (int j = 0; j < 16; ++j) O[c][vb][j] = 0.f;
  float m_run[2] = {-1e30f, -1e30f}, l_run[2] = {0.f, 0.f};
  const float qposf = (float)(qpos0 + qw0 + r);
  const float b0q = slope2 * ((float)(4 * h) - qposf);
  const int sr = tid >> 3, sc = tid & 7;
  const unsigned oDK = (unsigned)(sr * (int)kstride * 2 + sc * 16), oDV = (unsigned)(sr * ldv * 2 + sc * 16);
  uint4 g0, g1;
#define DF_GLOAD(t) do { g0 = *(const uint4*)((const char*)(kbase + (long)(t) * 64 * kstride) + oDK); g1 = *(const uint4*)((const char*)(vT + (long)(t) * 64) + oDV); } while (0)
#define DF_LSTORE(s) do { unsigned char* Kt = smem + (s) * 18432; *(uint4*)(Kt + sr * 144 + sc * 16) = g0; *(uint4*)(Kt + 9216 + sr * 144 + sc * 16) = g1; } while (0)
  if (__builtin_amdgcn_readfirstlane(w) >= 4) __builtin_amdgcn_s_setprio(1);
  DF_GLOAD(ntmax - 1); DF_LSTORE((ntmax - 1) & 1);
  __syncthreads();
  for (int t = ntmax - 1; t >= 0; --t) {
    if (t > 0) DF_GLOAD(t - 1);
    if (t < ntw - 1) {
      const unsigned char* Kt = smem + (t & 1) * 18432; const unsigned char* Vt = Kt + 9216;
#pragma unroll 1
      for (int kb = 1; kb >= 0; --kb) {
        bf16x8 vf[2][2];
#pragma unroll
        for (int vb = 0; vb < 2; ++vb)
#pragma unroll
          for (int s2 = 0; s2 < 2; ++s2) vf[vb][s2] = *(const bf16x8*)(Vt + (vb * 32 + r) * 144 + (kb * 32 + 16 * s2) * 2 + h * 16);
        const float dl = slope2 * (float)(t * 64 + kb * 32);
        f32x16 sc[2];
#pragma unroll
        for (int c = 0; c < 2; ++c) { const float u = b0q + dl - m_run[c];
#pragma unroll
          for (int j = 0; j < 16; ++j) sc[c][j] = fmaf(slope2, (float)((j & 3) + 8 * (j >> 2)), u); }
        bf16x8 kfr[2][2];
#pragma unroll
        for (int ks = 0; ks < 2; ++ks)
#pragma unroll
          for (int c = 0; c < 2; ++c) kfr[ks][c] = *(const bf16x8*)(Kt + (kb * 32 + r) * 144 + (c * 32 + ks * 16 + h * 8) * 2);
#pragma unroll
        for (int ks = 0; ks < 2; ++ks)
#pragma unroll
          for (int c = 0; c < 2; ++c) sc[c] = __builtin_amdgcn_mfma_f32_32x32x16_bf16(kfr[ks][c], qf[c][ks], sc[c], 0, 0, 0);
        __builtin_amdgcn_sched_group_barrier(0x100, 8, 0);
        __builtin_amdgcn_sched_group_barrier(0x008, 4, 0);
#pragma unroll
        for (int c = 0; c < 2; ++c) {
          float mx = sc[c][0];
#pragma unroll
          for (int j = 1; j < 16; ++j) mx = fmaxf(mx, sc[c][j]);
          if (__builtin_amdgcn_ballot_w64(mx > 8.f) != 0ull) {
            mx = fmaxf(mx, __shfl_xor(mx, 32));
            const float d = fmaxf(mx, 0.f); const float alpha = __builtin_amdgcn_exp2f(-d); m_run[c] += d; l_run[c] *= alpha;
#pragma unroll
            for (int vb = 0; vb < 2; ++vb)
#pragma unroll
              for (int j = 0; j < 16; ++j) O[c][vb][j] *= alpha;
#pragma unroll
            for (int j = 0; j < 16; ++j) sc[c][j] -= d;
          }
          float ls = 0.f;
#pragma unroll
          for (int j = 0; j < 16; ++j) { sc[c][j] = __builtin_amdgcn_exp2f(sc[c][j]); ls += sc[c][j]; }
          l_run[c] += ls;
#pragma unroll
          for (int s2 = 0; s2 < 2; ++s2) { const uint4 wv = uint4{pk2(sc[c][8 * s2], sc[c][8 * s2 + 1]), pk2(sc[c][8 * s2 + 2], sc[c][8 * s2 + 3]), pk2(sc[c][8 * s2 + 4], sc[c][8 * s2 + 5]), pk2(sc[c][8 * s2 + 6], sc[c][8 * s2 + 7])};
            const bf16x8 pk = __builtin_bit_cast(bf16x8, wv);
#pragma unroll
            for (int vb = 0; vb < 2; ++vb) O[c][vb] = __builtin_amdgcn_mfma_f32_32x32x16_bf16(vf[vb][s2], pk, O[c][vb], 0, 0, 0); }
        }
      }
    } else if (t < ntw) {
      const unsigned char* Kt = smem + (t & 1) * 18432; const unsigned char* Vt = Kt + 9216;
      const bool partial = (t * 64 + 64 > kvis);
#pragma unroll 1
      for (int kb = 1; kb >= 0; --kb) {
        bf16x8 vf[2][2];
#pragma unroll
        for (int vb = 0; vb < 2; ++vb)
#pragma unroll
          for (int s2 = 0; s2 < 2; ++s2) vf[vb][s2] = *(const bf16x8*)(Vt + (vb * 32 + r) * 144 + (kb * 32 + 16 * s2) * 2 + h * 16);
        const float kb0 = (float)(t * 64 + kb * 32 + 4 * h) - qposf;
#pragma unroll
        for (int c = 0; c < 2; ++c) {
          f32x16 s;
#pragma unroll
          for (int j = 0; j < 16; ++j) s[j] = 0.f;
#pragma unroll
          for (int ks = 0; ks < 2; ++ks) { bf16x8 a = *(const bf16x8*)(Kt + (kb * 32 + r) * 144 + (c * 32 + ks * 16 + h * 8) * 2); s = __builtin_amdgcn_mfma_f32_32x32x16_bf16(a, qf[c][ks], s, 0, 0, 0); }
#pragma unroll
          for (int j = 0; j < 16; ++j) { const float dk = kb0 + (float)((j & 3) + 8 * (j >> 2)); s[j] = fmaf(-slope2, fabsf(dk), s[j]); }
          if (partial) {
#pragma unroll
            for (int j = 0; j < 16; ++j) if (t * 64 + kb * 32 + crow(j, h) >= kvis) s[j] = -1e30f; }
          float mx = s[0];
#pragma unroll
          for (int j = 1; j < 16; ++j) mx = fmaxf(mx, s[j]);
          if (__builtin_amdgcn_ballot_w64(mx > m_run[c] + 8.f) != 0ull) {
            mx = fmaxf(mx, __shfl_xor(mx, 32));
            const float m_new = fmaxf(m_run[c], mx); const float alpha = __builtin_amdgcn_exp2f(m_run[c] - m_new); m_run[c] = m_new;
            l_run[c] *= alpha;
#pragma unroll
            for (int vb = 0; vb < 2; ++vb)
#pragma unroll
              for (int j = 0; j < 16; ++j) O[c][vb][j] *= alpha;
          }
          float ls = 0.f;
#pragma unroll
          for (int j = 0; j < 16; ++j) { s[j] = __builtin_amdgcn_exp2f(s[j] - m_run[c]); ls += s[j]; }
          l_run[c] += ls;
#pragma unroll
          for (int s2 = 0; s2 < 2; ++s2) { u32 w0 = pk2(s[8 * s2], s[8 * s2 + 1]), w1 = pk2(s[8 * s2 + 2], s[8 * s2 + 3]), w2 = pk2(s[8 * s2 + 4], s[8 * s2 + 5]), w3 = pk2(s[8 * s2 + 6], s[8 * s2 + 7]);
            uint4 wv = uint4{w0, w1, w2, w3}; bf16x8 pk = __builtin_bit_cast(bf16x8, wv);
#pragma unroll
            for (int vb = 0; vb < 2; ++vb) O[c][vb] = __builtin_amdgcn_mfma_f32_32x32x16_bf16(vf[vb][s2], pk, O[c][vb], 0, 0, 0); }
          __builtin_amdgcn_sched_barrier(0);
        }
      }
    }
    if (t > 0) DF_LSTORE((t - 1) & 1);
    __syncthreads();
  }
  __builtin_amdgcn_s_setprio(0);
  if (wactive) {
    const float i0 = 1.f / (l_run[0] + __shfl_xor(l_run[0], 32)); const float i1 = lam / (l_run[1] + __shfl_xor(l_run[1], 32));
    float ss = 0.f;
#pragma unroll
    for (int vb = 0; vb < 2; ++vb)
#pragma unroll
      for (int j = 0; j < 16; ++j) { float o = O[0][vb][j] * i0 - O[1][vb][j] * i1; O[0][vb][j] = o; ss += o * o; }
    ss += __shfl_xor(ss, 32);
    const float rsd = rsqrtf(ss * (1.f / 64) + EPS) * oml;
    if (qw0 + r < nq) {
      const u16* zp = zbase + (long)(qw0 + r) * NPJ; u16* op = obase + (long)(qw0 + r) * NPJ;
#pragma unroll
      for (int vb = 0; vb < 2; ++vb)
#pragma unroll
        for (int g = 0; g < 4; ++g) { const int v0 = vb * 32 + 8 * g + 4 * h;
          uint2 z = *(const uint2*)(zp + v0); float4 gg = *(const float4*)(subg + v0);
          float y0 = O[0][vb][4 * g] * rsd * gg.x * silu(lo2f(z.x)), y1 = O[0][vb][4 * g + 1] * rsd * gg.y * silu(hi2f(z.x));
          float y2 = O[0][vb][4 * g + 2] * rsd * gg.z * silu(lo2f(z.y)), y3 = O[0][vb][4 * g + 3] * rsd * gg.w * silu(hi2f(z.y));
          uint2 o; o.x = pk2(y0, y1); o.y = pk2(y2, y3); *(uint2*)(op + v0) = o; }
    }
  }
}

DI void attn_phase(const int TID, KP p, int l, unsigned* ctr) {
  unsigned char* ws = p->ws;
  u16* proj = (u16*)(ws + WS_PROJ);
  const u16* qm = (const u16*)(ws + WS_QMLA);
  u16* olat = (u16*)(ws + WS_XN);
  const float* sc = (const float*)(ws + WS_CTL + 1024);
  const float* subg = p->in[19] + l * 64;
  volatile int* s_task = (volatile int*)(smem + TASK_OFF);
  for (;;) {
    int tid = TID; asm volatile("" : "+v"(tid));
    if (tid == 0) *s_task = (int)atomicAdd(ctr, 1u);
    __syncthreads();
    const int ti = *s_task;
    __syncthreads();
    if (ti >= g_tab.n) break;
    const u32 e = g_tab.t[ti]; const int ty = e >> 16, idx = e & 0xffff;
    if (ty == 0 || ty == 2) {
      const bool pr = (ty == 0);
      const int j = idx >> 5, b = pr ? ((idx >> 3) & 3) : (idx >> 3), hh = idx & 7;
      const long row0 = pr ? (long)b * TP + j * 256 : (long)MP + b * 16;
      const u16* kb = pr ? proj + (long)b * TP * NPJ + PC_KD + hh * 64 : (const u16*)(ws + WS_KDS) + (long)b * SKP * 512 + hh * 64;
      const u16* vt = pr ? (const u16*)(ws + WS_VDTP) + ((long)b * 512 + hh * 64) * TP : (const u16*)(ws + WS_VDTS) + ((long)b * 512 + hh * 64) * SKP;
      const float lam = sc[l * 2], oml = 1.f - sc[l * 2 + 1];
      for (int rep = 0; rep < REP_DIFF; ++rep) {
        diff_task(tid, proj + row0 * NPJ + PC_QD + hh * 64, proj + row0 * NPJ + PC_ZD + hh * 64, proj + row0 * NPJ + PC_VD + hh * 64, pr ? 256 : 16, pr ? j * 256 : PAST,
                kb, pr ? (long)NPJ : 512L, vt, pr ? TP : SKP, pr ? TP : SK, lam, oml, LOG2E * exp2f(-(float)(hh + 1)), subg);
        __syncthreads(); }
    } else if (ty == 1 || ty == 3) {
      const bool pr = (ty == 1);
      const int q32 = idx >> 2, b = pr ? (idx & 3) : idx;
      const long row0 = pr ? (long)b * TP + q32 * 32 : (long)MP + b * 16;
      const u16* kc = pr ? (const u16*)(ws + WS_CKVP) + (long)b * TP * 128 : (const u16*)(ws + WS_CKVS) + (long)b * SKP * 128;
      const u16* kr = pr ? (const u16*)(ws + WS_KRP) + (long)b * TP * 32 : (const u16*)(ws + WS_KRS) + (long)b * SKP * 32;
      const u16* vt = pr ? (const u16*)(ws + WS_CKVTP) + (long)b * 128 * TP : (const u16*)(ws + WS_CKVTS) + (long)b * 128 * SKP;
      for (int rep = 0; rep < REP_MLA; ++rep) {
        mla_task(tid, qm + row0 * 1280, pr ? 32 : 16, kc, kr, vt, pr ? TP : SKP, pr ? (q32 / 2 + 1) * 64 : SK, olat + row0 * 1024);
        __syncthreads(); }
    } else {
      const int b = idx >> 6, c = idx & 63; const long row0 = (long)b * TP + c * 64;
      const float* ab = (const float*)(ws + WS_A) + row0 * 512 + tid; const float* bb = (const float*)(ws + WS_B) + row0 * 512 + tid;
      float A = 1.f, B = 0.f;
#pragma unroll 16
      for (int i = 0; i < 64; ++i) { float a = ab[i * 512], x = bb[i * 512]; B = a * B + x; A *= a; }
      ((float2*)(ws + WS_SCAN))[(long)idx * 512 + tid] = float2{A, B};
    }
    __syncthreads();
  }
}

DI void uvscan_phase(const int TID_in, KP p, int l, int vid) {
  const int wv = __builtin_amdgcn_readfirstlane(TID_in >> 6);
  unsigned char* ws = p->ws;
  u16* proj = (u16*)(ws + WS_PROJ);
  f32x4 acc[2][2][4][2];
  for (int it = vid; it < 64 * 2 + 258 + 16; it += gridDim.x) {
    if (it < 64 * 2) {
      int pm, pn; tile_coords(it, 64, 2, pm, pn);
      const int brow = pm * 256, bcol = pn * 256;
      gemm_kloop8(fresh_tid(wv), (const u16*)(ws + WS_XN) + (long)brow * 1024 + pn * 512, 1024, (const u16*)(ws + WS_WUV) + (long)bcol * 512, 512, 8, acc);
      const int TID = fresh_tid(wv);
      GEMM_IDS
      const int oz = opaque_zero(); const int browz = brow + oz;
      u16* pz = proj + oz;
#pragma unroll
      for (int ai = 0; ai < 2; ++ai) {
        ACC_TO_LDS(ai);
        __syncthreads();
        EPI_ROWS_BEGIN(ai)
          u16* q = pz + (long)row * NPJ + PC_ZMLA + col; const uint2 z = *(const uint2*)q;
          *(uint2*)(q + (PC_QD - PC_ZMLA)) = pk4(v.x * silu(lo2f(z.x)), v.y * silu(hi2f(z.x)), v.z * silu(lo2f(z.y)), v.w * silu(hi2f(z.y)));
        EPI_ROWS_END
        __syncthreads();
      }
    } else {
      const int TID = fresh_tid(wv);
      GEMM_IDS
      const int s = it - 64 * 2;
      if (s >= 258) {
        const int q = s - 258; const int rg = q & 7, pn = q >> 3; const int row0 = MP + rg * 16, bcol = pn * 256;
        f32x4 c0, c1;
        sgemm16(lane, (const u16*)(ws + WS_XN) + (long)row0 * 1024 + pn * 512, 1024, (const u16*)(ws + WS_WUV) + (long)bcol * 512, 512, 512, wid * 32, wid * 32 + 16, c0, c1);
#pragma unroll
        for (int j = 0; j < 4; ++j) { const long row = row0 + fq * 4 + j; u16* q0 = proj + row * NPJ + PC_ZMLA + bcol + wid * 32 + fr;
          q0[PC_QD - PC_ZMLA] = f2bf(c0[j] * silu(bf2f(q0[0]))); q0[PC_QD - PC_ZMLA + 16] = f2bf(c1[j] * silu(bf2f(q0[16]))); }
        continue;
      }
      float hh; long row0; int nsteps; float* hout;
      if (s < 256) { const int b = s >> 6, c = s & 63; row0 = (long)b * TP + c * 64; nsteps = 64; hh = 0.f;
        const float2* sm = (const float2*)(ws + WS_SCAN) + (long)(b * 64) * 512 + tid;
        { int cc = 0;
          for (; cc + 16 <= c; cc += 16) { float2 t[16];
#pragma unroll
            for (int q = 0; q < 16; ++q) t[q] = sm[(long)(cc + q) * 512];
#pragma unroll
            for (int q = 0; q < 16; ++q) hh = t[q].x * hh + t[q].y; }
          for (; cc < c; ++cc) { float2 ab2 = sm[(long)cc * 512]; hh = ab2.x * hh + ab2.y; } }
        hout = (c == 63) ? p->out + O_PH + ((long)l * 4 + b) * 512 + tid : nullptr;
      } else { const int sb = (s - 256) * 4 + 0; (void)sb; row0 = 0; nsteps = 0; hh = 0.f; hout = nullptr; }
      if (s < 256) {
        const float* ab = (const float*)(ws + WS_A) + row0 * 512 + tid; const float* bb = (const float*)(ws + WS_B) + row0 * 512 + tid;
        u16* zp = proj + row0 * NPJ + PC_ZL + tid;
#pragma unroll 16
        for (int i = 0; i < nsteps; ++i) { float a = ab[(long)i * 512], x = bb[(long)i * 512]; float z = bf2f(zp[(long)i * NPJ]); hh = a * hh + x; zp[(long)i * NPJ + (PC_KD - PC_ZL)] = f2bf(hh * silu(z)); }
        if (hout) *hout = hh;
      } else {
        for (int q = 0; q < 4; ++q) { const int sb = (s - 256) * 4 + q; const long r0 = MP + sb * 16;
          float h2 = p->in[6][((long)l * 8 + sb) * 512 + tid];
          const float* ab = (const float*)(ws + WS_A) + r0 * 512 + tid; const float* bb = (const float*)(ws + WS_B) + r0 * 512 + tid;
          u16* zp = proj + r0 * NPJ + PC_ZL + tid;
#pragma unroll 16
          for (int i = 0; i < 16; ++i) { float a = ab[(long)i * 512], x = bb[(long)i * 512]; float z = bf2f(zp[(long)i * NPJ]); h2 = a * h2 + x; zp[(long)i * NPJ + (PC_KD - PC_ZL)] = f2bf(h2 * silu(z)); }
          p->out[O_SH + ((long)l * 8 + sb) * 512 + tid] = h2; }
      }
    }
  }
}

DI void oproj_phase(const int TID, KP p, int l, int vid) {
  GEMM_IDS
  unsigned char* ws = p->ws;
  f32x4 acc[1][2][4][2];
  for (int tile = vid; tile < 128 * 4; tile += gridDim.x) {
    int pm, pn; tile_coords(tile, 128, 4, pm, pn);
    const int brow = pm * 128, bcol = pn * 256;
    float4 mreg[16];
#pragma unroll
    for (int i = 0; i < 16; ++i) mreg[i] = float4{0.f, 0.f, 0.f, 0.f};
#pragma unroll 1
    for (int b = 0; b < 3; ++b) {
      const int acol = (b == 0) ? PC_QD : (b == 1) ? PC_VD : PC_KD;
      gemm_kloop_r3(TID, (const u16*)(ws + WS_PROJ) + (long)brow * NPJ + acol, NPJ, (const u16*)(ws + WS_WO) + ((long)b * 1024 + bcol) * 512, 512, 8, acc);
      const int oz = opaque_zero(); const int browz = brow + oz;
      const u16* gp = (const u16*)(ws + WS_PROJ) + oz + PC_G + b * 1024 + bcol;
      ACC_TO_LDS(0);
      __syncthreads();
#pragma unroll
      for (int it = 0; it < 16; ++it) { const int idx = it * 512 + tid; const int rl = idx >> 6, cl = (idx & 63) * 4;
        const float4 v = *(const float4*)((const float*)smem + rl * EP_LD + cl);
        const uint2 g = *(const uint2*)(gp + (long)(browz + rl) * NPJ + cl);
        mreg[it].x += lo2f(g.x) * v.x; mreg[it].y += hi2f(g.x) * v.y; mreg[it].z += lo2f(g.y) * v.z; mreg[it].w += hi2f(g.y) * v.w; }
      __syncthreads();
    }
    { const int oz = opaque_zero(); u16* mg = (u16*)(ws + WS_XN) + oz;
#pragma unroll
      for (int it = 0; it < 16; ++it) { const int idx = it * 512 + tid; const int rl = idx >> 6, cl = (idx & 63) * 4;
        *(uint2*)(mg + (long)(brow + rl) * 1024 + bcol + cl) = pk4(mreg[it].x, mreg[it].y, mreg[it].z, mreg[it].w); } }
  }
  for (int it = (int)gridDim.x - 1 - vid; it < 8 * 4; it += gridDim.x) {
    const int rg = it & 7, pn = it >> 3; const int row0 = MP + rg * 16, bcol = pn * 256;
    const u16* proj = (const u16*)(ws + WS_PROJ); u16* mg = (u16*)(ws + WS_XN);
    float m0[4] = {0.f, 0.f, 0.f, 0.f}, m1[4] = {0.f, 0.f, 0.f, 0.f};
#pragma unroll 1
    for (int b = 0; b < 3; ++b) {
      const int acol = (b == 0) ? PC_QD : (b == 1) ? PC_VD : PC_KD;
      f32x4 c0, c1;
      sgemm16(lane, proj + (long)row0 * NPJ + acol, NPJ, (const u16*)(ws + WS_WO) + ((long)b * 1024 + bcol) * 512, 512, 512, wid * 32, wid * 32 + 16, c0, c1);
#pragma unroll
      for (int j = 0; j < 4; ++j) { const long row = row0 + fq * 4 + j; const u16* g = proj + row * NPJ + PC_G + b * 1024 + bcol + wid * 32 + fr;
        m0[j] += bf2f(g[0]) * c0[j]; m1[j] += bf2f(g[16]) * c1[j]; }
    }
#pragma unroll
    for (int j = 0; j < 4; ++j) { const long row = row0 + fq * 4 + j; u16* q = mg + row * 1024 + bcol + wid * 32 + fr; q[0] = f2bf(m0[j]); q[16] = f2bf(m1[j]); }
  }
}

DI void wout_phase(const int TID_in, KP p, int l, int vid, float* outp) {
  const int wv = __builtin_amdgcn_readfirstlane(TID_in >> 6);
  unsigned char* ws = p->ws;
  f32x4 acc[2][2][4][2];
  for (int tile = vid; tile < 64 * 4; tile += gridDim.x) {
    int pm, pn; tile_coords(tile, 64, 4, pm, pn);
    const int brow = pm * 256, bcol = pn * 256;
    gemm_kloop8(fresh_tid(wv), (const u16*)(ws + WS_XN) + (long)brow * 1024, 1024, (const u16*)(ws + WS_WOUT) + (long)bcol * 1024, 1024, 16, acc);
    const int TID = fresh_tid(wv);
    GEMM_IDS
    const int oz = opaque_zero(); const int browz = brow + oz;
    float* out = outp + oz;
#pragma unroll
    for (int ai = 0; ai < 2; ++ai) {
      ACC_TO_LDS(ai);
      __syncthreads();
      EPI_ROWS_BEGIN(ai)
        if (row < M) { const float4 xo = (l == 0) ? (row < MP ? *(const float4*)(p->in[0] + (long)row * D + col) : *(const float4*)(p->in[1] + (long)(row - MP) * D + col)) : *(const float4*)(out + (long)row * D + col);
          *(float4*)(out + (long)row * D + col) = float4{xo.x + v.x, xo.y + v.y, xo.z + v.z, xo.w + v.w}; }
      EPI_ROWS_END
      __syncthreads();
    }
  }
  const int TID = fresh_tid(wv);
  GEMM_IDS
  for (int it = (int)gridDim.x - 1 - vid; it < 8 * 4; it += gridDim.x) {
    const int rg = it & 7, pn = it >> 3; const int row0 = MP + rg * 16, bcol = pn * 256;
    f32x4 c0, c1;
    sgemm16(lane, (const u16*)(ws + WS_XN) + (long)row0 * 1024, 1024, (const u16*)(ws + WS_WOUT) + (long)bcol * 1024, 1024, 1024, wid * 32, wid * 32 + 16, c0, c1);
#pragma unroll
    for (int j = 0; j < 4; ++j) { const int row = row0 + fq * 4 + j; const int col = bcol + wid * 32 + fr;
      const float* xo = (l == 0) ? p->in[1] + (long)(row - MP) * D + col : outp + (long)row * D + col;
      const float x0 = xo[0], x1 = xo[16];
      outp[(long)row * D + col] = x0 + c0[j]; outp[(long)row * D + col + 16] = x1 + c1[j]; }
  }
}

DI void final_phase(const int TID, KP p) {
  const int lane = TID & 63, wid = TID >> 6;
  const float* g = p->in[31];
  for (int row = blockIdx.x * 8 + wid; row < M; row += gridDim.x * 8) {
    float* src = p->out + (long)row * D;
    float4 v[4]; float ss = 0.f;
#pragma unroll
    for (int i = 0; i < 4; ++i) { v[i] = *(const float4*)(src + i * 256 + lane * 4); ss += v[i].x * v[i].x + v[i].y * v[i].y + v[i].z * v[i].z + v[i].w * v[i].w; }
    ss = wsum(ss); const float rs = rsqrtf(ss * (1.f / D) + EPS);
#pragma unroll
    for (int i = 0; i < 4; ++i) { float4 gg = *(const float4*)(g + i * 256 + lane * 4);
      *(float4*)(src + i * 256 + lane * 4) = float4{v[i].x * rs * gg.x, v[i].y * rs * gg.y, v[i].z * rs * gg.z, v[i].w * rs * gg.w}; }
  }
}


#define XB_TMO      128
#define XB_XCNT(j)  (256  + 64 * (j))
#define XB_XSUB(j)  (1280 + 64 * (j))
#define XB_XGEN(j)  (2304 + 64 * (j))
#define XB_TOP      3328
#define XB_TOPGEN   3392
#define XCD_BAR_WORDS 3456
#define XB_SPIN_CAP (1u << 22)
#define LAS __attribute__((address_space(3)))
DI unsigned xb_ld(unsigned* p) { return __hip_atomic_load(p, __ATOMIC_RELAXED, __HIP_MEMORY_SCOPE_AGENT); }
DI unsigned xb_add(unsigned* p, unsigned v) { return __hip_atomic_fetch_add(p, v, __ATOMIC_RELAXED, __HIP_MEMORY_SCOPE_AGENT); }
DI unsigned xb_xcc_id() { return (unsigned)__builtin_amdgcn_s_getreg((3 << 11) | 20) & 0xFu; }
#define XB_SPIN(cond, bar) do { unsigned _sp = 0; while (cond) { __builtin_amdgcn_s_sleep(1); \
    if ((++_sp & 255u) == 0u) { if (xb_ld(&(bar)[XB_TMO])) break; if (_sp > XB_SPIN_CAP) { atomicAdd(&(bar)[XB_TMO], 1u); break; } } } } while (0)
DI void xcd_barrier_complete(unsigned* bar, unsigned x, unsigned& nloc, unsigned& nx) {
  const unsigned G = gridDim.x;
  unsigned sum, cnt, mine, sp = 0u;
  for (;;) {
    sum = 0u; cnt = 0u; mine = 0u;
#pragma unroll
    for (unsigned j = 0; j < 16; ++j) { const unsigned c = xb_ld(&bar[XB_XCNT(j)]); sum += c; cnt += (c > 0u) ? 1u : 0u; mine = (j == x) ? c : mine; }
    if (sum == G) break;
    __builtin_amdgcn_s_sleep(1);
    if ((++sp & 255u) == 0u) { if (xb_ld(&bar[XB_TMO])) break; if (sp > XB_SPIN_CAP) { atomicAdd(&bar[XB_TMO], 1u); break; } }
  }
  nloc = mine > 0u ? mine : 1u; nx = cnt > 0u ? cnt : 1u;
}
DI void xcd_barrier(const int TID, unsigned* bar, unsigned x) {
  volatile LAS unsigned* st = (volatile LAS unsigned*)(smem + TASK_OFF + 16);
  asm volatile("s_waitcnt vmcnt(0)" ::: "memory");
  __syncthreads();
  if (TID == 0) {
    __builtin_amdgcn_s_waitcnt(0);
    unsigned nloc = st[0], nx = st[1];
    if (nloc == 0u) { xcd_barrier_complete(bar, x, nloc, nx); st[0] = nloc; st[1] = nx; }
    const unsigned old = xb_add(&bar[XB_XSUB(x)], 1u);
    const unsigned gen = old / nloc;
    if (old + 1u == (gen + 1u) * nloc) {
      __builtin_amdgcn_fence(__ATOMIC_RELEASE, "agent");
      asm volatile("s_waitcnt vmcnt(0)" ::: "memory");
      const unsigned og = xb_add(&bar[XB_TOP], 1u);
      const unsigned tg = og / nx;
      if (og + 1u == (tg + 1u) * nx) xb_add(&bar[XB_TOPGEN], 1u);
      else XB_SPIN(xb_ld(&bar[XB_TOPGEN]) == tg, bar);
      __builtin_amdgcn_fence(__ATOMIC_ACQUIRE, "agent");
      xb_add(&bar[XB_XGEN(x)], 1u);
      asm volatile("s_waitcnt vmcnt(0)" ::: "memory");
    } else {
      XB_SPIN(xb_ld(&bar[XB_XGEN(x)]) == gen, bar);
      __builtin_amdgcn_fence(__ATOMIC_ACQUIRE, "agent");
      asm volatile("s_waitcnt vmcnt(0)" ::: "memory");
    }
  }
  __syncthreads();
}

__global__ void __launch_bounds__(512, 2) mega(Params p_) {
  const int wave_s = __builtin_amdgcn_readfirstlane((int)(__builtin_amdgcn_workitem_id_x() >> 6));
  const int G = gridDim.x, bx = blockIdx.x;
  const int vid = (G % 8 == 0) ? (bx % 8) * (G / 8) + bx / 8 : bx;
  const int ph_lo = p_.ph_lo, ph_hi = p_.ph_hi;
  const unsigned xcc = xb_xcc_id();
  { const int t0 = __builtin_amdgcn_workitem_id_x(); if (t0 < 4) ((volatile LAS unsigned*)(smem + TASK_OFF))[4 + t0] = 0u; __syncthreads();
    if (t0 == 0) (void)xb_add((unsigned*)(p_.ws + WS_BAR) + XB_XCNT(xcc), 1u); }
  if (ph_hi - ph_lo > 1) cg::this_grid().sync();
  for (int ph = ph_lo; ph < ph_hi; ++ph) {
    int TID; asm volatile("v_mbcnt_lo_u32_b32 %0, -1, 0\n\tv_mbcnt_hi_u32_b32 %0, -1, %0" : "=v"(TID)); TID += wave_s * 64;
    KP p = (KP)__builtin_amdgcn_kernarg_segment_ptr(); asm volatile("" : "+s"(p));
    unsigned* ctrs = (unsigned*)(p->ws + WS_CTL);
    if (ph == NPH - 1) final_phase(TID, p);
    else {
      const int l = ph >> 3, s = ph & 7;
      switch (s) {
        case 0: for (int rep = 0; rep < REP_PREP; ++rep) { prep_phase(TID, p, l); __syncthreads(); } break;
        case 1: for (int rep = 0; rep < REP_INPROJ; ++rep) { inproj_phase(TID, p, l, vid); __syncthreads(); } break;
        case 2: mid_phase(TID, p, l); break;
        case 3: for (int rep = 0; rep < REP_QLRU; ++rep) { qlru_phase(TID, p, l, vid); __syncthreads(); } break;
        case 4: for (int rep = 0; rep < REP_ATTN; ++rep) { attn_phase(TID, p, l, ctrs + ph + 64 * rep); __syncthreads(); } break;
        case 5: for (int rep = 0; rep < REP_UVSCAN; ++rep) { uvscan_phase(TID, p, l, vid); __syncthreads(); } break;
        case 6: for (int rep = 0; rep < REP_OPROJ; ++rep) { oproj_phase(TID, p, l, vid); __syncthreads(); } break;
        default: wout_phase(TID, p, l, vid, p->out); break;
      }
    }
    if (TAIL_PHASE >= 0 && ph == NPH - 1) {
      for (int rep = 0; rep < TAIL_REPS; ++rep) {
        xcd_barrier(TID, (unsigned*)(p->ws + WS_BAR), xcc);
        if (TAIL_PHASE == 2) mid_phase(TID, p, 3);
        else if (TAIL_PHASE == 7) wout_phase(TID, p, 3, vid, (float*)(p->ws + WS_PROJ));
        else if (TAIL_PHASE == 1) inproj_phase(TID, p, 3, vid);
        else if (TAIL_PHASE == 6) oproj_phase(TID, p, 3, vid);
        else if (TAIL_PHASE == 8) final_phase(TID, p);
        __syncthreads();
      }
    }
    if (ph + 1 < ph_hi) {
      xcd_barrier(TID, (unsigned*)(p->ws + WS_BAR), xcc);
      for (int e = 0; e < EXTRA_SYNC; ++e) xcd_barrier(TID, (unsigned*)(p->ws + WS_BAR), xcc);
    }
  }
}

extern "C" void kernel_launch(void* const* d_in, const int* in_sizes, int n_in, void* d_out, int out_size, void* d_ws, size_t ws_size, hipStream_t stream) {
  static int grid = 0;
  if (grid == 0) {
    if (n_in != 32 || (long)out_size != O_END || ws_size < WS_END) { fprintf(stderr, "kernel_launch: unexpected shapes (n_in %d out %d ws %zu need %zu)\n", n_in, out_size, ws_size, (size_t)WS_END); grid = -1; return; }
    int dev = 0, cus = 0, per_cu = 0;
    (void)hipGetDevice(&dev); (void)hipDeviceGetAttribute(&cus, hipDeviceAttributeMultiprocessorCount, dev);
    if (hipFuncSetAttribute((const void*)mega, hipFuncAttributeMaxDynamicSharedMemorySize, LDS_BYTES) != hipSuccess) { fprintf(stderr, "hipFuncSetAttribute failed\n"); grid = -1; return; }
    if (hipOccupancyMaxActiveBlocksPerMultiprocessor(&per_cu, (const void*)mega, 512, LDS_BYTES) != hipSuccess || per_cu < 1) { fprintf(stderr, "occupancy query failed (%d)\n", per_cu); per_cu = 1; }
    (void)hipGetLastError();
    grid = cus;
  }
  if (grid < 0) return;
  (void)hipMemsetAsync((char*)d_ws + WS_CTL, 0, WS_ROPE, stream);
  Params p{};
  for (int i = 0; i < 32; ++i) p.in[i] = (const float*)d_in[i];
  p.out = (float*)d_out; p.ws = (unsigned char*)d_ws;
#if ONE_LAUNCH
  p.ph_lo = 0; p.ph_hi = NPH;
  void* args[] = {&p};
  hipError_t e = hipLaunchCooperativeKernel((const void*)mega, dim3(grid), dim3(512), args, LDS_BYTES, stream);
  if (e != hipSuccess) fprintf(stderr, "cooperative launch failed: %s\n", hipGetErrorString(e));
#else
  for (int ph = 0; ph < NPH; ++ph) { p.ph_lo = ph; p.ph_hi = ph + 1; hipLaunchKernelGGL(mega, dim3(grid), dim3(512), LDS_BYTES, stream, p); }
#endif
}
```

```cpp
#include <hip/hip_runtime.h>
#include <hip/hip_cooperative_groups.h>
#include <cstdio>
namespace cg = cooperative_groups;

#ifndef ONE_LAUNCH
#define ONE_LAUNCH 1
#endif
#define REP_PREP 1
#define REP_INPROJ 1
#define REP_QLRU 1
#define REP_ATTN 1
#define REP_OPROJ 1
#define REP_UVSCAN 1
#define TAIL_PHASE -1
#define TAIL_REPS 4
#define REP_MLA 1
#define REP_DIFF 1
#define EXTRA_SYNC 0

typedef unsigned short u16;
typedef unsigned int u32;
using bf16x8 = __attribute__((ext_vector_type(8))) short;
using s16x4  = __attribute__((ext_vector_type(4))) short;
using f32x4  = __attribute__((ext_vector_type(4))) float;
using f32x16 = __attribute__((ext_vector_type(16))) float;
typedef float f32x2 __attribute__((ext_vector_type(2)));
typedef __bf16 bf16x2 __attribute__((ext_vector_type(2)));
#define DI __device__ __forceinline__

constexpr int D = 1024, TP = 4096, MP = 16384, TS = 16, MS = 128, M = MP + MS, MT = 65, MPAD = MT * 256;
constexpr int PAST = 2048, SK = PAST + TS, SKP = 2112;
constexpr int NIN = 7072, NPJ = 7168, DEPTH = 4;
constexpr float EPS = 1e-6f;
constexpr float LOG2E = 1.4426950408889634f;
constexpr float QM_SCALE = 0.10206207261596575f * LOG2E;
constexpr float QD_SCALE = 0.17677669529663687f * LOG2E;
constexpr int PC_CQ = 0, PC_CKV = 256, PC_KR = 384, PC_ZMLA = 512, PC_QD = 1024, PC_KD = 1536, PC_VD = 2048, PC_ZD = 2560,
              PC_XL = 3072, PC_ZL = 3584, PC_G = 4096;
constexpr long O_YP = 0, O_YS = O_YP + (long)MP * D, O_PCKV = O_YS + (long)MS * D, O_PKR = O_PCKV + 4L * MP * 128,
               O_PDK = O_PKR + 4L * MP * 32, O_PDV = O_PDK + 4L * MP * 512, O_PH = O_PDV + 4L * MP * 512, O_PCV = O_PH + 4L * 4 * 512,
               O_SCKV = O_PCV + 4L * 4 * 3 * 512, O_SKR = O_SCKV + 4L * MS * 128, O_SDK = O_SKR + 4L * MS * 32, O_SDV = O_SDK + 4L * MS * 512,
               O_SH = O_SDV + 4L * MS * 512, O_SCV = O_SH + 4L * 8 * 512, O_END = O_SCV + 4L * 8 * 3 * 512;
constexpr size_t al(size_t x) { return (x + 255) & ~(size_t)255; }
constexpr size_t WS_CTL = 0, WS_BAR = 4096, WS_ROPE = 20480, WS_WIN = WS_ROPE + al(4096 * 16 * 8), WS_WQ = WS_WIN + al((size_t)NPJ * 1024 * 2),
                 WS_WUV = WS_WQ + al(1280 * 256 * 2), WS_WO = WS_WUV + al(512 * 512 * 2), WS_WOUT = WS_WO + al(3 * 1024 * 512 * 2),
                 WS_WLRU = WS_WOUT + al(1024 * 1024 * 2), WS_XN = WS_WLRU + al(1024 * 256 * 2), WS_PROJ = WS_XN + al((size_t)MPAD * 1024 * 2),
                 WS_QMLA = WS_PROJ + al((size_t)MPAD * NPJ * 2), WS_XC = WS_QMLA + al((size_t)MPAD * 1280 * 2), WS_A = WS_XC + al((size_t)MPAD * 512 * 2),
                 WS_B = WS_A + al((size_t)M * 512 * 4), WS_SCAN = WS_B + al((size_t)M * 512 * 4), WS_CKVP = WS_SCAN + al(4 * 64 * 512 * 8),
                 WS_CKVTP = WS_CKVP + al((size_t)MP * 128 * 2), WS_KRP = WS_CKVTP + al((size_t)MP * 128 * 2), WS_VDTP = WS_KRP + al((size_t)MP * 32 * 2),
                 WS_CKVS = WS_VDTP + al((size_t)MP * 512 * 2), WS_CKVTS = WS_CKVS + al(8 * SKP * 128 * 2), WS_KRS = WS_CKVTS + al(8 * SKP * 128 * 2),
                 WS_KDS = WS_KRS + al(8 * SKP * 32 * 2), WS_VDTS = WS_KDS + al((size_t)8 * SKP * 512 * 2), WS_END = WS_VDTS + al((size_t)8 * SKP * 512 * 2);
constexpr int EP_LD = 260;
constexpr int LDS_BYTES = 147456 + 256;
constexpr int TASK_OFF = 147456;
constexpr int NPH = 33;

struct Params { const float* in[32]; float* out; unsigned char* ws; int ph_lo, ph_hi; };
typedef const Params __attribute__((address_space(4)))* KP;

extern __shared__ __attribute__((aligned(16))) unsigned char smem[];

DI float bf2f(u16 v) { return __uint_as_float((u32)v << 16); }
DI u32 pk2(float a, float b) { f32x2 v = {a, b}; bf16x2 r = __builtin_convertvector(v, bf16x2); return __builtin_bit_cast(u32, r); }
DI u16 f2bf(float a) { return (u16)(pk2(a, 0.f) & 0xffffu); }
DI float lo2f(u32 v) { return __uint_as_float(v << 16); }
DI float hi2f(u32 v) { return __uint_as_float(v & 0xffff0000u); }
DI float sigm(float x) { return 1.f / (1.f + __expf(-x)); }
DI float silu(float x) { return x / (1.f + __expf(-x)); }
DI float softplus_f(float x) { return fmaxf(x, 0.f) + __logf(1.f + __expf(-fabsf(x))); }
DI float neg_expm1(float x) { const float t = x * (1.f + x * (0.5f + x * (0.16666667f + x * 0.041666668f))); return (x > -0.1f) ? -t : 1.f - __expf(x); }
DI float wsum(float v) { for (int o = 32; o; o >>= 1) v += __shfl_xor(v, o); return v; }
DI int kperm(int k) { int q = (k >> 2) & 3; q = (q == 1) ? 2 : (q == 2) ? 1 : q; return (k & ~15) | (q << 2) | (k & 3); }
DI int crow(int reg, int h) { return (reg & 3) + 8 * (reg >> 2) + 4 * h; }
DI int row_pos(int row) { return row < MP ? (row & (TP - 1)) : PAST + ((row - MP) & 15); }

struct TaskTab { int n; u32 t[1408]; };
constexpr TaskTab make_tab() {
  TaskTab x{}; int n = 0;
  for (int i = 0; i < 64; ++i) x.t[n++] = (2u << 16) | i;
  for (int i = 0; i < 8; ++i) x.t[n++] = (3u << 16) | i;
  for (int L = 144; L >= 1; --L) {
    for (int j = 0; j < 16; ++j) if (9 * (j + 1) == L) for (int i = 0; i < 32; ++i) x.t[n++] = (0u << 16) | (j * 32 + i);
    for (int q = 0; q < 128; ++q) if (q / 2 + 1 == L) for (int b = 0; b < 4; ++b) x.t[n++] = (1u << 16) | (q * 4 + b);
  }
  for (int i = 0; i < 256; ++i) x.t[n++] = (4u << 16) | i;
  x.n = n; return x;
}
__device__ const TaskTab g_tab = make_tab();
__device__ const float g_invf[16] = {1.0f, 0.5623413251903491f, 0.31622776601683794f, 0.1778279410038923f, 0.1f, 0.05623413251903491f,
  0.031622776601683794f, 0.01778279410038923f, 0.01f, 0.005623413251903491f, 0.0031622776601683794f, 0.001778279410038923f, 0.001f,
  0.0005623413251903491f, 0.00031622776601683794f, 0.0001778279410038923f};

DI int lds_byte(int r, int c) { int st = (r >> 4) * 2 + (c >> 5), rr = r & 15, cc = c & 31, ob = rr * 64 + cc * 2; return st * 1024 + (ob ^ (((ob >> 9) & 1) << 5)); }
DI void stage_rc(int b, int& R, int& C) { int st = b >> 10, sb = b & 1023, swz = sb ^ (((sb >> 9) & 1) << 5); R = (st >> 1) * 16 + (swz >> 6); C = (st & 1) * 32 + ((swz & 63) >> 1); }

#define SA(b, h) (smem + ((b) * 2 + (h)) * 16384)
#define SB(b, h) (smem + (4 + (b) * 2 + (h)) * 16384)
#define STAGE_A(P, half, kt) do { const u16* _g = A + (long)(half) * 128 * lda + (long)(kt) * 64; \
    __builtin_amdgcn_global_load_lds((const unsigned*)(_g + offA0), (unsigned*)((P) + wbase), 16, 0, 0); \
    __builtin_amdgcn_global_load_lds((const unsigned*)(_g + 64 * lda + offA0), (unsigned*)((P) + wbase + 8192), 16, 0, 0); } while (0)
#define STAGE_B(P, half, kt) do { const u16* _g = Bt + (long)(half) * 128 * ldb + (long)(kt) * 64; \
    __builtin_amdgcn_global_load_lds((const unsigned*)(_g + offB0), (unsigned*)((P) + wbase), 16, 0, 0); \
    __builtin_amdgcn_global_load_lds((const unsigned*)(_g + 64 * ldb + offB0), (unsigned*)((P) + wbase + 8192), 16, 0, 0); } while (0)
#define LDA(dst, b, h) _Pragma("unroll") for (int m = 0; m < 4; ++m) _Pragma("unroll") for (int k = 0; k < 2; ++k) \
    dst[m][k] = *reinterpret_cast<const bf16x8*>(SA(b, h) + lds_byte(wr * 64 + m * 16 + fr, k * 32 + fq * 8))
#define LDB(dst, b, h) _Pragma("unroll") for (int n = 0; n < 2; ++n) _Pragma("unroll") for (int k = 0; k < 2; ++k) \
    dst[n][k] = *reinterpret_cast<const bf16x8*>(SB(b, h) + lds_byte(wc * 32 + n * 16 + fr, k * 32 + fq * 8))
#define MMA(ai, bj, At, Bx) do { __builtin_amdgcn_s_setprio(1); \
    _Pragma("unroll") for (int m = 0; m < 4; ++m) _Pragma("unroll") for (int n = 0; n < 2; ++n) _Pragma("unroll") for (int k = 0; k < 2; ++k) \
      acc[ai][bj][m][n] = __builtin_amdgcn_mfma_f32_16x16x32_bf16(At[m][k], Bx[n][k], acc[ai][bj][m][n], 0, 0, 0); \
    __builtin_amdgcn_s_setprio(0); } while (0)
#define WAIT_V(n) asm volatile("s_waitcnt vmcnt(" #n ")" ::: "memory")
#define WAIT_L(n) asm volatile("s_waitcnt lgkmcnt(" #n ")" ::: "memory")
#define BAR __builtin_amdgcn_s_barrier()
#define SCHED __builtin_amdgcn_sched_barrier(0)

template <int NA> DI void gemm_kloop(const int TID, const u16* __restrict__ A, int lda, const u16* __restrict__ Bt, int ldb, int nt, f32x4 (&acc)[NA][2][4][2]) {
  const int tid = TID, wid = tid >> 6, lane = tid & 63, wr = wid >> 2, wc = wid & 3, fr = lane & 15, fq = lane >> 4;
  unsigned offA0, offB0;
  { int r, c; stage_rc(tid * 16, r, c); offA0 = r * lda + c; offB0 = r * ldb + c; }
  const int wbase = __builtin_amdgcn_readfirstlane(wid) * 1024;
#pragma unroll
  for (int a = 0; a < NA; ++a)
#pragma unroll
    for (int b = 0; b < 2; ++b)
#pragma unroll
      for (int m = 0; m < 4; ++m)
#pragma unroll
        for (int n = 0; n < 2; ++n) acc[a][b][m][n] = f32x4{0.f, 0.f, 0.f, 0.f};
  STAGE_B(SB(0, 0), 0, 0); STAGE_A(SA(0, 0), 0, 0); STAGE_B(SB(0, 1), 1, 0); if (NA == 2) STAGE_A(SA(0, 1), 1, 0);
  WAIT_V(0); __syncthreads();
#pragma unroll 1
  for (int t = 0; t < nt; ++t) {
    const int cb = t & 1, nb = cb ^ 1;
    if (t + 1 < nt) { STAGE_B(SB(nb, 0), 0, t + 1); STAGE_A(SA(nb, 0), 0, t + 1); STAGE_B(SB(nb, 1), 1, t + 1); if (NA == 2) STAGE_A(SA(nb, 1), 1, t + 1); }
#pragma unroll 1
    for (int k = 0; k < 2; ++k) {
      bf16x8 Bf[2][2];
#pragma unroll
      for (int bj = 0; bj < 2; ++bj)
#pragma unroll
        for (int n = 0; n < 2; ++n) Bf[bj][n] = *reinterpret_cast<const bf16x8*>(SB(cb, bj) + lds_byte(wc * 32 + n * 16 + fr, k * 32 + fq * 8));
#pragma unroll
      for (int ai = 0; ai < NA; ++ai) {
        bf16x8 Af[4];
#pragma unroll
        for (int m = 0; m < 4; ++m) Af[m] = *reinterpret_cast<const bf16x8*>(SA(cb, ai) + lds_byte(wr * 64 + m * 16 + fr, k * 32 + fq * 8));
#pragma unroll
        for (int bj = 0; bj < 2; ++bj)
#pragma unroll
          for (int m = 0; m < 4; ++m)
#pragma unroll
            for (int n = 0; n < 2; ++n) acc[ai][bj][m][n] = __builtin_amdgcn_mfma_f32_16x16x32_bf16(Af[m], Bf[bj][n], acc[ai][bj][m][n], 0, 0, 0);
      }
    }
    WAIT_V(0); __syncthreads();
  }
}

#define LDA8(dst, b, h) _Pragma("unroll") for (int m = 0; m < 4; ++m) _Pragma("unroll") for (int k = 0; k < 2; ++k) \
    dst[m][k] = *reinterpret_cast<const bf16x8*>(SA(b, h) + lds_byte(wr * 64 + m * 16 + fr, k * 32 + fq * 8))
#define LDB8(dst, b, h) _Pragma("unroll") for (int n = 0; n < 2; ++n) _Pragma("unroll") for (int k = 0; k < 2; ++k) \
    dst[n][k] = *reinterpret_cast<const bf16x8*>(SB(b, h) + lds_byte(wc * 32 + n * 16 + fr, k * 32 + fq * 8))
#define MMA8(ai, bj, At, Bx) do { __builtin_amdgcn_s_setprio(1); \
    _Pragma("unroll") for (int m = 0; m < 4; ++m) _Pragma("unroll") for (int n = 0; n < 2; ++n) _Pragma("unroll") for (int k = 0; k < 2; ++k) \
      acc[ai][bj][m][n] = __builtin_amdgcn_mfma_f32_16x16x32_bf16(At[m][k], Bx[n][k], acc[ai][bj][m][n], 0, 0, 0); \
    __builtin_amdgcn_s_setprio(0); } while (0)
DI void gemm_kloop8(const int TID, const u16* __restrict__ A, int lda, const u16* __restrict__ Bt, int ldb, int nt, f32x4 (&acc)[2][2][4][2]) {
  const int tid = TID, wid = tid >> 6, lane = tid & 63, wr = wid >> 2, wc = wid & 3, fr = lane & 15, fq = lane >> 4;
  unsigned offA0, offB0;
  { int r, c; stage_rc(tid * 16, r, c); offA0 = r * lda + c; offB0 = r * ldb + c; }
  const int wbase = __builtin_amdgcn_readfirstlane(wid) * 1024;
#pragma unroll
  for (int a = 0; a < 2; ++a)
#pragma unroll
    for (int b = 0; b < 2; ++b)
#pragma unroll
      for (int m = 0; m < 4; ++m)
#pragma unroll
        for (int n = 0; n < 2; ++n) acc[a][b][m][n] = f32x4{0.f, 0.f, 0.f, 0.f};
  bf16x8 At[4][2], B0[2][2], B1[2][2];
  STAGE_B(SB(0, 0), 0, 0); STAGE_A(SA(0, 0), 0, 0);
  STAGE_B(SB(0, 1), 1, 0); STAGE_A(SA(0, 1), 1, 0);
  if (wr == 1) BAR;
  WAIT_V(4); BAR;
  STAGE_B(SB(1, 0), 0, 1); STAGE_A(SA(1, 0), 0, 1); STAGE_B(SB(1, 1), 1, 1);
  WAIT_V(6); BAR;
#pragma unroll 1
  for (int t = 0; t < nt - 2; t += 2) {
    LDB8(B0, 0, 0); SCHED; LDA8(At, 0, 0); STAGE_A(SA(1, 1), 1, t + 1);
    WAIT_L(8); BAR; WAIT_L(0); MMA8(0, 0, At, B0); BAR; SCHED;
    LDB8(B1, 0, 1); STAGE_B(SB(0, 0), 0, t + 2);
    BAR; WAIT_L(0); MMA8(0, 1, At, B1); BAR;
    LDA8(At, 0, 1); STAGE_A(SA(0, 0), 0, t + 2);
    BAR; WAIT_L(0); MMA8(1, 0, At, B0); BAR; SCHED;
    STAGE_B(SB(0, 1), 1, t + 2);
    WAIT_V(6); BAR; MMA8(1, 1, At, B1); BAR;
    LDB8(B0, 1, 0); SCHED; LDA8(At, 1, 0); STAGE_A(SA(0, 1), 1, t + 2);
    WAIT_L(8); BAR; WAIT_L(0); MMA8(0, 0, At, B0); BAR; SCHED;
    LDB8(B1, 1, 1); STAGE_B(SB(1, 0), 0, t + 3);
    BAR; WAIT_L(0); MMA8(0, 1, At, B1); BAR;
    LDA8(At, 1, 1); STAGE_A(SA(1, 0), 0, t + 3);
    BAR; WAIT_L(0); MMA8(1, 0, At, B0); BAR; SCHED;
    STAGE_B(SB(1, 1), 1, t + 3);
    WAIT_V(6); BAR; MMA8(1, 1, At, B1); BAR;
  }
  { LDB8(B0, 0, 0); LDA8(At, 0, 0); STAGE_A(SA(1, 1), 1, nt - 1);
    BAR; WAIT_L(0); MMA8(0, 0, At, B0); BAR;
    LDB8(B1, 0, 1); BAR; WAIT_L(0); MMA8(0, 1, At, B1); BAR;
    LDA8(At, 0, 1); WAIT_V(4); BAR; WAIT_L(0); MMA8(1, 0, At, B0); MMA8(1, 1, At, B1); BAR; }
  { LDB8(B0, 1, 0); LDA8(At, 1, 0); WAIT_V(2); BAR; WAIT_L(0); MMA8(0, 0, At, B0); BAR;
    LDB8(B1, 1, 1); WAIT_V(0); BAR; WAIT_L(0); MMA8(0, 1, At, B1); BAR;
    LDA8(At, 1, 1); BAR; WAIT_L(0); MMA8(1, 0, At, B0); MMA8(1, 1, At, B1); BAR; }
  if (wr == 0) BAR;
  __syncthreads();
}

DI void gemm_kloop_r3(const int TID, const u16* __restrict__ A, int lda, const u16* __restrict__ Bt, int ldb, int nt, f32x4 (&acc)[1][2][4][2]) {
  const int tid = TID, wid = tid >> 6, lane = tid & 63, wr = wid >> 2, wc = wid & 3, fr = lane & 15, fq = lane >> 4;
  unsigned offA0, offB0;
  { int r, c; stage_rc(tid * 16, r, c); offA0 = r * lda + c; offB0 = r * ldb + c; }
  const int wbase = __builtin_amdgcn_readfirstlane(wid) * 1024;
#pragma unroll
  for (int b = 0; b < 2; ++b)
#pragma unroll
    for (int m = 0; m < 4; ++m)
#pragma unroll
      for (int n = 0; n < 2; ++n) acc[0][b][m][n] = f32x4{0.f, 0.f, 0.f, 0.f};
#define R3A(i) (smem + (i) * 49152)
#define R3B(i, h) (smem + (i) * 49152 + 16384 + (h) * 16384)
#define R3_STAGE(i, kt) do { STAGE_B(R3B(i, 0), 0, kt); STAGE_A(R3A(i), 0, kt); STAGE_B(R3B(i, 1), 1, kt); } while (0)
  R3_STAGE(0, 0); R3_STAGE(1, 1);
  WAIT_V(6); BAR;
  int cur = 0;
#pragma unroll 1
  for (int t = 0; t < nt; ++t) {
    const int nx1 = (cur == 2) ? 0 : cur + 1, nx2 = (cur == 0) ? 2 : cur - 1;
    if (t + 2 < nt) R3_STAGE(nx2, t + 2);
#pragma unroll
    for (int k = 0; k < 2; ++k) {
      bf16x8 Bf[2][2], Af[4];
#pragma unroll
      for (int bj = 0; bj < 2; ++bj)
#pragma unroll
        for (int n = 0; n < 2; ++n) Bf[bj][n] = *reinterpret_cast<const bf16x8*>(R3B(cur, bj) + lds_byte(wc * 32 + n * 16 + fr, k * 32 + fq * 8));
#pragma unroll
      for (int m = 0; m < 4; ++m) Af[m] = *reinterpret_cast<const bf16x8*>(R3A(cur) + lds_byte(wr * 64 + m * 16 + fr, k * 32 + fq * 8));
#pragma unroll
      for (int bj = 0; bj < 2; ++bj)
#pragma unroll
        for (int m = 0; m < 4; ++m)
#pragma unroll
          for (int n = 0; n < 2; ++n) acc[0][bj][m][n] = __builtin_amdgcn_mfma_f32_16x16x32_bf16(Af[m], Bf[bj][n], acc[0][bj][m][n], 0, 0, 0);
    }
    if (t + 2 < nt) WAIT_V(6); else WAIT_V(0);
    WAIT_L(0); BAR;
    cur = nx1;
  }
}

DI void tile_coords(int tile, int nM, int nN, int& pm, int& pn) {
  int nig = 8 * nN, gid = tile / nig, fm = gid * 8, gsz = min(nM - fm, 8), loc = tile % nig;
  pm = fm + loc % gsz; pn = loc / gsz;
}

#define GEMM_IDS const int tid = TID, wid = tid >> 6, lane = tid & 63, wr = wid >> 2, wc = wid & 3, fr = lane & 15, fq = lane >> 4; (void)tid; (void)wr; (void)wc; (void)fr; (void)fq; (void)lane;
DI int fresh_tid(int wv) { int l; asm volatile("v_mbcnt_lo_u32_b32 %0, -1, 0\n\tv_mbcnt_hi_u32_b32 %0, -1, %0" : "=v"(l)); return wv * 64 + l; }
DI int opaque_zero() { int z; asm volatile("s_mov_b32 %0, 0" : "=s"(z)); return z; }
#define ACC_TO_LDS(ai) do { float* _e = (float*)smem; \
  _Pragma("unroll") for (int bj = 0; bj < 2; ++bj) _Pragma("unroll") for (int m = 0; m < 4; ++m) _Pragma("unroll") for (int n = 0; n < 2; ++n) _Pragma("unroll") for (int j = 0; j < 4; ++j) \
    _e[(wr * 64 + m * 16 + fq * 4 + j) * EP_LD + bj * 128 + wc * 32 + n * 16 + fr] = acc[ai][bj][m][n][j]; } while (0)
#define EPI_ROWS_BEGIN(ai) _Pragma("unroll 4") for (int _it = 0; _it < 16; ++_it) { const int _idx = _it * 512 + tid; const int rl = _idx >> 6, cl = (_idx & 63) * 4; \
    const float4 v = *(const float4*)((const float*)smem + rl * EP_LD + cl); const int row = browz + (ai) * 128 + rl; const int col = bcol + cl; (void)row; (void)col;
#define EPI_ROWS_END }
DI uint2 pk4(float a, float b, float c, float d) { uint2 o; o.x = pk2(a, b); o.y = pk2(c, d); return o; }

DI void sgemm16(const int lane, const u16* __restrict__ A, int lda, const u16* __restrict__ Bt, int ldb, int K, int bc0, int bc1, f32x4& c0, f32x4& c1) {
  const int fr = lane & 15, fq = lane >> 4;
  const u16* ap = A + (long)fr * lda + fq * 8;
  const u16* b0 = Bt + (long)(bc0 + fr) * ldb + fq * 8; const u16* b1 = Bt + (long)(bc1 + fr) * ldb + fq * 8;
  c0 = f32x4{0.f, 0.f, 0.f, 0.f}; c1 = c0;
#pragma unroll 8
  for (int k = 0; k < K; k += 32) { const bf16x8 a = *(const bf16x8*)(ap + k), x = *(const bf16x8*)(b0 + k), y = *(const bf16x8*)(b1 + k);
    c0 = __builtin_amdgcn_mfma_f32_16x16x32_bf16(a, x, c0, 0, 0, 0); c1 = __builtin_amdgcn_mfma_f32_16x16x32_bf16(a, y, c1, 0, 0, 0); }
}
DI void inproj_store_s(KP p, int l, int row, int col, float v) {
  unsigned char* ws = p->ws; u16* proj = (u16*)(ws + WS_PROJ);
  const int rs = row - MP;
  if (col >= PC_G) proj[(long)row * NPJ + col] = f2bf(sigm(v));
  else if (col >= PC_QD && col < PC_KD) proj[(long)row * NPJ + col] = f2bf(v * QD_SCALE);
  else if (col >= PC_KD && col < PC_VD) { const int hv = col - PC_KD; p->out[O_SDK + (long)l * MS * 512 + rs * 512 + hv] = v;
    ((u16*)(ws + WS_KDS))[((long)(rs >> 4) * SKP + PAST + (rs & 15)) * 512 + hv] = f2bf(v); }
  else if (col >= PC_VD && col < PC_ZD) { const int hv = col - PC_VD; p->out[O_SDV + (long)l * MS * 512 + rs * 512 + hv] = v;
    ((u16*)(ws + WS_VDTS))[((long)(rs >> 4) * 512 + hv) * SKP + kperm(PAST + (rs & 15))] = f2bf(v); }
  else proj[(long)row * NPJ + col] = f2bf(v);
}

template <bool PERM> DI void transpose_tile(const int TID, const float* __restrict__ src, long ld_s, u16* __restrict__ dst, long ld_d, int r0, int c0, int drow0) {
  u16* tl = (u16*)smem;
  const int tid = TID;
  { int rr = tid >> 3, cc = (tid & 7) * 4; float4 v = *(const float4*)(src + (long)(r0 + rr) * ld_s + c0 + cc);
    tl[(cc + 0) * 72 + rr] = f2bf(v.x); tl[(cc + 1) * 72 + rr] = f2bf(v.y); tl[(cc + 2) * 72 + rr] = f2bf(v.z); tl[(cc + 3) * 72 + rr] = f2bf(v.w); }
  __syncthreads();
  if (tid < 256) { int cc = tid >> 3, rr = (tid & 7) * 8; uint4 v = *(const uint4*)(tl + cc * 72 + rr);
    if (PERM) { u16* d = dst + (long)(drow0 + cc) * ld_d; *(uint2*)(d + kperm(r0 + rr)) = uint2{v.x, v.y}; *(uint2*)(d + kperm(r0 + rr + 4)) = uint2{v.z, v.w}; }
    else *(uint4*)(dst + (long)(drow0 + cc) * ld_d + r0 + rr) = v; }
  __syncthreads();
}

DI void rmsnorm_rows_to_bf16(const int TID, KP p, int l) {
  const int lane = TID & 63, wid = TID >> 6;
  const float* g = p->in[8] + l * D;
  u16* xn = (u16*)(p->ws + WS_XN);
  for (int row = blockIdx.x * 8 + wid; row < M; row += gridDim.x * 8) {
    const float* src = (l == 0) ? (row < MP ? p->in[0] + (long)row * D : p->in[1] + (long)(row - MP) * D) : p->out + (long)row * D;
    float4 v[4]; float ss = 0.f;
#pragma unroll
    for (int i = 0; i < 4; ++i) { v[i] = *(const float4*)(src + i * 256 + lane * 4); ss += v[i].x * v[i].x + v[i].y * v[i].y + v[i].z * v[i].z + v[i].w * v[i].w; }
    ss = wsum(ss); const float rs = rsqrtf(ss * (1.f / D) + EPS);
#pragma unroll
    for (int i = 0; i < 4; ++i) { float4 gg = *(const float4*)(g + i * 256 + lane * 4);
      uint2 o; o.x = pk2(v[i].x * rs * gg.x, v[i].y * rs * gg.y); o.y = pk2(v[i].z * rs * gg.z, v[i].w * rs * gg.w);
      *(uint2*)(xn + (long)row * D + i * 256 + lane * 4) = o; }
  }
}

DI void prep_phase(const int TID, KP p, int l) {
  const int tid = TID, G = gridDim.x, bx = blockIdx.x;
  const long gtid = (long)bx * 512 + tid, gn = (long)G * 512;
  unsigned char* ws = p->ws;
  rmsnorm_rows_to_bf16(TID, p, l);
  { const float* w = p->in[9] + (long)l * 1024 * NIN; u16* d = (u16*)(ws + WS_WIN);
    for (int i = bx; i < 16 * 221; i += G) { int kt = i & 15, ct = i >> 4, c0 = ct * 32; transpose_tile<false>(TID, w, NIN, d, 1024, kt * 64, c0, c0 < 416 ? c0 : c0 + 96); }
    for (long i = gtid; i < 96 * 1024 / 8; i += gn) { const unsigned z = (unsigned)TID >> 31; ((uint4*)(d + 416 * 1024))[i] = uint4{z, z, z, z}; } }
  for (int b = 0; b < 3; ++b) { const float* w = p->in[27 + b] + (long)l * 512 * 1024; u16* d = (u16*)(ws + WS_WO) + (long)b * 1024 * 512;
    for (int i = bx; i < 8 * 32; i += G) { int rt = i & 7, ct = i >> 3; transpose_tile<false>(TID, w, 1024, d, 512, rt * 64, ct * 32, ct * 32); } }
  { const float* w = p->in[30] + (long)l * 1024 * 1024; u16* d = (u16*)(ws + WS_WOUT);
    for (int i = bx; i < 16 * 32; i += G) { int rt = i & 15, ct = i >> 4; transpose_tile<false>(TID, w, 1024, d, 1024, rt * 64, ct * 32, ct * 32); } }
  { const float* c = p->in[2] + (long)l * 8 * PAST * 128; u16* d = (u16*)(ws + WS_CKVTS);
    for (int i = bx; i < 8 * 32 * 4; i += G) { int sb = i >> 7, r = i & 127, rt = r & 31, ct = r >> 5;
      transpose_tile<true>(TID, c + (long)sb * PAST * 128, 128, d + (long)sb * 128 * SKP, SKP, rt * 64, ct * 32, ct * 32); } }
  { const float* c = p->in[5] + (long)l * 8 * PAST * 512; u16* d = (u16*)(ws + WS_VDTS);
    for (int i = bx; i < 8 * 32 * 16; i += G) { int sb = i >> 9, r = i & 511, rt = r & 31, ct = r >> 5;
      transpose_tile<true>(TID, c + (long)sb * PAST * 512, 512, d + (long)sb * 512 * SKP, SKP, rt * 64, ct * 32, ct * 32); } }
  { const float* c = p->in[2] + (long)l * 8 * PAST * 128; u16* d = (u16*)(ws + WS_CKVS);
    for (long i = gtid; i < 8L * PAST * 128 / 4; i += gn) { long e = i * 4; int sb = (int)(e / (PAST * 128)); long r = e - (long)sb * PAST * 128;
      float4 v = *(const float4*)(c + e); uint2 o; o.x = pk2(v.x, v.y); o.y = pk2(v.z, v.w); *(uint2*)(d + (long)sb * SKP * 128 + r) = o; } }
  { const float* c = p->in[3] + (long)l * 8 * PAST * 32; u16* d = (u16*)(ws + WS_KRS);
    for (long i = gtid; i < 8L * PAST * 32 / 4; i += gn) { long e = i * 4; int sb = (int)(e / (PAST * 32)); long r = e - (long)sb * PAST * 32;
      float4 v = *(const float4*)(c + e); uint2 o; o.x = pk2(v.x, v.y); o.y = pk2(v.z, v.w); *(uint2*)(d + (long)sb * SKP * 32 + r) = o; } }
  { const float* c = p->in[4] + (long)l * 8 * PAST * 512; u16* d = (u16*)(ws + WS_KDS);
    for (long i = gtid; i < 8L * PAST * 512 / 4; i += gn) { long e = i * 4; int sb = (int)(e / (PAST * 512)); long r = e - (long)sb * PAST * 512;
      float4 v = *(const float4*)(c + e); uint2 o; o.x = pk2(v.x, v.y); o.y = pk2(v.z, v.w); *(uint2*)(d + (long)sb * SKP * 512 + r) = o; } }
  for (long i = gtid; i < 8L * 48 * 128; i += gn) { int sb = (int)(i / (48 * 128)); int r = (int)(i % (48 * 128)); ((u16*)(ws + WS_CKVS))[((long)sb * SKP + SK) * 128 + r] = 0; }
  for (long i = gtid; i < 8L * 48 * 32; i += gn) { int sb = (int)(i / (48 * 32)); int r = (int)(i % (48 * 32)); ((u16*)(ws + WS_KRS))[((long)sb * SKP + SK) * 32 + r] = 0; }
  for (long i = gtid; i < 8L * 48 * 512; i += gn) { int sb = (int)(i / (48 * 512)); int r = (int)(i % (48 * 512)); ((u16*)(ws + WS_KDS))[((long)sb * SKP + SK) * 512 + r] = 0; }
  for (long i = gtid; i < 8L * 128 * 48; i += gn) { int rw = (int)(i / 48), k = (int)(i % 48); ((u16*)(ws + WS_CKVTS))[(long)rw * SKP + SK + k] = 0; }
  for (long i = gtid; i < 8L * 512 * 48; i += gn) { int rw = (int)(i / 48), k = (int)(i % 48); ((u16*)(ws + WS_VDTS))[(long)rw * SKP + SK + k] = 0; }
  { const float* uq = p->in[12] + (long)l * 256 * 768; const float* uk = p->in[13] + (long)l * 128 * 512; u16* d = (u16*)(ws + WS_WQ);
    for (long i = gtid; i < 1280L * 256; i += gn) { int n = (int)(i >> 8), r = (int)(i & 255); float s;
      if (n < 1024) { int hd = n >> 7, c = n & 127; const float* a = uq + r * 768 + hd * 96; const float* b = uk + c * 512 + hd * 64; s = 0.f;
        for (int dd = 0; dd < 64; dd += 4) { float4 x = *(const float4*)(a + dd), y = *(const float4*)(b + dd); s += x.x * y.x + x.y * y.y + x.z * y.z + x.w * y.w; } }
      else { int hd = (n - 1024) >> 5, j = (n - 1024) & 31; s = uq[r * 768 + hd * 96 + 64 + j]; }
      d[i] = f2bf(s); } }
  { const float* uv = p->in[14] + (long)l * 128 * 512; u16* d = (u16*)(ws + WS_WUV);
    for (long i = gtid; i < 512L * 512; i += gn) { int n = (int)(i >> 9), kk = (int)(i & 511); int hd = n >> 6, v = n & 63, hk = (n >> 8) * 4 + (kk >> 7), c = kk & 127;
      d[i] = (hk == hd) ? f2bf(uv[c * 512 + hd * 64 + v]) : (u16)0; } }
  { const float* wa = p->in[22] + (long)l * 8 * 4096; const float* wx = p->in[24] + (long)l * 8 * 4096; u16* d = (u16*)(ws + WS_WLRU);
    for (long i = gtid; i < 1024L * 256; i += gn) { int nn = (int)(i >> 8), kk = (int)(i & 255); int pn = nn >> 8, nl = nn & 255; int f = pn * 128 + (nl & 127);
      int blk = f >> 6, o = f & 63, bk = (pn >> 1) * 4 + (kk >> 6), ii = kk & 63; const float* w = (nl < 128) ? wa : wx;
      d[i] = (bk == blk) ? f2bf(w[blk * 4096 + ii * 64 + o]) : (u16)0; } }
  if (bx == 0 && tid == 0) {
    float s1 = 0.f, s2 = 0.f;
    for (int i = 0; i < 32; ++i) { s1 += p->in[15][l * 32 + i] * p->in[16][l * 32 + i]; s2 += p->in[17][l * 32 + i] * p->in[18][l * 32 + i]; }
    const float lam_init = 0.8f - 0.6f * expf(-0.3f * (float)l);
    float* sc = (float*)(ws + WS_CTL + 1024);
    sc[l * 2 + 0] = expf(s1) - expf(s2) + lam_init; sc[l * 2 + 1] = lam_init;
  }
  if (l == 0) {
    float2* tab = (float2*)(ws + WS_ROPE);
    for (long i = gtid; i < 4096 * 16; i += gn) { int pos = (int)(i >> 4), j = (int)(i & 15);
      const float a = (float)pos * g_invf[j];
      const float k = rintf(a * 0.63661977236758134f);
      float y = fmaf(-k, 1.5707963109016418f, a); y = fmaf(-k, 1.5893254712295857e-08f, y); y = fmaf(-k, 6.0770999344e-16f, y);
      const float y2 = y * y;
      const float sn = y * (1.f + y2 * (-1.6666667163e-01f + y2 * (8.3333337680e-03f + y2 * (-1.9841270114e-04f + y2 * 2.7557314297e-06f))));
      const float cs = 1.f + y2 * (-0.5f + y2 * (4.1666667908e-02f + y2 * (-1.3888889225e-03f + y2 * (2.4801587642e-05f + y2 * -2.7557314297e-07f))));
      const int q = ((int)k) & 3;
      const float c2 = (q == 0) ? cs : (q == 1) ? -sn : (q == 2) ? -cs : sn;
      const float s2 = (q == 0) ? sn : (q == 1) ? cs : (q == 2) ? -sn : -cs;
      tab[i] = float2{c2, s2}; }
  }
}

DI void inproj_phase(const int TID_in, KP p, int l, int vid) {
  const int wv = __builtin_amdgcn_readfirstlane(TID_in >> 6);
  unsigned char* ws = p->ws;
  f32x4 acc[2][2][4][2];
  for (int tile = vid; tile < 64 * 28; tile += gridDim.x) {
    int pm, pn; tile_coords(tile, 64, 28, pm, pn);
    const int brow = pm * 256, bcol = pn * 256;
    gemm_kloop8(fresh_tid(wv), (const u16*)(ws + WS_XN) + (long)brow * 1024, 1024, (const u16*)(ws + WS_WIN) + (long)bcol * 1024, 1024, 16, acc);
    const int TID = fresh_tid(wv);
    GEMM_IDS
    const int oz = opaque_zero(); const int browz = brow + oz;
    u16* proj = (u16*)(ws + WS_PROJ) + oz;
#pragma unroll
    for (int ai = 0; ai < 2; ++ai) {
      ACC_TO_LDS(ai);
      __syncthreads();
      if (pn >= 16) {
        EPI_ROWS_BEGIN(ai) *(uint2*)(proj + (long)row * NPJ + col) = pk4(sigm(v.x), sigm(v.y), sigm(v.z), sigm(v.w)); EPI_ROWS_END
      } else if (pn == 4 || pn == 5) {
        EPI_ROWS_BEGIN(ai) *(uint2*)(proj + (long)row * NPJ + col) = pk4(v.x * QD_SCALE, v.y * QD_SCALE, v.z * QD_SCALE, v.w * QD_SCALE); EPI_ROWS_END
      } else if (pn == 6 || pn == 7) {
        u16* kds = (u16*)(ws + WS_KDS) + oz;
        EPI_ROWS_BEGIN(ai)
          const int hv = col - PC_KD; const uint2 pk = pk4(v.x, v.y, v.z, v.w);
          *(uint2*)(proj + (long)row * NPJ + col) = pk;
          if (row < MP) *(float4*)(p->out + O_PDK + (long)l * MP * 512 + (long)row * 512 + hv) = v;
          else if (row < M) { const int rs = row - MP; *(float4*)(p->out + O_SDK + (long)l * MS * 512 + rs * 512 + hv) = v;
            *(uint2*)(kds + ((long)(rs >> 4) * SKP + PAST + (rs & 15)) * 512 + hv) = pk; }
        EPI_ROWS_END
      } else if (pn == 8 || pn == 9) {
        EPI_ROWS_BEGIN(ai)
          const int hv = col - PC_VD;
          if (row < MP) *(float4*)(p->out + O_PDV + (long)l * MP * 512 + (long)row * 512 + hv) = v;
          else if (row < M) *(float4*)(p->out + O_SDV + (long)l * MS * 512 + (row - MP) * 512 + hv) = v;
        EPI_ROWS_END
        u16* vtp = (u16*)(ws + WS_VDTP) + oz; u16* vts = (u16*)(ws + WS_VDTS) + oz;
#pragma unroll 4
        for (int it = 0; it < 16; ++it) { const int idx = it * 512 + tid; const int cl = idx & 255, r4 = (idx >> 8) * 4;
          const float* e = (const float*)smem + r4 * EP_LD + cl;
          const uint2 pk = pk4(e[0], e[EP_LD], e[2 * EP_LD], e[3 * EP_LD]);
          const int row0 = browz + ai * 128 + r4, hv = bcol + cl - PC_VD;
          if (row0 < MP) *(uint2*)(vtp + ((long)(row0 >> 12) * 512 + hv) * TP + kperm(row0 & (TP - 1))) = pk;
          else if (row0 < M) { const int rs = row0 - MP; *(uint2*)(vts + ((long)(rs >> 4) * 512 + hv) * SKP + kperm(PAST + (rs & 15))) = pk; } }
      } else {
        EPI_ROWS_BEGIN(ai) *(uint2*)(proj + (long)row * NPJ + col) = pk4(v.x, v.y, v.z, v.w); EPI_ROWS_END
      }
      __syncthreads();
    }
  }
  const int TID = fresh_tid(wv);
  GEMM_IDS
  for (int it = (int)gridDim.x - 1 - vid; it < 8 * 28; it += gridDim.x) {
    const int rg = it & 7, pn = it >> 3; const int row0 = MP + rg * 16, bcol = pn * 256;
    f32x4 c0, c1;
    sgemm16(lane, (const u16*)(ws + WS_XN) + (long)row0 * 1024, 1024, (const u16*)(ws + WS_WIN) + (long)bcol * 1024, 1024, 1024, wid * 32, wid * 32 + 16, c0, c1);
#pragma unroll
    for (int j = 0; j < 4; ++j) { const int row = row0 + fq * 4 + j; inproj_store_s(p, l, row, bcol + wid * 32 + fr, c0[j]); inproj_store_s(p, l, row, bcol + wid * 32 + 16 + fr, c1[j]); }
  }
}

template <int NR> DI void mid_unit(const int TID, KP p, int l, const int r0) {
  const int tid = TID, lane = tid & 63, wid = tid >> 6;
  unsigned char* ws = p->ws;
  u16* proj = (u16*)(ws + WS_PROJ);
  u16* tl = (u16*)smem;
  const float* gq = p->in[10] + l * 256; const float* gkv = p->in[11] + l * 128;
  const float2* rope = (const float2*)(ws + WS_ROPE);
  const float* cw = p->in[20] + l * 4 * 512; const float* cb = p->in[21] + l * 512;
  u16* xc = (u16*)(ws + WS_XC);
  const int rw0 = r0 + wid * NR;
  const bool pr = rw0 < MP; const int rs0 = rw0 - MP;
  const int b = pr ? (rw0 >> 12) : (rs0 >> 4), t0 = pr ? (rw0 & (TP - 1)) : (rs0 & 15);
  u16* prow0 = proj + (long)rw0 * NPJ;
  {
    uint2 vq[NR]; u32 vk[NR]; float x1[NR], x2[NR];
#pragma unroll
    for (int i = 0; i < NR; ++i) { const u16* pw = prow0 + (long)i * NPJ; vq[i] = *(const uint2*)(pw + PC_CQ + lane * 4); vk[i] = *(const u32*)(pw + PC_CKV + lane * 2);
      x1[i] = bf2f(pw[PC_KR + (lane & 15)]); x2[i] = bf2f(pw[PC_KR + 16 + (lane & 15)]); }
    const float4 g4 = *(const float4*)(gq + lane * 4); const float2 g2 = *(const float2*)(gkv + lane * 2);
#pragma unroll
    for (int i = 0; i < NR; ++i) {
      const int row = rw0 + i, t = t0 + i, pos = pr ? t : PAST + t; const int rs = row - MP;
      u16* prow = prow0 + (long)i * NPJ;
      { float a0 = lo2f(vq[i].x), a1 = hi2f(vq[i].x), a2 = lo2f(vq[i].y), a3 = hi2f(vq[i].y);
        float ss = wsum(a0 * a0 + a1 * a1 + a2 * a2 + a3 * a3); float rsd = rsqrtf(ss * (1.f / 256) + EPS);
        *(uint2*)(prow + PC_CQ + lane * 4) = pk4(a0 * rsd * g4.x, a1 * rsd * g4.y, a2 * rsd * g4.z, a3 * rsd * g4.w); }
      { float a0 = lo2f(vk[i]), a1 = hi2f(vk[i]);
        float ss = wsum(a0 * a0 + a1 * a1); float rsd = rsqrtf(ss * (1.f / 128) + EPS);
        float y0 = a0 * rsd * g2.x, y1 = a1 * rsd * g2.y;
        float* so = pr ? p->out + O_PCKV + (long)l * MP * 128 + (long)row * 128 : p->out + O_SCKV + (long)l * MS * 128 + rs * 128;
        *(float2*)(so + lane * 2) = float2{y0, y1};
        u32 pk = pk2(y0, y1);
        u16* kb = pr ? (u16*)(ws + WS_CKVP) + (long)row * 128 : (u16*)(ws + WS_CKVS) + ((long)b * SKP + PAST + t) * 128;
        *(u32*)(kb + lane * 2) = pk;
        tl[(lane * 2) * 72 + wid * NR + i] = (u16)(pk & 0xffff); tl[(lane * 2 + 1) * 72 + wid * NR + i] = (u16)(pk >> 16); }
      if (lane < 16) {
        float2 cs = rope[pos * 16 + lane];
        float o1 = x1[i] * cs.x - x2[i] * cs.y, o2 = x2[i] * cs.x + x1[i] * cs.y;
        float* so = pr ? p->out + O_PKR + (long)l * MP * 32 + (long)row * 32 : p->out + O_SKR + (long)l * MS * 32 + rs * 32;
        so[lane] = o1; so[lane + 16] = o2;
        u16* kb = pr ? (u16*)(ws + WS_KRP) + (long)row * 32 : (u16*)(ws + WS_KRS) + ((long)b * SKP + PAST + t) * 32;
        kb[lane] = f2bf(o1); kb[lane + 16] = f2bf(o2); }
    }
  }
  {
    const int f = lane * 8;
    uint4 xin[NR + 3];
#pragma unroll
    for (int k = 0; k < NR + 3; ++k) {
      const int tt = t0 + k - 3;
      if (tt >= 0) xin[k] = *(const uint4*)(prow0 + (long)(k - 3) * NPJ + PC_XL + f);
      else if (!pr) { const float* c0 = p->in[7] + (((long)l * 8 + b) * 3 + (tt + 3)) * 512 + f; float4 u0 = *(const float4*)c0, u1 = *(const float4*)(c0 + 4);
        xin[k] = uint4{pk2(u0.x, u0.y), pk2(u0.z, u0.w), pk2(u1.x, u1.y), pk2(u1.z, u1.w)}; }
      else xin[k] = uint4{0u, 0u, 0u, 0u};
    }
    float4 w[4][2];
#pragma unroll
    for (int k = 0; k < 4; ++k) { w[k][0] = *(const float4*)(cw + k * 512 + f); w[k][1] = *(const float4*)(cw + k * 512 + f + 4); }
    const float4 b0 = *(const float4*)(cb + f), b1 = *(const float4*)(cb + f + 4);
    const int T = pr ? TP : TS;
#pragma unroll
    for (int i = 0; i < NR; ++i) {
      float a[8] = {b0.x, b0.y, b0.z, b0.w, b1.x, b1.y, b1.z, b1.w};
#pragma unroll
      for (int k = 0; k < 4; ++k) { const uint4 v = xin[i + k];
        a[0] += lo2f(v.x) * w[k][0].x; a[1] += hi2f(v.x) * w[k][0].y; a[2] += lo2f(v.y) * w[k][0].z; a[3] += hi2f(v.y) * w[k][0].w;
        a[4] += lo2f(v.z) * w[k][1].x; a[5] += hi2f(v.z) * w[k][1].y; a[6] += lo2f(v.w) * w[k][1].z; a[7] += hi2f(v.w) * w[k][1].w; }
      *(uint4*)(xc + (long)(rw0 + i) * 512 + f) = uint4{pk2(a[0], a[1]), pk2(a[2], a[3]), pk2(a[4], a[5]), pk2(a[6], a[7])};
      const int t = t0 + i;
      if (t >= T - 3) { const uint4 v = xin[i + 3];
        float* so = pr ? p->out + O_PCV + (((long)l * 4 + b) * 3 + (t - (T - 3))) * 512 + f : p->out + O_SCV + (((long)l * 8 + b) * 3 + (t - (T - 3))) * 512 + f;
        *(float4*)so = float4{lo2f(v.x), hi2f(v.x), lo2f(v.y), hi2f(v.y)}; *(float4*)(so + 4) = float4{lo2f(v.z), hi2f(v.z), lo2f(v.w), hi2f(v.w)}; }
    }
  }
  __syncthreads();
  for (int id = tid; id < 128 * NR; id += 512) { const int c = id / NR, rg = id % NR; const int row = r0 + rg * 8;
    uint4 v = *(const uint4*)(tl + c * 72 + rg * 8);
    u16* dbase = (row < MP) ? (u16*)(ws + WS_CKVTP) + ((long)(row >> 12) * 128 + c) * TP : (u16*)(ws + WS_CKVTS) + ((long)((row - MP) >> 4) * 128 + c) * SKP;
    const int key = (row < MP) ? (row & (TP - 1)) : PAST + ((row - MP) & 15);
    *(uint2*)(dbase + kperm(key)) = uint2{v.x, v.y}; *(uint2*)(dbase + kperm(key + 4)) = uint2{v.z, v.w}; }
  __syncthreads();
}
DI void mid_phase(const int TID, KP p, int l) {
  for (int u = blockIdx.x; u < 256 + 16; u += gridDim.x) {
    if (u < 256) mid_unit<8>(TID, p, l, u * 64);
    else mid_unit<1>(TID, p, l, MP + (u - 256) * 8);
  }
}

DI void qlru_phase(const int TID_in, KP p, int l, int vid) {
  const int wv = __builtin_amdgcn_readfirstlane(TID_in >> 6);
  unsigned char* ws = p->ws;
  f32x4 acc[2][2][4][2];
  for (int tile = vid; tile < 64 * 9; tile += gridDim.x) {
    if (tile < 64 * 5) {
      int pm, pn; tile_coords(tile, 64, 5, pm, pn);
      const int brow = pm * 256, bcol = pn * 256;
      gemm_kloop8(fresh_tid(wv), (const u16*)(ws + WS_PROJ) + (long)brow * NPJ + PC_CQ, NPJ, (const u16*)(ws + WS_WQ) + (long)bcol * 256, 256, 4, acc);
      const int TID = fresh_tid(wv);
      GEMM_IDS
      const int oz = opaque_zero(); const int browz = brow + oz;
      u16* qm = (u16*)(ws + WS_QMLA) + oz;
#pragma unroll
      for (int ai = 0; ai < 2; ++ai) {
        ACC_TO_LDS(ai);
        __syncthreads();
        if (pn < 4) {
          EPI_ROWS_BEGIN(ai) *(uint2*)(qm + (long)row * 1280 + col) = pk4(v.x * QM_SCALE, v.y * QM_SCALE, v.z * QM_SCALE, v.w * QM_SCALE); EPI_ROWS_END
        } else {
          const float2* rope = (const float2*)(ws + WS_ROPE) + oz;
#pragma unroll 2
          for (int it = 0; it < 8; ++it) { const int idx = it * 512 + tid; const int rl = idx >> 5, hd = (idx >> 2) & 7, j4 = (idx & 3) * 4;
            const int row = browz + ai * 128 + rl;
            if (row < M) {
              const float* e = (const float*)smem + rl * EP_LD + hd * 32 + j4;
              const float4 x1 = *(const float4*)e, x2 = *(const float4*)(e + 16);
              const float4 c01 = *(const float4*)(rope + row_pos(row) * 16 + j4), c23 = *(const float4*)(rope + row_pos(row) * 16 + j4 + 2);
              u16* q = qm + (long)row * 1280 + 1024 + hd * 32 + j4;
              *(uint2*)q = pk4((x1.x * c01.x - x2.x * c01.y) * QM_SCALE, (x1.y * c01.z - x2.y * c01.w) * QM_SCALE, (x1.z * c23.x - x2.z * c23.y) * QM_SCALE, (x1.w * c23.z - x2.w * c23.w) * QM_SCALE);
              *(uint2*)(q + 16) = pk4((x2.x * c01.x + x1.x * c01.y) * QM_SCALE, (x2.y * c01.z + x1.y * c01.w) * QM_SCALE, (x2.z * c23.x + x1.z * c23.y) * QM_SCALE, (x2.w * c23.z + x1.w * c23.w) * QM_SCALE); } }
        }
        __syncthreads();
      }
    } else {
      int pm, pn; tile_coords(tile - 64 * 5, 64, 4, pm, pn);
      const int brow = pm * 256;
      gemm_kloop8(fresh_tid(wv), (const u16*)(ws + WS_XC) + (long)brow * 512 + (pn >> 1) * 256, 512, (const u16*)(ws + WS_WLRU) + (long)pn * 256 * 256, 256, 4, acc);
      const int TID = fresh_tid(wv);
      GEMM_IDS
      const int oz = opaque_zero(); const int browz = brow + oz;
      const u16* xc = (const u16*)(ws + WS_XC) + oz;
      float* ab = (float*)(ws + WS_A) + oz; float* bb = (float*)(ws + WS_B) + oz;
      float spv[4], baa[4], bxa[4];
      { const int f = pn * 128 + (tid & 31) * 4;
        const float4 lb = *(const float4*)(p->in[26] + l * 512 + f), bav = *(const float4*)(p->in[23] + l * 512 + f), bxv = *(const float4*)(p->in[25] + l * 512 + f);
        spv[0] = softplus_f(-lb.x); spv[1] = softplus_f(-lb.y); spv[2] = softplus_f(-lb.z); spv[3] = softplus_f(-lb.w);
        baa[0] = bav.x; baa[1] = bav.y; baa[2] = bav.z; baa[3] = bav.w; bxa[0] = bxv.x; bxa[1] = bxv.y; bxa[2] = bxv.z; bxa[3] = bxv.w; }
#pragma unroll
      for (int ai = 0; ai < 2; ++ai) {
        ACC_TO_LDS(ai);
        __syncthreads();
#pragma unroll 2
        for (int it = 0; it < 8; ++it) { const int idx = it * 512 + tid; const int rl = idx >> 5, f4 = (idx & 31) * 4;
          const int row = browz + ai * 128 + rl;
          if (row < M) {
            const float* e = (const float*)smem + rl * EP_LD + f4;
            const float4 ra = *(const float4*)e, rx = *(const float4*)(e + 128);
            const int f = pn * 128 + f4;
            const uint2 xv = *(const uint2*)(xc + (long)row * 512 + f);
            const bool first = (row < MP) && ((row & (TP - 1)) == 0);
            float av[4], bv[4];
            const float raa[4] = {ra.x, ra.y, ra.z, ra.w}, rxa[4] = {rx.x, rx.y, rx.z, rx.w};
            const float xca[4] = {lo2f(xv.x), hi2f(xv.x), lo2f(xv.y), hi2f(xv.y)};
#pragma unroll
            for (int k = 0; k < 4; ++k) { const float sp = spv[k];
              const float r = sigm(raa[k] + baa[k]), ii = sigm(rxa[k] + bxa[k]); const float la = -8.f * r * sp;
              av[k] = __expf(la); const float mult = first ? 1.f : sqrtf(neg_expm1(2.f * la)); bv[k] = mult * ii * xca[k]; }
            *(float4*)(ab + (long)row * 512 + f) = float4{av[0], av[1], av[2], av[3]};
            *(float4*)(bb + (long)row * 512 + f) = float4{bv[0], bv[1], bv[2], bv[3]}; } }
        __syncthreads();
      }
    }
  }
  const int TID = fresh_tid(wv);
  GEMM_IDS
  for (int it = (int)gridDim.x - 1 - vid; it < 8 * 9; it += gridDim.x) {
    const int rg = it & 7, pn = it >> 3; const int row0 = MP + rg * 16;
    f32x4 c0, c1;
    if (pn < 5) {
      const int bcol = pn * 256;
      sgemm16(lane, (const u16*)(ws + WS_PROJ) + (long)row0 * NPJ + PC_CQ, NPJ, (const u16*)(ws + WS_WQ) + (long)bcol * 256, 256, 256, wid * 32, wid * 32 + 16, c0, c1);
      u16* qm = (u16*)(ws + WS_QMLA);
      if (pn < 4) {
#pragma unroll
        for (int j = 0; j < 4; ++j) { const long row = row0 + fq * 4 + j; qm[row * 1280 + bcol + wid * 32 + fr] = f2bf(c0[j] * QM_SCALE); qm[row * 1280 + bcol + wid * 32 + 16 + fr] = f2bf(c1[j] * QM_SCALE); }
      } else {
        const float2* rope = (const float2*)(ws + WS_ROPE);
#pragma unroll
        for (int j = 0; j < 4; ++j) { const int row = row0 + fq * 4 + j; const float2 cs = rope[row_pos(row) * 16 + fr];
          qm[(long)row * 1280 + 1024 + wid * 32 + fr] = f2bf((c0[j] * cs.x - c1[j] * cs.y) * QM_SCALE);
          qm[(long)row * 1280 + 1024 + wid * 32 + 16 + fr] = f2bf((c1[j] * cs.x + c0[j] * cs.y) * QM_SCALE); }
      }
    } else {
      const int pl = pn - 5;
      const u16* xc = (const u16*)(ws + WS_XC);
      sgemm16(lane, xc + (long)row0 * 512 + (pl >> 1) * 256, 512, (const u16*)(ws + WS_WLRU) + (long)pl * 256 * 256, 256, 256, wid * 16, 128 + wid * 16, c0, c1);
      const int f = pl * 128 + wid * 16 + fr;
      const float nl = -(p->in[26][l * 512 + f]); const float sp = softplus_f(nl);
      const float bav = p->in[23][l * 512 + f], bxv = p->in[25][l * 512 + f];
      float* ab = (float*)(ws + WS_A); float* bb = (float*)(ws + WS_B);
#pragma unroll
      for (int j = 0; j < 4; ++j) { const long row = row0 + fq * 4 + j;
        const float r = sigm(c0[j] + bav), ii = sigm(c1[j] + bxv); const float la = -8.f * r * sp;
        ab[row * 512 + f] = __expf(la); bb[row * 512 + f] = sqrtf(neg_expm1(2.f * la)) * ii * bf2f(xc[row * 512 + f]); }
    }
  }
}

DI void mla_task(const int TID, const u16* __restrict__ qbase, int nq, const u16* __restrict__ kck, const u16* __restrict__ kkr, const u16* __restrict__ vT, int ldv, int nkeys, u16* __restrict__ obase) {
  const int tid = TID, lane = tid & 63, hd = tid >> 6, r = lane & 31, h = lane >> 5;
  const u16* qp = qbase + (long)(r & (nq - 1)) * 1280;
  bf16x8 qf[10];
#pragma unroll
  for (int ks = 0; ks < 8; ++ks) qf[ks] = *(const bf16x8*)(qp + hd * 128 + ks * 16 + h * 8);
#pragma unroll
  for (int ks = 0; ks < 2; ++ks) qf[8 + ks] = *(const bf16x8*)(qp + 1024 + hd * 32 + ks * 16 + h * 8);
  f32x16 O[4];
#pragma unroll
  for (int i = 0; i < 4; ++i)
#pragma unroll
    for (int j = 0; j < 16; ++j) O[i][j] = 0.f;
  float m_run = -1e30f, l_run = 0.f;
  const int nt = (nkeys + 63) >> 6;
  const int wv = __builtin_amdgcn_readfirstlane(hd);
  if (wv >= 4) __builtin_amdgcn_s_setprio(1);
  const char* gp[5]; unsigned ginc[5];
#pragma unroll
  for (int i = 0; i < 5; ++i) {
    int g = wv + 8 * i; if (g > 38) g = 38;
    if (g < 21) { const int o = g * 1024 + lane * 16; const int row = o / 336, wi = o - row * 336;
      if (wi >= 256 && wi < 320) { gp[i] = (const char*)kkr + row * 64 + (wi - 256); ginc[i] = 64 * 64; }
      else { gp[i] = (const char*)kck + row * 256 + (wi < 256 ? wi : 0); ginc[i] = 64 * 256; } }
    else { const int o = (g - 21) * 1024 + lane * 16; const int row = o / 144, wi = o - row * 144;
      gp[i] = (const char*)vT + (long)row * ldv * 2 + (wi < 128 ? wi : 0); ginc[i] = 128; }
  }
#define MLA_ISSUE(buf) do { _Pragma("unroll") for (int i = 0; i < 5; ++i) { int g = wv + 8 * i; if (g > 38) g = 38; \
    __builtin_amdgcn_global_load_lds((const unsigned*)gp[i], (unsigned*)(smem + (buf) * 39936 + g * 1024), 16, 0, 0); gp[i] += ginc[i]; } } while (0)
#define MLA_QK(S, KT, KB) do { bf16x8 kfr[10]; \
    _Pragma("unroll") for (int ks = 0; ks < 10; ++ks) kfr[ks] = *(const bf16x8*)((KT) + ((KB) * 32 + r) * 336 + ks * 32 + h * 16); \
    _Pragma("unroll") for (int ks = 0; ks < 10; ++ks) { \
      if (ks == 0) S = __builtin_amdgcn_mfma_f32_32x32x16_bf16(kfr[ks], qf[ks], negm, 0, 0, 0); else S = __builtin_amdgcn_mfma_f32_32x32x16_bf16(kfr[ks], qf[ks], S, 0, 0, 0); } \
      \
    __builtin_amdgcn_sched_group_barrier(0x100, 5, 0); \
    _Pragma("unroll") for (int i = 0; i < 5; ++i) { __builtin_amdgcn_sched_group_barrier(0x008, 1, 0); __builtin_amdgcn_sched_group_barrier(0x100, 1, 0); } \
    __builtin_amdgcn_sched_group_barrier(0x008, 5, 0); } while (0)
#define MLA_SMPV(S, OTHER, VT, KB, T) do { \
    if (((T) == nt - 1) && (nkeys & 63)) { _Pragma("unroll") for (int j = 0; j < 16; ++j) if ((T) * 64 + (KB) * 32 + crow(j, h) >= nkeys) S[j] = -1e30f; } \
    float mx = S[0]; _Pragma("unroll") for (int j = 1; j < 16; ++j) mx = fmaxf(mx, S[j]); \
    if (first || __builtin_amdgcn_ballot_w64(mx > 8.f) != 0ull) { \
      mx = fmaxf(mx, __shfl_xor(mx, 32)); \
      const float d = first ? mx : fmaxf(mx, 0.f); \
      if (!first) { const float alpha = __builtin_amdgcn_exp2f(-d); l_run *= alpha; \
        _Pragma("unroll") for (int cb = 0; cb < 4; ++cb) _Pragma("unroll") for (int j = 0; j < 16; ++j) O[cb][j] *= alpha; } \
      _Pragma("unroll") for (int j = 0; j < 16; ++j) { S[j] -= d; negm[j] -= d; OTHER[j] -= d; } \
      first = false; } \
    float ls = 0.f; _Pragma("unroll") for (int j = 0; j < 16; ++j) { S[j] = __builtin_amdgcn_exp2f(S[j]); ls += S[j]; } \
    l_run += ls; \
    bf16x8 pk[2]; \
    _Pragma("unroll") for (int s2 = 0; s2 < 2; ++s2) { const uint4 w = uint4{pk2(S[8 * s2], S[8 * s2 + 1]), pk2(S[8 * s2 + 2], S[8 * s2 + 3]), pk2(S[8 * s2 + 4], S[8 * s2 + 5]), pk2(S[8 * s2 + 6], S[8 * s2 + 7])}; pk[s2] = __builtin_bit_cast(bf16x8, w); } \
    bf16x8 vfr[4][2]; \
    _Pragma("unroll") for (int cb = 0; cb < 4; ++cb) _Pragma("unroll") for (int s2 = 0; s2 < 2; ++s2) vfr[cb][s2] = *(const bf16x8*)((VT) + (cb * 32 + r) * 144 + ((KB) * 32 + 16 * s2) * 2 + h * 16); \
    _Pragma("unroll") for (int cb = 0; cb < 4; ++cb) _Pragma("unroll") for (int s2 = 0; s2 < 2; ++s2) O[cb] = __builtin_amdgcn_mfma_f32_32x32x16_bf16(vfr[cb][s2], pk[s2], O[cb], 0, 0, 0); \
    __builtin_amdgcn_sched_group_barrier(0x100, 4, 0); \
    _Pragma("unroll") for (int i = 0; i < 4; ++i) { __builtin_amdgcn_sched_group_barrier(0x008, 1, 0); __builtin_amdgcn_sched_group_barrier(0x100, 1, 0); } \
    __builtin_amdgcn_sched_group_barrier(0x008, 4, 0); } while (0)
  MLA_ISSUE(0);
  if (nt > 1) MLA_ISSUE(1);
  asm volatile("s_waitcnt vmcnt(0)" ::: "memory");
  __builtin_amdgcn_s_barrier();
  f32x16 sA, sB, negm;
#pragma unroll
  for (int j = 0; j < 16; ++j) { negm[j] = 0.f; sB[j] = 0.f; }
  bool first = true;
  MLA_QK(sA, smem, 0);
  int cur = 0;
#pragma unroll 1
  for (int t = 0; t < nt; ++t) {
    const int nx1 = (cur == 2) ? 0 : cur + 1, nx2 = (cur == 0) ? 2 : cur - 1;
    if (t + 2 < nt) MLA_ISSUE(nx2);
    const unsigned char* Kt = smem + cur * 39936; const unsigned char* Vt = Kt + 21504;
    MLA_QK(sB, Kt, 1);
    MLA_SMPV(sA, sB, Vt, 0, t);
    if (t + 1 < nt) MLA_QK(sA, smem + nx1 * 39936, 0);
    MLA_SMPV(sB, sA, Vt, 1, t);
    asm volatile("s_waitcnt vmcnt(0)" ::: "memory");
    asm volatile("s_waitcnt lgkmcnt(0)" ::: "memory");
    __builtin_amdgcn_s_barrier();
    cur = nx1;
  }
  __builtin_amdgcn_s_setprio(0);
  const float lt = l_run + __shfl_xor(l_run, 32); const float inv = 1.f / lt;
  if (r < nq) {
    u16* op = obase + (long)r * 1024 + hd * 128;
#pragma unroll
    for (int cb = 0; cb < 4; ++cb)
#pragma unroll
      for (int g = 0; g < 4; ++g) { uint2 o; o.x = pk2(O[cb][4 * g] * inv, O[cb][4 * g + 1] * inv); o.y = pk2(O[cb][4 * g + 2] * inv, O[cb][4 * g + 3] * inv);
        *(uint2*)(op + cb * 32 + 8 * g + 4 * h) = o; }
  }
}

DI void diff_task(const int TID, const u16* __restrict__ qbase, const u16* __restrict__ zbase, u16* __restrict__ obase, int nq, int qpos0,
                  const u16* __restrict__ kbase, long kstride, const u16* __restrict__ vT, int ldv, int nkeys_total,
                  float lam, float oml, float slope2, const float* __restrict__ subg) {
  const int tid = TID, lane = tid & 63, w = tid >> 6, r = lane & 31, h = lane >> 5;
  const int qw0 = w * 32;
  const bool wactive = qw0 < nq;
  const int qr = (qw0 + r < nq) ? qw0 + r : 0;
  const int wl = (nq - 1) >> 5;
  const int ntmax = (min(nkeys_total, ((qpos0 + wl * 32) / 64 + 1) * 64) + 63) >> 6;
  const int kvis = min(nkeys_total, ((qpos0 + qw0) / 64 + 1) * 64);
  const int ntw = wactive ? ((kvis + 63) >> 6) : 0;
  const u16* qp = qbase + (long)qr * NPJ;
  bf16x8 qf[2][2];
#pragma unroll
  for (int c = 0; c < 2; ++c)
#pragma unroll
    for (int ks = 0; ks < 2; ++ks) qf[c][ks] = *(const bf16x8*)(qp + c * 32 + ks * 16 + h * 8);
  f32x16 O[2][2];
#pragma unroll
  for (int c = 0; c < 2; ++c)
#pragma unroll
    for (int vb = 0; vb < 2; ++vb)
#pragma unroll
      for (int j = 0; j < 16; ++j) O[c][vb][j] = 0.f;
  float m_run[2] = {-1e30f, -1e30f}, l_run[2] = {0.f, 0.f};
  const float qposf = (float)(qpos0 + qw0 + r);
  const float b0q = slope2 * ((float)(4 * h) - qposf);
  const int sr = tid >> 3, sc = tid & 7;
  const unsigned oDK = (unsigned)(sr * (int)kstride * 2 + sc * 16), oDV = (unsigned)(sr * ldv * 2 + sc * 16);
  uint4 g0, g1;
#define DF_GLOAD(t) do { g0 = *(const uint4*)((const char*)(kbase + (long)(t) * 64 * kstride) + oDK); g1 = *(const uint4*)((const char*)(vT + (long)(t) * 64) + oDV); } while (0)
#define DF_LSTORE(s) do { unsigned char* Kt = smem + (s) * 18432; *(uint4*)(Kt + sr * 144 + sc * 16) = g0; *(uint4*)(Kt + 9216 + sr * 144 + sc * 16) = g1; } while (0)
  if (__builtin_amdgcn_readfirstlane(w) >= 4) __builtin_amdgcn_s_setprio(1);
  DF_GLOAD(ntmax - 1); DF_LSTORE((ntmax - 1) & 1);
  __syncthreads();
  for (int t = ntmax - 1; t >= 0; --t) {
    if (t > 0) DF_GLOAD(t - 1);
    if (t < ntw - 1) {
      const unsigned char* Kt = smem + (t & 1) * 18432; const unsigned char* Vt = Kt + 9216;
#pragma unroll 1
      for (int kb = 1; kb >= 0; --kb) {
        bf16x8 vf[2][2];
#pragma unroll
        for (int vb = 0; vb < 2; ++vb)
#pragma unroll
          for (int s2 = 0; s2 < 2; ++s2) vf[vb][s2] = *(const bf16x8*)(Vt + (vb * 32 + r) * 144 + (kb * 32 + 16 * s2) * 2 + h * 16);
        const float dl = slope2 * (float)(t * 64 + kb * 32);
        f32x16 sc[2];
#pragma unroll
        for (int c = 0; c < 2; ++c) { const float u = b0q + dl - m_run[c];
#pragma unroll
          for (int j = 0; j < 16; ++j) sc[c][j] = fmaf(slope2, (float)((j & 3) + 8 * (j >> 2)), u); }
        bf16x8 kfr[2][2];
#pragma unroll
        for (int ks = 0; ks < 2; ++ks)
#pragma unroll
          for (int c = 0; c < 2; ++c) kfr[ks][c] = *(const bf16x8*)(Kt + (kb * 32 + r) * 144 + (c * 32 + ks * 16 + h * 8) * 2);
#pragma unroll
        for (int ks = 0; ks < 2; ++ks)
#pragma unroll
          for (int c = 0; c < 2; ++c) sc[c] = __builtin_amdgcn_mfma_f32_32x32x16_bf16(kfr[ks][c], qf[c][ks], sc[c], 0, 0, 0);
        __builtin_amdgcn_sched_group_barrier(0x100, 8, 0);
        __builtin_amdgcn_sched_group_barrier(0x008, 4, 0);
#pragma unroll
        for (int c = 0; c < 2; ++c) {
          float mx = sc[c][0];
#pragma unroll
          for (int j = 1; j < 16; ++j) mx = fmaxf(mx, sc[c][j]);
          if (__builtin_amdgcn_ballot_w64(mx > 8.f) != 0ull) {
            mx = fmaxf(mx, __shfl_xor(mx, 32));
            const float d = fmaxf(mx, 0.f); const float alpha = __builtin_amdgcn_exp2f(-d); m_run[c] += d; l_run[c] *= alpha;
#pragma unroll
            for (int vb = 0; vb < 2; ++vb)
#pragma unroll
              for (int j = 0; j < 16; ++j) O[c][vb][j] *= alpha;
#pragma unroll
            for (int j = 0; j < 16; ++j) sc[c][j] -= d;
          }
          float ls = 0.f;
#pragma unroll
          for (int j = 0; j < 16; ++j) { sc[c][j] = __builtin_amdgcn_exp2f(sc[c][j]); ls += sc[c][j]; }
          l_run[c] += ls;
#pragma unroll
          for (int s2 = 0; s2 < 2; ++s2) { const uint4 wv = uint4{pk2(sc[c][8 * s2], sc[c][8 * s2 + 1]), pk2(sc[c][8 * s2 + 2], sc[c][8 * s2 + 3]), pk2(sc[c][8 * s2 + 4], sc[c][8 * s2 + 5]), pk2(sc[c][8 * s2 + 6], sc[c][8 * s2 + 7])};
            const bf16x8 pk = __builtin_bit_cast(bf16x8, wv);
#pragma unroll
            for (int vb = 0; vb < 2; ++vb) O[c][vb] = __builtin_amdgcn_mfma_f32_32x32x16_bf16(vf[vb][s2], pk, O[c][vb], 0, 0, 0); }
        }
      }
    } else if (t < ntw) {
      const unsigned char* Kt = smem + (t & 1) * 18432; const unsigned char* Vt = Kt + 9216;
      const bool partial = (t * 64 + 64 > kvis);
#pragma unroll 1
      for (int kb = 1; kb >= 0; --kb) {
        bf16x8 vf[2][2];
#pragma unroll
        for (int vb = 0; vb < 2; ++vb)
#pragma unroll
          for (int s2 = 0; s2 < 2; ++s2) vf[vb][s2] = *(const bf16x8*)(Vt + (vb * 32 + r) * 144 + (kb * 32 + 16 * s2) * 2 + h * 16);
        const float kb0 = (float)(t * 64 + kb * 32 + 4 * h) - qposf;
#pragma unroll
        for (int c = 0; c < 2; ++c) {
          f32x16 s;
#pragma unroll
          for (int j = 0; j < 16; ++j) s[j] = 0.f;
#pragma unroll
          for (int ks = 0; ks < 2; ++ks) { bf16x8 a = *(const bf16x8*)(Kt + (kb * 32 + r) * 144 + (c * 32 + ks * 16 + h * 8) * 2); s = __builtin_amdgcn_mfma_f32_32x32x16_bf16(a, qf[c][ks], s, 0, 0, 0); }
#pragma unroll
          for (int j = 0; j < 16; ++j) { const float dk = kb0 + (float)((j & 3) + 8 * (j >> 2)); s[j] = fmaf(-slope2, fabsf(dk), s[j]); }
          if (partial) {
#pragma unroll
            for (int j = 0; j < 16; ++j) if (t * 64 + kb * 32 + crow(j, h) >= kvis) s[j] = -1e30f; }
          float mx = s[0];
#pragma unroll
          for (int j = 1; j < 16; ++j) mx = fmaxf(mx, s[j]);
          if (__builtin_amdgcn_ballot_w64(mx > m_run[c] + 8.f) != 0ull) {
            mx = fmaxf(mx, __shfl_xor(mx, 32));
            const float m_new = fmaxf(m_run[c], mx); const float alpha = __builtin_amdgcn_exp2f(m_run[c] - m_new); m_run[c] = m_new;
            l_run[c] *= alpha;
#pragma unroll
            for (int vb = 0; vb < 2; ++vb)
#pragma unroll
              for (int j = 0; j < 16; ++j) O[c][vb][j] *= alpha;
          }
          float ls = 0.f;
#pragma unroll
          for (int j = 0; j < 16; ++j) { s[j] = __builtin_amdgcn_exp2f(s[j] - m_run[c]); ls += s[j]; }
          l_run[c] += ls;
#pragma unroll
          for (int s2 = 0; s2 < 2; ++s2) { u32 w0 = pk2(s[8 * s2], s[8 * s2 + 1]), w1 = pk2(s[8 * s2 + 2], s[8 * s2 + 3]), w2 = pk2(s[8 * s2 + 4], s[8 * s2 + 5]), w3 = pk2(s[8 * s2 + 6], s[8 * s2 + 7]);
            uint4 wv = uint4{w0, w1, w2, w3}; bf16x8 pk = __builtin_bit_cast(bf16x8, wv);
#pragma unroll
            for (int vb = 0; vb < 2; ++vb) O[c][vb] = __builtin_amdgcn_mfma_f32_32x32x16_bf16(vf[vb][s2], pk, O[c][vb], 0, 0, 0); }
          __builtin_amdgcn_sched_barrier(0);
        }
      }
    }
    if (t > 0) DF_LSTORE((t - 1) & 1);
    __syncthreads();
  }
  __builtin_amdgcn_s_setprio(0);
  if (wactive) {
    const float i0 = 1.f / (l_run[0] + __shfl_xor(l_run[0], 32)); const float i1 = lam / (l_run[1] + __shfl_xor(l_run[1], 32));
    float ss = 0.f;
#pragma unroll
    for (int vb = 0; vb < 2; ++vb)
#pragma unroll
      for (int j = 0; j < 16; ++j) { float o = O[0][vb][j] * i0 - O[1][vb][j] * i1; O[0][vb][j] = o; ss += o * o; }
    ss += __shfl_xor(ss, 32);
    const float rsd = rsqrtf(ss * (1.f / 64) + EPS) * oml;
    if (qw0 + r < nq) {
      const u16* zp = zbase + (long)(qw0 + r) * NPJ; u16* op = obase + (long)(qw0 + r) * NPJ;
#pragma unroll
      for (int vb = 0; vb < 2; ++vb)
#pragma unroll
        for (int g = 0; g < 4; ++g) { const int v0 = vb * 32 + 8 * g + 4 * h;
          uint2 z = *(const uint2*)(zp + v0); float4 gg = *(const float4*)(subg + v0);
          float y0 = O[0][vb][4 * g] * rsd * gg.x * silu(lo2f(z.x)), y1 = O[0][vb][4 * g + 1] * rsd * gg.y * silu(hi2f(z.x));
          float y2 = O[0][vb][4 * g + 2] * rsd * gg.z * silu(lo2f(z.y)), y3 = O[0][vb][4 * g + 3] * rsd * gg.w * silu(hi2f(z.y));
          uint2 o; o.x = pk2(y0, y1); o.y = pk2(y2, y3); *(uint2*)(op + v0) = o; }
    }
  }
}

DI void attn_phase(const int TID, KP p, int l, unsigned* ctr) {
  unsigned char* ws = p->ws;
  u16* proj = (u16*)(ws + WS_PROJ);
  const u16* qm = (const u16*)(ws + WS_QMLA);
  u16* olat = (u16*)(ws + WS_XN);
  const float* sc = (const float*)(ws + WS_CTL + 1024);
  const float* subg = p->in[19] + l * 64;
  volatile int* s_task = (volatile int*)(smem + TASK_OFF);
  for (;;) {
    int tid = TID; asm volatile("" : "+v"(tid));
    if (tid == 0) *s_task = (int)atomicAdd(ctr, 1u);
    __syncthreads();
    const int ti = __builtin_amdgcn_readfirstlane(*s_task);
    __syncthreads();
    if (ti >= g_tab.n) break;
    const u32 e = g_tab.t[ti]; const int ty = e >> 16, idx = e & 0xffff;
    if (ty == 0 || ty == 2) {
      const bool pr = (ty == 0);
      const int j = idx >> 5, b = pr ? ((idx >> 3) & 3) : (idx >> 3), hh = idx & 7;
      const long row0 = pr ? (long)b * TP + j * 256 : (long)MP + b * 16;
      const u16* kb = pr ? proj + (long)b * TP * NPJ + PC_KD + hh * 64 : (const u16*)(ws + WS_KDS) + (long)b * SKP * 512 + hh * 64;
      const u16* vt = pr ? (const u16*)(ws + WS_VDTP) + ((long)b * 512 + hh * 64) * TP : (const u16*)(ws + WS_VDTS) + ((long)b * 512 + hh * 64) * SKP;
      const float lam = sc[l * 2], oml = 1.f - sc[l * 2 + 1];
      for (int rep = 0; rep < REP_DIFF; ++rep) {
        diff_task(tid, proj + row0 * NPJ + PC_QD + hh * 64, proj + row0 * NPJ + PC_ZD + hh * 64, proj + row0 * NPJ + PC_VD + hh * 64, pr ? 256 : 16, pr ? j * 256 : PAST,
                kb, pr ? (long)NPJ : 512L, vt, pr ? TP : SKP, pr ? TP : SK, lam, oml, LOG2E * exp2f(-(float)(hh + 1)), subg);
        __syncthreads(); }
    } else if (ty == 1 || ty == 3) {
      const bool pr = (ty == 1);
      const int q32 = idx >> 2, b = pr ? (idx & 3) : idx;
      const long row0 = pr ? (long)b * TP + q32 * 32 : (long)MP + b * 16;
      const u16* kc = pr ? (const u16*)(ws + WS_CKVP) + (long)b * TP * 128 : (const u16*)(ws + WS_CKVS) + (long)b * SKP * 128;
      const u16* kr = pr ? (const u16*)(ws + WS_KRP) + (long)b * TP * 32 : (const u16*)(ws + WS_KRS) + (long)b * SKP * 32;
      const u16* vt = pr ? (const u16*)(ws + WS_CKVTP) + (long)b * 128 * TP : (const u16*)(ws + WS_CKVTS) + (long)b * 128 * SKP;
      for (int rep = 0; rep < REP_MLA; ++rep) {
        mla_task(tid, qm + row0 * 1280, pr ? 32 : 16, kc, kr, vt, pr ? TP : SKP, pr ? (q32 / 2 + 1) * 64 : SK, olat + row0 * 1024);
        __syncthreads(); }
    } else {
      const int b = idx >> 6, c = idx & 63; const long row0 = (long)b * TP + c * 64;
      const float* ab = (const float*)(ws + WS_A) + row0 * 512 + tid; const float* bb = (const float*)(ws + WS_B) + row0 * 512 + tid;
      float A = 1.f, B = 0.f;
#pragma unroll 16
      for (int i = 0; i < 64; ++i) { float a = ab[i * 512], x = bb[i * 512]; B = a * B + x; A *= a; }
      ((float2*)(ws + WS_SCAN))[(long)idx * 512 + tid] = float2{A, B};
    }
    __syncthreads();
  }
}

DI void uvscan_phase(const int TID_in, KP p, int l, int vid) {
  const int wv = __builtin_amdgcn_readfirstlane(TID_in >> 6);
  unsigned char* ws = p->ws;
  u16* proj = (u16*)(ws + WS_PROJ);
  f32x4 acc[2][2][4][2];
  for (int it = vid; it < 64 * 2 + 258 + 16; it += gridDim.x) {
    if (it < 64 * 2) {
      int pm, pn; tile_coords(it, 64, 2, pm, pn);
      const int brow = pm * 256, bcol = pn * 256;
      gemm_kloop8(fresh_tid(wv), (const u16*)(ws + WS_XN) + (long)brow * 1024 + pn * 512, 1024, (const u16*)(ws + WS_WUV) + (long)bcol * 512, 512, 8, acc);
      const int TID = fresh_tid(wv);
      GEMM_IDS
      const int oz = opaque_zero(); const int browz = brow + oz;
      u16* pz = proj + oz;
#pragma unroll
      for (int ai = 0; ai < 2; ++ai) {
        ACC_TO_LDS(ai);
        __syncthreads();
        EPI_ROWS_BEGIN(ai)
          u16* q = pz + (long)row * NPJ + PC_ZMLA + col; const uint2 z = *(const uint2*)q;
          *(uint2*)(q + (PC_QD - PC_ZMLA)) = pk4(v.x * silu(lo2f(z.x)), v.y * silu(hi2f(z.x)), v.z * silu(lo2f(z.y)), v.w * silu(hi2f(z.y)));
        EPI_ROWS_END
        __syncthreads();
      }
    } else {
      const int TID = fresh_tid(wv);
      GEMM_IDS
      const int s = it - 64 * 2;
      if (s >= 258) {
        const int q = s - 258; const int rg = q & 7, pn = q >> 3; const int row0 = MP + rg * 16, bcol = pn * 256;
        f32x4 c0, c1;
        sgemm16(lane, (const u16*)(ws + WS_XN) + (long)row0 * 1024 + pn * 512, 1024, (const u16*)(ws + WS_WUV) + (long)bcol * 512, 512, 512, wid * 32, wid * 32 + 16, c0, c1);
#pragma unroll
        for (int j = 0; j < 4; ++j) { const long row = row0 + fq * 4 + j; u16* q0 = proj + row * NPJ + PC_ZMLA + bcol + wid * 32 + fr;
          q0[PC_QD - PC_ZMLA] = f2bf(c0[j] * silu(bf2f(q0[0]))); q0[PC_QD - PC_ZMLA + 16] = f2bf(c1[j] * silu(bf2f(q0[16]))); }
        continue;
      }
      float hh; long row0; int nsteps; float* hout;
      if (s < 256) { const int b = s >> 6, c = s & 63; row0 = (long)b * TP + c * 64; nsteps = 64; hh = 0.f;
        const float2* sm = (const float2*)(ws + WS_SCAN) + (long)(b * 64) * 512 + tid;
        { int cc = 0;
          for (; cc + 16 <= c; cc += 16) { float2 t[16];
#pragma unroll
            for (int q = 0; q < 16; ++q) t[q] = sm[(long)(cc + q) * 512];
#pragma unroll
            for (int q = 0; q < 16; ++q) hh = t[q].x * hh + t[q].y; }
          for (; cc < c; ++cc) { float2 ab2 = sm[(long)cc * 512]; hh = ab2.x * hh + ab2.y; } }
        hout = (c == 63) ? p->out + O_PH + ((long)l * 4 + b) * 512 + tid : nullptr;
      } else { const int sb = (s - 256) * 4 + 0; (void)sb; row0 = 0; nsteps = 0; hh = 0.f; hout = nullptr; }
      if (s < 256) {
        const float* ab = (const float*)(ws + WS_A) + row0 * 512 + tid; const float* bb = (const float*)(ws + WS_B) + row0 * 512 + tid;
        u16* zp = proj + row0 * NPJ + PC_ZL + tid;
#pragma unroll 16
        for (int i = 0; i < nsteps; ++i) { float a = ab[(long)i * 512], x = bb[(long)i * 512]; float z = bf2f(zp[(long)i * NPJ]); hh = a * hh + x; zp[(long)i * NPJ + (PC_KD - PC_ZL)] = f2bf(hh * silu(z)); }
        if (hout) *hout = hh;
      } else {
        for (int q = 0; q < 4; ++q) { const int sb = (s - 256) * 4 + q; const long r0 = MP + sb * 16;
          float h2 = p->in[6][((long)l * 8 + sb) * 512 + tid];
          const float* ab = (const float*)(ws + WS_A) + r0 * 512 + tid; const float* bb = (const float*)(ws + WS_B) + r0 * 512 + tid;
          u16* zp = proj + r0 * NPJ + PC_ZL + tid;
#pragma unroll 16
          for (int i = 0; i < 16; ++i) { float a = ab[(long)i * 512], x = bb[(long)i * 512]; float z = bf2f(zp[(long)i * NPJ]); h2 = a * h2 + x; zp[(long)i * NPJ + (PC_KD - PC_ZL)] = f2bf(h2 * silu(z)); }
          p->out[O_SH + ((long)l * 8 + sb) * 512 + tid] = h2; }
      }
    }
  }
}

DI void oproj_phase(const int TID, KP p, int l, int vid) {
  GEMM_IDS
  unsigned char* ws = p->ws;
  f32x4 acc[1][2][4][2];
  for (int tile = vid; tile < 128 * 4; tile += gridDim.x) {
    int pm, pn; tile_coords(tile, 128, 4, pm, pn);
    const int brow = pm * 128, bcol = pn * 256;
    float4 mreg[16];
#pragma unroll
    for (int i = 0; i < 16; ++i) mreg[i] = float4{0.f, 0.f, 0.f, 0.f};
#pragma unroll 1
    for (int b = 0; b < 3; ++b) {
      const int acol = (b == 0) ? PC_QD : (b == 1) ? PC_VD : PC_KD;
      gemm_kloop_r3(TID, (const u16*)(ws + WS_PROJ) + (long)brow * NPJ + acol, NPJ, (const u16*)(ws + WS_WO) + ((long)b * 1024 + bcol) * 512, 512, 8, acc);
      const int oz = opaque_zero(); const int browz = brow + oz;
      const u16* gp = (const u16*)(ws + WS_PROJ) + oz + PC_G + b * 1024 + bcol;
      ACC_TO_LDS(0);
      __syncthreads();
#pragma unroll
      for (int it = 0; it < 16; ++it) { const int idx = it * 512 + tid; const int rl = idx >> 6, cl = (idx & 63) * 4;
        const float4 v = *(const float4*)((const float*)smem + rl * EP_LD + cl);
        const uint2 g = *(const uint2*)(gp + (long)(browz + rl) * NPJ + cl);
        mreg[it].x += lo2f(g.x) * v.x; mreg[it].y += hi2f(g.x) * v.y; mreg[it].z += lo2f(g.y) * v.z; mreg[it].w += hi2f(g.y) * v.w; }
      __syncthreads();
    }
    { const int oz = opaque_zero(); u16* mg = (u16*)(ws + WS_XN) + oz;
#pragma unroll
      for (int it = 0; it < 16; ++it) { const int idx = it * 512 + tid; const int rl = idx >> 6, cl = (idx & 63) * 4;
        *(uint2*)(mg + (long)(brow + rl) * 1024 + bcol + cl) = pk4(mreg[it].x, mreg[it].y, mreg[it].z, mreg[it].w); } }
  }
  for (int it = (int)gridDim.x - 1 - vid; it < 8 * 4; it += gridDim.x) {
    const int rg = it & 7, pn = it >> 3; const int row0 = MP + rg * 16, bcol = pn * 256;
    const u16* proj = (const u16*)(ws + WS_PROJ); u16* mg = (u16*)(ws + WS_XN);
    float m0[4] = {0.f, 0.f, 0.f, 0.f}, m1[4] = {0.f, 0.f, 0.f, 0.f};
#pragma unroll 1
    for (int b = 0; b < 3; ++b) {
      const int acol = (b == 0) ? PC_QD : (b == 1) ? PC_VD : PC_KD;
      f32x4 c0, c1;
      sgemm16(lane, proj + (long)row0 * NPJ + acol, NPJ, (const u16*)(ws + WS_WO) + ((long)b * 1024 + bcol) * 512, 512, 512, wid * 32, wid * 32 + 16, c0, c1);
#pragma unroll
      for (int j = 0; j < 4; ++j) { const long row = row0 + fq * 4 + j; const u16* g = proj + row * NPJ + PC_G + b * 1024 + bcol + wid * 32 + fr;
        m0[j] += bf2f(g[0]) * c0[j]; m1[j] += bf2f(g[16]) * c1[j]; }
    }
#pragma unroll
    for (int j = 0; j < 4; ++j) { const long row = row0 + fq * 4 + j; u16* q = mg + row * 1024 + bcol + wid * 32 + fr; q[0] = f2bf(m0[j]); q[16] = f2bf(m1[j]); }
  }
}

DI void wout_phase(const int TID_in, KP p, int l, int vid, float* outp) {
  const int wv = __builtin_amdgcn_readfirstlane(TID_in >> 6);
  unsigned char* ws = p->ws;
  f32x4 acc[2][2][4][2];
  for (int tile = vid; tile < 64 * 4; tile += gridDim.x) {
    int pm, pn; tile_coords(tile, 64, 4, pm, pn);
    const int brow = pm * 256, bcol = pn * 256;
    gemm_kloop8(fresh_tid(wv), (const u16*)(ws + WS_XN) + (long)brow * 1024, 1024, (const u16*)(ws + WS_WOUT) + (long)bcol * 1024, 1024, 16, acc);
    const int TID = fresh_tid(wv);
    GEMM_IDS
    const int oz = opaque_zero(); const int browz = brow + oz;
    float* out = outp + oz;
#pragma unroll
    for (int ai = 0; ai < 2; ++ai) {
      ACC_TO_LDS(ai);
      __syncthreads();
      EPI_ROWS_BEGIN(ai)
        if (row < M) { const float4 xo = (l == 0) ? (row < MP ? *(const float4*)(p->in[0] + (long)row * D + col) : *(const float4*)(p->in[1] + (long)(row - MP) * D + col)) : *(const float4*)(out + (long)row * D + col);
          *(float4*)(out + (long)row * D + col) = float4{xo.x + v.x, xo.y + v.y, xo.z + v.z, xo.w + v.w}; }
      EPI_ROWS_END
      __syncthreads();
    }
  }
  const int TID = fresh_tid(wv);
  GEMM_IDS
  for (int it = (int)gridDim.x - 1 - vid; it < 8 * 4; it += gridDim.x) {
    const int rg = it & 7, pn = it >> 3; const int row0 = MP + rg * 16, bcol = pn * 256;
    f32x4 c0, c1;
    sgemm16(lane, (const u16*)(ws + WS_XN) + (long)row0 * 1024, 1024, (const u16*)(ws + WS_WOUT) + (long)bcol * 1024, 1024, 1024, wid * 32, wid * 32 + 16, c0, c1);
#pragma unroll
    for (int j = 0; j < 4; ++j) { const int row = row0 + fq * 4 + j; const int col = bcol + wid * 32 + fr;
      const float* xo = (l == 0) ? p->in[1] + (long)(row - MP) * D + col : outp + (long)row * D + col;
      const float x0 = xo[0], x1 = xo[16];
      outp[(long)row * D + col] = x0 + c0[j]; outp[(long)row * D + col + 16] = x1 + c1[j]; }
  }
}

DI void final_phase(const int TID, KP p) {
  const int lane = TID & 63, wid = TID >> 6;
  const float* g = p->in[31];
  for (int row = blockIdx.x * 8 + wid; row < M; row += gridDim.x * 8) {
    float* src = p->out + (long)row * D;
    float4 v[4]; float ss = 0.f;
#pragma unroll
    for (int i = 0; i < 4; ++i) { v[i] = *(const float4*)(src + i * 256 + lane * 4); ss += v[i].x * v[i].x + v[i].y * v[i].y + v[i].z * v[i].z + v[i].w * v[i].w; }
    ss = wsum(ss); const float rs = rsqrtf(ss * (1.f / D) + EPS);
#pragma unroll
    for (int i = 0; i < 4; ++i) { float4 gg = *(const float4*)(g + i * 256 + lane * 4);
      *(float4*)(src + i * 256 + lane * 4) = float4{v[i].x * rs * gg.x, v[i].y * rs * gg.y, v[i].z * rs * gg.z, v[i].w * rs * gg.w}; }
  }
}


#define XB_TMO      128
#define XB_XCNT(j)  (256  + 64 * (j))
#define XB_XSUB(j)  (1280 + 64 * (j))
#define XB_XGEN(j)  (2304 + 64 * (j))
#define XB_TOP      3328
#define XB_TOPGEN   3392
#define XCD_BAR_WORDS 3456
#define XB_SPIN_CAP (1u << 22)
#define LAS __attribute__((address_space(3)))
DI unsigned xb_ld(unsigned* p) { return __hip_atomic_load(p, __ATOMIC_RELAXED, __HIP_MEMORY_SCOPE_AGENT); }
DI unsigned xb_add(unsigned* p, unsigned v) { return __hip_atomic_fetch_add(p, v, __ATOMIC_RELAXED, __HIP_MEMORY_SCOPE_AGENT); }
DI unsigned xb_xcc_id() { return (unsigned)__builtin_amdgcn_s_getreg((3 << 11) | 20) & 0xFu; }
#define XB_SPIN(cond, bar) do { unsigned _sp = 0; while (cond) { __builtin_amdgcn_s_sleep(1); \
    if ((++_sp & 255u) == 0u) { if (xb_ld(&(bar)[XB_TMO])) break; if (_sp > XB_SPIN_CAP) { atomicAdd(&(bar)[XB_TMO], 1u); break; } } } } while (0)
DI void xcd_barrier_complete(unsigned* bar, unsigned x, unsigned& nloc, unsigned& nx) {
  const unsigned G = gridDim.x;
  unsigned sum, cnt, mine, sp = 0u;
  for (;;) {
    sum = 0u; cnt = 0u; mine = 0u;
#pragma unroll
    for (unsigned j = 0; j < 16; ++j) { const unsigned c = xb_ld(&bar[XB_XCNT(j)]); sum += c; cnt += (c > 0u) ? 1u : 0u; mine = (j == x) ? c : mine; }
    if (sum == G) break;
    __builtin_amdgcn_s_sleep(1);
    if ((++sp & 255u) == 0u) { if (xb_ld(&bar[XB_TMO])) break; if (sp > XB_SPIN_CAP) { atomicAdd(&bar[XB_TMO], 1u); break; } }
  }
  nloc = mine > 0u ? mine : 1u; nx = cnt > 0u ? cnt : 1u;
}
DI void xcd_barrier(const int TID, unsigned* bar, unsigned x) {
  volatile LAS unsigned* st = (volatile LAS unsigned*)(smem + TASK_OFF + 16);
  asm volatile("s_waitcnt vmcnt(0)" ::: "memory");
  __syncthreads();
  if (TID == 0) {
    __builtin_amdgcn_s_waitcnt(0);
    unsigned nloc = st[0], nx = st[1];
    if (nloc == 0u) { xcd_barrier_complete(bar, x, nloc, nx); st[0] = nloc; st[1] = nx; }
    const unsigned old = xb_add(&bar[XB_XSUB(x)], 1u);
    const unsigned gen = old / nloc;
    if (old + 1u == (gen + 1u) * nloc) {
      __builtin_amdgcn_fence(__ATOMIC_RELEASE, "agent");
      asm volatile("s_waitcnt vmcnt(0)" ::: "memory");
      const unsigned og = xb_add(&bar[XB_TOP], 1u);
      const unsigned tg = og / nx;
      if (og + 1u == (tg + 1u) * nx) xb_add(&bar[XB_TOPGEN], 1u);
      else XB_SPIN(xb_ld(&bar[XB_TOPGEN]) == tg, bar);
      __builtin_amdgcn_fence(__ATOMIC_ACQUIRE, "agent");
      xb_add(&bar[XB_XGEN(x)], 1u);
      asm volatile("s_waitcnt vmcnt(0)" ::: "memory");
    } else {
      XB_SPIN(xb_ld(&bar[XB_XGEN(x)]) == gen, bar);
      __builtin_amdgcn_fence(__ATOMIC_ACQUIRE, "agent");
      asm volatile("s_waitcnt vmcnt(0)" ::: "memory");
    }
  }
  __syncthreads();
}

__global__ void __launch_bounds__(512, 2) mega(Params p_) {
  const int wave_s = __builtin_amdgcn_readfirstlane((int)(__builtin_amdgcn_workitem_id_x() >> 6));
  const int G = gridDim.x, bx = blockIdx.x;
  const int vid = (G % 8 == 0) ? (bx % 8) * (G / 8) + bx / 8 : bx;
  const int ph_lo = p_.ph_lo, ph_hi = p_.ph_hi;
  const unsigned xcc = xb_xcc_id();
  { const int t0 = __builtin_amdgcn_workitem_id_x(); if (t0 < 4) ((volatile LAS unsigned*)(smem + TASK_OFF))[4 + t0] = 0u; __syncthreads();
    if (t0 == 0) (void)xb_add((unsigned*)(p_.ws + WS_BAR) + XB_XCNT(xcc), 1u); }
  if (ph_hi - ph_lo > 1) cg::this_grid().sync();
  for (int ph = ph_lo; ph < ph_hi; ++ph) {
    int TID; asm volatile("v_mbcnt_lo_u32_b32 %0, -1, 0\n\tv_mbcnt_hi_u32_b32 %0, -1, %0" : "=v"(TID)); TID += wave_s * 64;
    KP p = (KP)__builtin_amdgcn_kernarg_segment_ptr(); asm volatile("" : "+s"(p));
    unsigned* ctrs = (unsigned*)(p->ws + WS_CTL);
    if (ph == NPH - 1) final_phase(TID, p);
    else {
      const int l = ph >> 3, s = ph & 7;
      switch (s) {
        case 0: for (int rep = 0; rep < REP_PREP; ++rep) { prep_phase(TID, p, l); __syncthreads(); } break;
        case 1: for (int rep = 0; rep < REP_INPROJ; ++rep) { inproj_phase(TID, p, l, vid); __syncthreads(); } break;
        case 2: mid_phase(TID, p, l); break;
        case 3: for (int rep = 0; rep < REP_QLRU; ++rep) { qlru_phase(TID, p, l, vid); __syncthreads(); } break;
        case 4: for (int rep = 0; rep < REP_ATTN; ++rep) { attn_phase(TID, p, l, ctrs + ph + 64 * rep); __syncthreads(); } break;
        case 5: for (int rep = 0; rep < REP_UVSCAN; ++rep) { uvscan_phase(TID, p, l, vid); __syncthreads(); } break;
        case 6: for (int rep = 0; rep < REP_OPROJ; ++rep) { oproj_phase(TID, p, l, vid); __syncthreads(); } break;
        default: wout_phase(TID, p, l, vid, p->out); break;
      }
    }
    if (TAIL_PHASE >= 0 && ph == NPH - 1) {
      for (int rep = 0; rep < TAIL_REPS; ++rep) {
        xcd_barrier(TID, (unsigned*)(p->ws + WS_BAR), xcc);
        if (TAIL_PHASE == 2) mid_phase(TID, p, 3);
        else if (TAIL_PHASE == 7) wout_phase(TID, p, 3, vid, (float*)(p->ws + WS_PROJ));
        else if (TAIL_PHASE == 1) inproj_phase(TID, p, 3, vid);
        else if (TAIL_PHASE == 6) oproj_phase(TID, p, 3, vid);
        else if (TAIL_PHASE == 8) final_phase(TID, p);
        __syncthreads();
      }
    }
    if (ph + 1 < ph_hi) {
      xcd_barrier(TID, (unsigned*)(p->ws + WS_BAR), xcc);
      for (int e = 0; e < EXTRA_SYNC; ++e) xcd_barrier(TID, (unsigned*)(p->ws + WS_BAR), xcc);
    }
  }
}

extern "C" void kernel_launch(void* const* d_in, const int* in_sizes, int n_in, void* d_out, int out_size, void* d_ws, size_t ws_size, hipStream_t stream) {
  static int grid = 0;
  if (grid == 0) {
    if (n_in != 32 || (long)out_size != O_END || ws_size < WS_END) { fprintf(stderr, "kernel_launch: unexpected shapes (n_in %d out %d ws %zu need %zu)\n", n_in, out_size, ws_size, (size_t)WS_END); grid = -1; return; }
    int dev = 0, cus = 0, per_cu = 0;
    (void)hipGetDevice(&dev); (void)hipDeviceGetAttribute(&cus, hipDeviceAttributeMultiprocessorCount, dev);
    if (hipFuncSetAttribute((const void*)mega, hipFuncAttributeMaxDynamicSharedMemorySize, LDS_BYTES) != hipSuccess) { fprintf(stderr, "hipFuncSetAttribute failed\n"); grid = -1; return; }
    if (hipOccupancyMaxActiveBlocksPerMultiprocessor(&per_cu, (const void*)mega, 512, LDS_BYTES) != hipSuccess || per_cu < 1) { fprintf(stderr, "occupancy query failed (%d)\n", per_cu); per_cu = 1; }
    (void)hipGetLastError();
    grid = cus;
  }
  if (grid < 0) return;
  (void)hipMemsetAsync((char*)d_ws + WS_CTL, 0, WS_ROPE, stream);
  Params p{};
  for (int i = 0; i < 32; ++i) p.in[i] = (const float*)d_in[i];
  p.out = (float*)d_out; p.ws = (unsigned char*)d_ws;
#if ONE_LAUNCH
  p.ph_lo = 0; p.ph_hi = NPH;
  void* args[] = {&p};
  hipError_t e = hipLaunchCooperativeKernel((const void*)mega, dim3(grid), dim3(512), args, LDS_BYTES, stream);
  if (e != hipSuccess) fprintf(stderr, "cooperative launch failed: %s\n", hipGetErrorString(e));
#else
  for (int ph = 0; ph < NPH; ++ph) { p.ph_lo = ph; p.ph_hi = ph + 1; hipLaunchKernelGGL(mega, dim3(grid), dim3(512), LDS_BYTES, stream, p); }
#endif
}
```

```cpp
#include <hip/hip_runtime.h>
#include <hip/hip_cooperative_groups.h>
#include <cstdio>
namespace cg = cooperative_groups;

#ifndef ONE_LAUNCH
#define ONE_LAUNCH 1
#endif
#define REP_PREP 1
#define REP_INPROJ 1
#define REP_QLRU 1
#define REP_ATTN 1
#define REP_OPROJ 1
#define REP_UVSCAN 1
#define TAIL_PHASE -1
#define TAIL_REPS 4
#define REP_MLA 1
#define REP_DIFF 1
#define EXTRA_SYNC 0

typedef unsigned short u16;
typedef unsigned int u32;
using bf16x8 = __attribute__((ext_vector_type(8))) short;
using s16x4  = __attribute__((ext_vector_type(4))) short;
using f32x4  = __attribute__((ext_vector_type(4))) float;
using f32x16 = __attribute__((ext_vector_type(16))) float;
typedef float f32x2 __attribute__((ext_vector_type(2)));
typedef __bf16 bf16x2 __attribute__((ext_vector_type(2)));
#define DI __device__ __forceinline__

constexpr int D = 1024, TP = 4096, MP = 16384, TS = 16, MS = 128, M = MP + MS, MT = 65, MPAD = MT * 256;
constexpr int PAST = 2048, SK = PAST + TS, SKP = 2112;
constexpr int NIN = 7072, NPJ = 7168, DEPTH = 4;
constexpr float EPS = 1e-6f;
constexpr float LOG2E = 1.4426950408889634f;
constexpr float QM_SCALE = 0.10206207261596575f * LOG2E;
constexpr float QD_SCALE = 0.17677669529663687f * LOG2E;
constexpr int PC_CQ = 0, PC_CKV = 256, PC_KR = 384, PC_ZMLA = 512, PC_QD = 1024, PC_KD = 1536, PC_VD = 2048, PC_ZD = 2560,
              PC_XL = 3072, PC_ZL = 3584, PC_G = 4096;
constexpr long O_YP = 0, O_YS = O_YP + (long)MP * D, O_PCKV = O_YS + (long)MS * D, O_PKR = O_PCKV + 4L * MP * 128,
               O_PDK = O_PKR + 4L * MP * 32, O_PDV = O_PDK + 4L * MP * 512, O_PH = O_PDV + 4L * MP * 512, O_PCV = O_PH + 4L * 4 * 512,
               O_SCKV = O_PCV + 4L * 4 * 3 * 512, O_SKR = O_SCKV + 4L * MS * 128, O_SDK = O_SKR + 4L * MS * 32, O_SDV = O_SDK + 4L * MS * 512,
               O_SH = O_SDV + 4L * MS * 512, O_SCV = O_SH + 4L * 8 * 512, O_END = O_SCV + 4L * 8 * 3 * 512;
constexpr size_t al(size_t x) { return (x + 255) & ~(size_t)255; }
constexpr size_t WS_CTL = 0, WS_BAR = 4096, WS_ROPE = 20480, WS_WIN = WS_ROPE + al(4096 * 16 * 8), WS_WQ = WS_WIN + al((size_t)NPJ * 1024 * 2),
                 WS_WUV = WS_WQ + al(1280 * 256 * 2), WS_WO = WS_WUV + al(512 * 512 * 2), WS_WOUT = WS_WO + al(3 * 1024 * 512 * 2),
                 WS_WLRU = WS_WOUT + al(1024 * 1024 * 2), WS_XN = WS_WLRU + al(1024 * 256 * 2), WS_PROJ = WS_XN + al((size_t)MPAD * 1024 * 2),
                 WS_QMLA = WS_PROJ + al((size_t)MPAD * NPJ * 2), WS_XC = WS_QMLA + al((size_t)MPAD * 1280 * 2), WS_A = WS_XC + al((size_t)MPAD * 512 * 2),
                 WS_B = WS_A + al((size_t)M * 512 * 4), WS_SCAN = WS_B + al((size_t)M * 512 * 4), WS_CKVP = WS_SCAN + al(4 * 64 * 512 * 8),
                 WS_CKVTP = WS_CKVP + al((size_t)MP * 128 * 2), WS_KRP = WS_CKVTP + al((size_t)MP * 128 * 2), WS_VDTP = WS_KRP + al((size_t)MP * 32 * 2),
                 WS_CKVS = WS_VDTP + al((size_t)MP * 512 * 2), WS_CKVTS = WS_CKVS + al(8 * SKP * 128 * 2), WS_KRS = WS_CKVTS + al(8 * SKP * 128 * 2),
                 WS_KDS = WS_KRS + al(8 * SKP * 32 * 2), WS_VDTS = WS_KDS + al((size_t)8 * SKP * 512 * 2), WS_END = WS_VDTS + al((size_t)8 * SKP * 512 * 2);
constexpr int EP_LD = 260;
constexpr int LDS_BYTES = 147456 + 256;
constexpr int TASK_OFF = 147456;
constexpr int NPH = 33;

struct Params { const float* in[32]; float* out; unsigned char* ws; int ph_lo, ph_hi; };
typedef const Params __attribute__((address_space(4)))* KP;

extern __shared__ __attribute__((aligned(16))) unsigned char smem[];

DI float bf2f(u16 v) { return __uint_as_float((u32)v << 16); }
DI u32 pk2(float a, float b) { f32x2 v = {a, b}; bf16x2 r = __builtin_convertvector(v, bf16x2); return __builtin_bit_cast(u32, r); }
DI u16 f2bf(float a) { return (u16)(pk2(a, 0.f) & 0xffffu); }
DI float lo2f(u32 v) { return __uint_as_float(v << 16); }
DI float hi2f(u32 v) { return __uint_as_float(v & 0xffff0000u); }
DI float sigm(float x) { return 1.f / (1.f + __expf(-x)); }
DI float silu(float x) { return x / (1.f + __expf(-x)); }
DI float softplus_f(float x) { return fmaxf(x, 0.f) + __logf(1.f + __expf(-fabsf(x))); }
DI float neg_expm1(float x) { const float t = x * (1.f + x * (0.5f + x * (0.16666667f + x * 0.041666668f))); return (x > -0.1f) ? -t : 1.f - __expf(x); }
DI float wsum(float v) { for (int o = 32; o; o >>= 1) v += __shfl_xor(v, o); return v; }
DI int kperm(int k) { int q = (k >> 2) & 3; q = (q == 1) ? 2 : (q == 2) ? 1 : q; return (k & ~15) | (q << 2) | (k & 3); }
DI int crow(int reg, int h) { return (reg & 3) + 8 * (reg >> 2) + 4 * h; }
DI int row_pos(int row) { return row < MP ? (row & (TP - 1)) : PAST + ((row - MP) & 15); }

struct TaskTab { int n; u32 t[1408]; };
constexpr TaskTab make_tab() {
  TaskTab x{}; int n = 0;
  for (int i = 0; i < 64; ++i) x.t[n++] = (2u << 16) | i;
  for (int i = 0; i < 8; ++i) x.t[n++] = (3u << 16) | i;
  for (int L = 144; L >= 1; --L) {
    for (int j = 0; j < 16; ++j) if (9 * (j + 1) == L) for (int i = 0; i < 32; ++i) x.t[n++] = (0u << 16) | (j * 32 + i);
    for (int q = 0; q < 128; ++q) if (q / 2 + 1 == L) for (int b = 0; b < 4; ++b) x.t[n++] = (1u << 16) | (q * 4 + b);
  }
  for (int i = 0; i < 256; ++i) x.t[n++] = (4u << 16) | i;
  x.n = n; return x;
}
__device__ const TaskTab g_tab = make_tab();
__device__ const float g_invf[16] = {1.0f, 0.5623413251903491f, 0.31622776601683794f, 0.1778279410038923f, 0.1f, 0.05623413251903491f,
  0.031622776601683794f, 0.01778279410038923f, 0.01f, 0.005623413251903491f, 0.0031622776601683794f, 0.001778279410038923f, 0.001f,
  0.0005623413251903491f, 0.00031622776601683794f, 0.0001778279410038923f};

DI int lds_byte(int r, int c) { int st = (r >> 4) * 2 + (c >> 5), rr = r & 15, cc = c & 31, ob = rr * 64 + cc * 2; return st * 1024 + (ob ^ (((ob >> 9) & 1) << 5)); }
DI void stage_rc(int b, int& R, int& C) { int st = b >> 10, sb = b & 1023, swz = sb ^ (((sb >> 9) & 1) << 5); R = (st >> 1) * 16 + (swz >> 6); C = (st & 1) * 32 + ((swz & 63) >> 1); }

#define SA(b, h) (smem + ((b) * 2 + (h)) * 16384)
#define SB(b, h) (smem + (4 + (b) * 2 + (h)) * 16384)
#define STAGE_A(P, half, kt) do { const u16* _g = A + (long)(half) * 128 * lda + (long)(kt) * 64; \
    __builtin_amdgcn_global_load_lds((const unsigned*)(_g + offA0), (unsigned*)((P) + wbase), 16, 0, 0); \
    __builtin_amdgcn_global_load_lds((const unsigned*)(_g + 64 * lda + offA0), (unsigned*)((P) + wbase + 8192), 16, 0, 0); } while (0)
#define STAGE_B(P, half, kt) do { const u16* _g = Bt + (long)(half) * 128 * ldb + (long)(kt) * 64; \
    __builtin_amdgcn_global_load_lds((const unsigned*)(_g + offB0), (unsigned*)((P) + wbase), 16, 0, 0); \
    __builtin_amdgcn_global_load_lds((const unsigned*)(_g + 64 * ldb + offB0), (unsigned*)((P) + wbase + 8192), 16, 0, 0); } while (0)
#define LDA(dst, b, h) _Pragma("unroll") for (int m = 0; m < 4; ++m) _Pragma("unroll") for (int k = 0; k < 2; ++k) \
    dst[m][k] = *reinterpret_cast<const bf16x8*>(SA(b, h) + lds_byte(wr * 64 + m * 16 + fr, k * 32 + fq * 8))
#define LDB(dst, b, h) _Pragma("unroll") for (int n = 0; n < 2; ++n) _Pragma("unroll") for (int k = 0; k < 2; ++k) \
    dst[n][k] = *reinterpret_cast<const bf16x8*>(SB(b, h) + lds_byte(wc * 32 + n * 16 + fr, k * 32 + fq * 8))
#define MMA(ai, bj, At, Bx) do { __builtin_amdgcn_s_setprio(1); \
    _Pragma("unroll") for (int m = 0; m < 4; ++m) _Pragma("unroll") for (int n = 0; n < 2; ++n) _Pragma("unroll") for (int k = 0; k < 2; ++k) \
      acc[ai][bj][m][n] = __builtin_amdgcn_mfma_f32_16x16x32_bf16(At[m][k], Bx[n][k], acc[ai][bj][m][n], 0, 0, 0); \
    __builtin_amdgcn_s_setprio(0); } while (0)
#define WAIT_V(n) asm volatile("s_waitcnt vmcnt(" #n ")" ::: "memory")
#define WAIT_L(n) asm volatile("s_waitcnt lgkmcnt(" #n ")" ::: "memory")
#define BAR __builtin_amdgcn_s_barrier()
#define SCHED __builtin_amdgcn_sched_barrier(0)

template <int NA> DI void gemm_kloop(const int TID, const u16* __restrict__ A, int lda, const u16* __restrict__ Bt, int ldb, int nt, f32x4 (&acc)[NA][2][4][2]) {
  const int tid = TID, wid = tid >> 6, lane = tid & 63, wr = wid >> 2, wc = wid & 3, fr = lane & 15, fq = lane >> 4;
  unsigned offA0, offB0;
  { int r, c; stage_rc(tid * 16, r, c); offA0 = r * lda + c; offB0 = r * ldb + c; }
  const int wbase = __builtin_amdgcn_readfirstlane(wid) * 1024;
#pragma unroll
  for (int a = 0; a < NA; ++a)
#pragma unroll
    for (int b = 0; b < 2; ++b)
#pragma unroll
      for (int m = 0; m < 4; ++m)
#pragma unroll
        for (int n = 0; n < 2; ++n) acc[a][b][m][n] = f32x4{0.f, 0.f, 0.f, 0.f};
  STAGE_B(SB(0, 0), 0, 0); STAGE_A(SA(0, 0), 0, 0); STAGE_B(SB(0, 1), 1, 0); if (NA == 2) STAGE_A(SA(0, 1), 1, 0);
  WAIT_V(0); __syncthreads();
#pragma unroll 1
  for (int t = 0; t < nt; ++t) {
    const int cb = t & 1, nb = cb ^ 1;
    if (t + 1 < nt) { STAGE_B(SB(nb, 0), 0, t + 1); STAGE_A(SA(nb, 0), 0, t + 1); STAGE_B(SB(nb, 1), 1, t + 1); if (NA == 2) STAGE_A(SA(nb, 1), 1, t + 1); }
#pragma unroll 1
    for (int k = 0; k < 2; ++k) {
      bf16x8 Bf[2][2];
#pragma unroll
      for (int bj = 0; bj < 2; ++bj)
#pragma unroll
        for (int n = 0; n < 2; ++n) Bf[bj][n] = *reinterpret_cast<const bf16x8*>(SB(cb, bj) + lds_byte(wc * 32 + n * 16 + fr, k * 32 + fq * 8));
#pragma unroll
      for (int ai = 0; ai < NA; ++ai) {
        bf16x8 Af[4];
#pragma unroll
        for (int m = 0; m < 4; ++m) Af[m] = *reinterpret_cast<const bf16x8*>(SA(cb, ai) + lds_byte(wr * 64 + m * 16 + fr, k * 32 + fq * 8));
#pragma unroll
        for (int bj = 0; bj < 2; ++bj)
#pragma unroll
          for (int m = 0; m < 4; ++m)
#pragma unroll
            for (int n = 0; n < 2; ++n) acc[ai][bj][m][n] = __builtin_amdgcn_mfma_f32_16x16x32_bf16(Af[m], Bf[bj][n], acc[ai][bj][m][n], 0, 0, 0);
      }
    }
    WAIT_V(0); __syncthreads();
  }
}

#define LDA8(dst, b, h) _Pragma("unroll") for (int m = 0; m < 4; ++m) _Pragma("unroll") for (int k = 0; k < 2; ++k) \
    dst[m][k] = *reinterpret_cast<const bf16x8*>(SA(b, h) + lds_byte(wr * 64 + m * 16 + fr, k * 32 + fq * 8))
#define LDB8(dst, b, h) _Pragma("unroll") for (int n = 0; n < 2; ++n) _Pragma("unroll") for (int k = 0; k < 2; ++k) \
    dst[n][k] = *reinterpret_cast<const bf16x8*>(SB(b, h) + lds_byte(wc * 32 + n * 16 + fr, k * 32 + fq * 8))
#define MMA8(ai, bj, At, Bx) do { __builtin_amdgcn_s_setprio(1); \
    _Pragma("unroll") for (int m = 0; m < 4; ++m) _Pragma("unroll") for (int n = 0; n < 2; ++n) _Pragma("unroll") for (int k = 0; k < 2; ++k) \
      acc[ai][bj][m][n] = __builtin_amdgcn_mfma_f32_16x16x32_bf16(At[m][k], Bx[n][k], acc[ai][bj][m][n], 0, 0, 0); \
    __builtin_amdgcn_s_setprio(0); } while (0)
DI void gemm_kloop8(const int TID, const u16* __restrict__ A, int lda, const u16* __restrict__ Bt, int ldb, int nt, f32x4 (&acc)[2][2][4][2]) {
  const int tid = TID, wid = tid >> 6, lane = tid & 63, wr = wid >> 2, wc = wid & 3, fr = lane & 15, fq = lane >> 4;
  unsigned offA0, offB0;
  { int r, c; stage_rc(tid * 16, r, c); offA0 = r * lda + c; offB0 = r * ldb + c; }
  const int wbase = __builtin_amdgcn_readfirstlane(wid) * 1024;
#pragma unroll
  for (int a = 0; a < 2; ++a)
#pragma unroll
    for (int b = 0; b < 2; ++b)
#pragma unroll
      for (int m = 0; m < 4; ++m)
#pragma unroll
        for (int n = 0; n < 2; ++n) acc[a][b][m][n] = f32x4{0.f, 0.f, 0.f, 0.f};
  bf16x8 At[4][2], B0[2][2], B1[2][2];
  STAGE_B(SB(0, 0), 0, 0); STAGE_A(SA(0, 0), 0, 0);
  STAGE_B(SB(0, 1), 1, 0); STAGE_A(SA(0, 1), 1, 0);
  if (wr == 1) BAR;
  WAIT_V(4); BAR;
  STAGE_B(SB(1, 0), 0, 1); STAGE_A(SA(1, 0), 0, 1); STAGE_B(SB(1, 1), 1, 1);
  WAIT_V(6); BAR;
#pragma unroll 1
  for (int t = 0; t < nt - 2; t += 2) {
    LDB8(B0, 0, 0); SCHED; LDA8(At, 0, 0); STAGE_A(SA(1, 1), 1, t + 1);
    WAIT_L(8); BAR; WAIT_L(0); MMA8(0, 0, At, B0); BAR; SCHED;
    LDB8(B1, 0, 1); STAGE_B(SB(0, 0), 0, t + 2);
    BAR; WAIT_L(0); MMA8(0, 1, At, B1); BAR;
    LDA8(At, 0, 1); STAGE_A(SA(0, 0), 0, t + 2);
    BAR; WAIT_L(0); MMA8(1, 0, At, B0); BAR; SCHED;
    STAGE_B(SB(0, 1), 1, t + 2);
    WAIT_V(6); BAR; MMA8(1, 1, At, B1); BAR;
    LDB8(B0, 1, 0); SCHED; LDA8(At, 1, 0); STAGE_A(SA(0, 1), 1, t + 2);
    WAIT_L(8); BAR; WAIT_L(0); MMA8(0, 0, At, B0); BAR; SCHED;
    LDB8(B1, 1, 1); STAGE_B(SB(1, 0), 0, t + 3);
    BAR; WAIT_L(0); MMA8(0, 1, At, B1); BAR;
    LDA8(At, 1, 1); STAGE_A(SA(1, 0), 0, t + 3);
    BAR; WAIT_L(0); MMA8(1, 0, At, B0); BAR; SCHED;
    STAGE_B(SB(1, 1), 1, t + 3);
    WAIT_V(6); BAR; MMA8(1, 1, At, B1); BAR;
  }
  { LDB8(B0, 0, 0); LDA8(At, 0, 0); STAGE_A(SA(1, 1), 1, nt - 1);
    BAR; WAIT_L(0); MMA8(0, 0, At, B0); BAR;
    LDB8(B1, 0, 1); BAR; WAIT_L(0); MMA8(0, 1, At, B1); BAR;
    LDA8(At, 0, 1); WAIT_V(4); BAR; WAIT_L(0); MMA8(1, 0, At, B0); MMA8(1, 1, At, B1); BAR; }
  { LDB8(B0, 1, 0); LDA8(At, 1, 0); WAIT_V(2); BAR; WAIT_L(0); MMA8(0, 0, At, B0); BAR;
    LDB8(B1, 1, 1); WAIT_V(0); BAR; WAIT_L(0); MMA8(0, 1, At, B1); BAR;
    LDA8(At, 1, 1); BAR; WAIT_L(0); MMA8(1, 0, At, B0); MMA8(1, 1, At, B1); BAR; }
  if (wr == 0) BAR;
  __syncthreads();
}

DI void gemm_kloop_r3(const int TID, const u16* __restrict__ A, int lda, const u16* __restrict__ Bt, int ldb, int nt, f32x4 (&acc)[1][2][4][2]) {
  const int tid = TID, wid = tid >> 6, lane = tid & 63, wr = wid >> 2, wc = wid & 3, fr = lane & 15, fq = lane >> 4;
  unsigned offA0, offB0;
  { int r, c; stage_rc(tid * 16, r, c); offA0 = r * lda + c; offB0 = r * ldb + c; }
  const int wbase = __builtin_amdgcn_readfirstlane(wid) * 1024;
#pragma unroll
  for (int b = 0; b < 2; ++b)
#pragma unroll
    for (int m = 0; m < 4; ++m)
#pragma unroll
      for (int n = 0; n < 2; ++n) acc[0][b][m][n] = f32x4{0.f, 0.f, 0.f, 0.f};
#define R3A(i) (smem + (i) * 49152)
#define R3B(i, h) (smem + (i) * 49152 + 16384 + (h) * 16384)
#define R3_STAGE(i, kt) do { STAGE_B(R3B(i, 0), 0, kt); STAGE_A(R3A(i), 0, kt); STAGE_B(R3B(i, 1), 1, kt); } while (0)
  if (wbase >= 4096) __builtin_amdgcn_s_setprio(1);
  R3_STAGE(0, 0); R3_STAGE(1, 1);
  WAIT_V(6); BAR;
  int cur = 0;
#pragma unroll 1
  for (int t = 0; t < nt; ++t) {
    const int nx1 = (cur == 2) ? 0 : cur + 1, nx2 = (cur == 0) ? 2 : cur - 1;
    if (t + 2 < nt) R3_STAGE(nx2, t + 2);
#pragma unroll
    for (int k = 0; k < 2; ++k) {
      bf16x8 Bf[2][2], Af[4];
#pragma unroll
      for (int bj = 0; bj < 2; ++bj)
#pragma unroll
        for (int n = 0; n < 2; ++n) Bf[bj][n] = *reinterpret_cast<const bf16x8*>(R3B(cur, bj) + lds_byte(wc * 32 + n * 16 + fr, k * 32 + fq * 8));
#pragma unroll
      for (int m = 0; m < 4; ++m) Af[m] = *reinterpret_cast<const bf16x8*>(R3A(cur) + lds_byte(wr * 64 + m * 16 + fr, k * 32 + fq * 8));
#pragma unroll
      for (int bj = 0; bj < 2; ++bj)
#pragma unroll
        for (int m = 0; m < 4; ++m)
#pragma unroll
          for (int n = 0; n < 2; ++n) acc[0][bj][m][n] = __builtin_amdgcn_mfma_f32_16x16x32_bf16(Af[m], Bf[bj][n], acc[0][bj][m][n], 0, 0, 0);
    }
    if (t + 2 < nt) WAIT_V(6); else WAIT_V(0);
    WAIT_L(0); BAR;
    cur = nx1;
  }
  __builtin_amdgcn_s_setprio(0);
}

DI void tile_coords(int tile, int nM, int nN, int& pm, int& pn) {
  int nig = 8 * nN, gid = tile / nig, fm = gid * 8, gsz = min(nM - fm, 8), loc = tile % nig;
  pm = fm + loc % gsz; pn = loc / gsz;
}

#define GEMM_IDS const int tid = TID, wid = tid >> 6, lane = tid & 63, wr = wid >> 2, wc = wid & 3, fr = lane & 15, fq = lane >> 4; (void)tid; (void)wr; (void)wc; (void)fr; (void)fq; (void)lane;
DI int fresh_tid(int wv) { int l; asm volatile("v_mbcnt_lo_u32_b32 %0, -1, 0\n\tv_mbcnt_hi_u32_b32 %0, -1, %0" : "=v"(l)); return wv * 64 + l; }
DI int opaque_zero() { int z; asm volatile("s_mov_b32 %0, 0" : "=s"(z)); return z; }
#define ACC_TO_LDS(ai) do { float* _e = (float*)smem; \
  _Pragma("unroll") for (int bj = 0; bj < 2; ++bj) _Pragma("unroll") for (int m = 0; m < 4; ++m) _Pragma("unroll") for (int n = 0; n < 2; ++n) _Pragma("unroll") for (int j = 0; j < 4; ++j) \
    _e[(wr * 64 + m * 16 + fq * 4 + j) * EP_LD + bj * 128 + wc * 32 + n * 16 + fr] = acc[ai][bj][m][n][j]; } while (0)
#define EPI_ROWS_BEGIN(ai) _Pragma("unroll 4") for (int _it = 0; _it < 16; ++_it) { const int _idx = _it * 512 + tid; const int rl = _idx >> 6, cl = (_idx & 63) * 4; \
    const float4 v = *(const float4*)((const float*)smem + rl * EP_LD + cl); const int row = browz + (ai) * 128 + rl; const int col = bcol + cl; (void)row; (void)col;
#define EPI_ROWS_END }
DI uint2 pk4(float a, float b, float c, float d) { uint2 o; o.x = pk2(a, b); o.y = pk2(c, d); return o; }

DI void sgemm16(const int lane, const u16* __restrict__ A, int lda, const u16* __restrict__ Bt, int ldb, int K, int bc0, int bc1, f32x4& c0, f32x4& c1) {
  const int fr = lane & 15, fq = lane >> 4;
  const u16* ap = A + (long)fr * lda + fq * 8;
  const u16* b0 = Bt + (long)(bc0 + fr) * ldb + fq * 8; const u16* b1 = Bt + (long)(bc1 + fr) * ldb + fq * 8;
  c0 = f32x4{0.f, 0.f, 0.f, 0.f}; c1 = c0;
#pragma unroll 8
  for (int k = 0; k < K; k += 32) { const bf16x8 a = *(const bf16x8*)(ap + k), x = *(const bf16x8*)(b0 + k), y = *(const bf16x8*)(b1 + k);
    c0 = __builtin_amdgcn_mfma_f32_16x16x32_bf16(a, x, c0, 0, 0, 0); c1 = __builtin_amdgcn_mfma_f32_16x16x32_bf16(a, y, c1, 0, 0, 0); }
}
DI void inproj_store_s(KP p, int l, int row, int col, float v) {
  unsigned char* ws = p->ws; u16* proj = (u16*)(ws + WS_PROJ);
  const int rs = row - MP;
  if (col >= PC_G) proj[(long)row * NPJ + col] = f2bf(sigm(v));
  else if (col >= PC_QD && col < PC_KD) proj[(long)row * NPJ + col] = f2bf(v * QD_SCALE);
  else if (col >= PC_KD && col < PC_VD) { const int hv = col - PC_KD; p->out[O_SDK + (long)l * MS * 512 + rs * 512 + hv] = v;
    ((u16*)(ws + WS_KDS))[((long)(rs >> 4) * SKP + PAST + (rs & 15)) * 512 + hv] = f2bf(v); }
  else if (col >= PC_VD && col < PC_ZD) { const int hv = col - PC_VD; p->out[O_SDV + (long)l * MS * 512 + rs * 512 + hv] = v;
    ((u16*)(ws + WS_VDTS))[((long)(rs >> 4) * 512 + hv) * SKP + kperm(PAST + (rs & 15))] = f2bf(v); }
  else proj[(long)row * NPJ + col] = f2bf(v);
}

template <bool PERM> DI void transpose_tile(const int TID, const float* __restrict__ src, long ld_s, u16* __restrict__ dst, long ld_d, int r0, int c0, int drow0) {
  u16* tl = (u16*)smem;
  const int tid = TID;
  { int rr = tid >> 3, cc = (tid & 7) * 4; float4 v = *(const float4*)(src + (long)(r0 + rr) * ld_s + c0 + cc);
    tl[(cc + 0) * 72 + rr] = f2bf(v.x); tl[(cc + 1) * 72 + rr] = f2bf(v.y); tl[(cc + 2) * 72 + rr] = f2bf(v.z); tl[(cc + 3) * 72 + rr] = f2bf(v.w); }
  __syncthreads();
  if (tid < 256) { int cc = tid >> 3, rr = (tid & 7) * 8; uint4 v = *(const uint4*)(tl + cc * 72 + rr);
    if (PERM) { u16* d = dst + (long)(drow0 + cc) * ld_d; *(uint2*)(d + kperm(r0 + rr)) = uint2{v.x, v.y}; *(uint2*)(d + kperm(r0 + rr + 4)) = uint2{v.z, v.w}; }
    else *(uint4*)(dst + (long)(drow0 + cc) * ld_d + r0 + rr) = v; }
  __syncthreads();
}

DI void rmsnorm_rows_to_bf16(const int TID, KP p, int l) {
  const int lane = TID & 63, wid = TID >> 6;
  const float* g = p->in[8] + l * D;
  u16* xn = (u16*)(p->ws + WS_XN);
  for (int row = blockIdx.x * 8 + wid; row < M; row += gridDim.x * 8) {
    const float* src = (l == 0) ? (row < MP ? p->in[0] + (long)row * D : p->in[1] + (long)(row - MP) * D) : p->out + (long)row * D;
    float4 v[4]; float ss = 0.f;
#pragma unroll
    for (int i = 0; i < 4; ++i) { v[i] = *(const float4*)(src + i * 256 + lane * 4); ss += v[i].x * v[i].x + v[i].y * v[i].y + v[i].z * v[i].z + v[i].w * v[i].w; }
    ss = wsum(ss); const float rs = rsqrtf(ss * (1.f / D) + EPS);
#pragma unroll
    for (int i = 0; i < 4; ++i) { float4 gg = *(const float4*)(g + i * 256 + lane * 4);
      uint2 o; o.x = pk2(v[i].x * rs * gg.x, v[i].y * rs * gg.y); o.y = pk2(v[i].z * rs * gg.z, v[i].w * rs * gg.w);
      *(uint2*)(xn + (long)row * D + i * 256 + lane * 4) = o; }
  }
}

DI void prep_phase(const int TID, KP p, int l) {
  const int tid = TID, G = gridDim.x, bx = blockIdx.x;
  const long gtid = (long)bx * 512 + tid, gn = (long)G * 512;
  unsigned char* ws = p->ws;
  rmsnorm_rows_to_bf16(TID, p, l);
  { const float* w = p->in[9] + (long)l * 1024 * NIN; u16* d = (u16*)(ws + WS_WIN);
    for (int i = bx; i < 16 * 221; i += G) { int kt = i & 15, ct = i >> 4, c0 = ct * 32; transpose_tile<false>(TID, w, NIN, d, 1024, kt * 64, c0, c0 < 416 ? c0 : c0 + 96); }
    for (long i = gtid; i < 96 * 1024 / 8; i += gn) { const unsigned z = (unsigned)TID >> 31; ((uint4*)(d + 416 * 1024))[i] = uint4{z, z, z, z}; } }
  for (int b = 0; b < 3; ++b) { const float* w = p->in[27 + b] + (long)l * 512 * 1024; u16* d = (u16*)(ws + WS_WO) + (long)b * 1024 * 512;
    for (int i = bx; i < 8 * 32; i += G) { int rt = i & 7, ct = i >> 3; transpose_tile<false>(TID, w, 1024, d, 512, rt * 64, ct * 32, ct * 32); } }
  { const float* w = p->in[30] + (long)l * 1024 * 1024; u16* d = (u16*)(ws + WS_WOUT);
    for (int i = bx; i < 16 * 32; i += G) { int rt = i & 15, ct = i >> 4; transpose_tile<false>(TID, w, 1024, d, 1024, rt * 64, ct * 32, ct * 32); } }
  { const float* c = p->in[2] + (long)l * 8 * PAST * 128; u16* d = (u16*)(ws + WS_CKVTS);
    for (int i = bx; i < 8 * 32 * 4; i += G) { int sb = i >> 7, r = i & 127, rt = r & 31, ct = r >> 5;
      transpose_tile<true>(TID, c + (long)sb * PAST * 128, 128, d + (long)sb * 128 * SKP, SKP, rt * 64, ct * 32, ct * 32); } }
  { const float* c = p->in[5] + (long)l * 8 * PAST * 512; u16* d = (u16*)(ws + WS_VDTS);
    for (int i = bx; i < 8 * 32 * 16; i += G) { int sb = i >> 9, r = i & 511, rt = r & 31, ct = r >> 5;
      transpose_tile<true>(TID, c + (long)sb * PAST * 512, 512, d + (long)sb * 512 * SKP, SKP, rt * 64, ct * 32, ct * 32); } }
  { const float* c = p->in[2] + (long)l * 8 * PAST * 128; u16* d = (u16*)(ws + WS_CKVS);
    for (long i = gtid; i < 8L * PAST * 128 / 4; i += gn) { long e = i * 4; int sb = (int)(e / (PAST * 128)); long r = e - (long)sb * PAST * 128;
      float4 v = *(const float4*)(c + e); uint2 o; o.x = pk2(v.x, v.y); o.y = pk2(v.z, v.w); *(uint2*)(d + (long)sb * SKP * 128 + r) = o; } }
  { const float* c = p->in[3] + (long)l * 8 * PAST * 32; u16* d = (u16*)(ws + WS_KRS);
    for (long i = gtid; i < 8L * PAST * 32 / 4; i += gn) { long e = i * 4; int sb = (int)(e / (PAST * 32)); long r = e - (long)sb * PAST * 32;
      float4 v = *(const float4*)(c + e); uint2 o; o.x = pk2(v.x, v.y); o.y = pk2(v.z, v.w); *(uint2*)(d + (long)sb * SKP * 32 + r) = o; } }
  { const float* c = p->in[4] + (long)l * 8 * PAST * 512; u16* d = (u16*)(ws + WS_KDS);
    for (long i = gtid; i < 8L * PAST * 512 / 4; i += gn) { long e = i * 4; int sb = (int)(e / (PAST * 512)); long r = e - (long)sb * PAST * 512;
      float4 v = *(const float4*)(c + e); uint2 o; o.x = pk2(v.x, v.y); o.y = pk2(v.z, v.w); *(uint2*)(d + (long)sb * SKP * 512 + r) = o; } }
  for (long i = gtid; i < 8L * 48 * 128; i += gn) { int sb = (int)(i / (48 * 128)); int r = (int)(i % (48 * 128)); ((u16*)(ws + WS_CKVS))[((long)sb * SKP + SK) * 128 + r] = 0; }
  for (long i = gtid; i < 8L * 48 * 32; i += gn) { int sb = (int)(i / (48 * 32)); int r = (int)(i % (48 * 32)); ((u16*)(ws + WS_KRS))[((long)sb * SKP + SK) * 32 + r] = 0; }
  for (long i = gtid; i < 8L * 48 * 512; i += gn) { int sb = (int)(i / (48 * 512)); int r = (int)(i % (48 * 512)); ((u16*)(ws + WS_KDS))[((long)sb * SKP + SK) * 512 + r] = 0; }
  for (long i = gtid; i < 8L * 128 * 48; i += gn) { int rw = (int)(i / 48), k = (int)(i % 48); ((u16*)(ws + WS_CKVTS))[(long)rw * SKP + SK + k] = 0; }
  for (long i = gtid; i < 8L * 512 * 48; i += gn) { int rw = (int)(i / 48), k = (int)(i % 48); ((u16*)(ws + WS_VDTS))[(long)rw * SKP + SK + k] = 0; }
  { const float* uq = p->in[12] + (long)l * 256 * 768; const float* uk = p->in[13] + (long)l * 128 * 512; u16* d = (u16*)(ws + WS_WQ);
    for (long i = gtid; i < 1280L * 256; i += gn) { int n = (int)(i >> 8), r = (int)(i & 255); float s;
      if (n < 1024) { int hd = n >> 7, c = n & 127; const float* a = uq + r * 768 + hd * 96; const float* b = uk + c * 512 + hd * 64; s = 0.f;
        for (int dd = 0; dd < 64; dd += 4) { float4 x = *(const float4*)(a + dd), y = *(const float4*)(b + dd); s += x.x * y.x + x.y * y.y + x.z * y.z + x.w * y.w; } }
      else { int hd = (n - 1024) >> 5, j = (n - 1024) & 31; s = uq[r * 768 + hd * 96 + 64 + j]; }
      d[i] = f2bf(s); } }
  { const float* uv = p->in[14] + (long)l * 128 * 512; u16* d = (u16*)(ws + WS_WUV);
    for (long i = gtid; i < 512L * 512; i += gn) { int n = (int)(i >> 9), kk = (int)(i & 511); int hd = n >> 6, v = n & 63, hk = (n >> 8) * 4 + (kk >> 7), c = kk & 127;
      d[i] = (hk == hd) ? f2bf(uv[c * 512 + hd * 64 + v]) : (u16)0; } }
  { const float* wa = p->in[22] + (long)l * 8 * 4096; const float* wx = p->in[24] + (long)l * 8 * 4096; u16* d = (u16*)(ws + WS_WLRU);
    for (long i = gtid; i < 1024L * 256; i += gn) { int nn = (int)(i >> 8), kk = (int)(i & 255); int pn = nn >> 8, nl = nn & 255; int f = pn * 128 + (nl & 127);
      int blk = f >> 6, o = f & 63, bk = (pn >> 1) * 4 + (kk >> 6), ii = kk & 63; const float* w = (nl < 128) ? wa : wx;
      d[i] = (bk == blk) ? f2bf(w[blk * 4096 + ii * 64 + o]) : (u16)0; } }
  if (bx == 0 && tid == 0) {
    float s1 = 0.f, s2 = 0.f;
    for (int i = 0; i < 32; ++i) { s1 += p->in[15][l * 32 + i] * p->in[16][l * 32 + i]; s2 += p->in[17][l * 32 + i] * p->in[18][l * 32 + i]; }
    const float lam_init = 0.8f - 0.6f * expf(-0.3f * (float)l);
    float* sc = (float*)(ws + WS_CTL + 1024);
    sc[l * 2 + 0] = expf(s1) - expf(s2) + lam_init; sc[l * 2 + 1] = lam_init;
  }
  if (l == 0) {
    float2* tab = (float2*)(ws + WS_ROPE);
    for (long i = gtid; i < 4096 * 16; i += gn) { int pos = (int)(i >> 4), j = (int)(i & 15);
      const float a = (float)pos * g_invf[j];
      const float k = rintf(a * 0.63661977236758134f);
      float y = fmaf(-k, 1.5707963109016418f, a); y = fmaf(-k, 1.5893254712295857e-08f, y); y = fmaf(-k, 6.0770999344e-16f, y);
      const float y2 = y * y;
      const float sn = y * (1.f + y2 * (-1.6666667163e-01f + y2 * (8.3333337680e-03f + y2 * (-1.9841270114e-04f + y2 * 2.7557314297e-06f))));
      const float cs = 1.f + y2 * (-0.5f + y2 * (4.1666667908e-02f + y2 * (-1.3888889225e-03f + y2 * (2.4801587642e-05f + y2 * -2.7557314297e-07f))));
      const int q = ((int)k) & 3;
      const float c2 = (q == 0) ? cs : (q == 1) ? -sn : (q == 2) ? -cs : sn;
      const float s2 = (q == 0) ? sn : (q == 1) ? cs : (q == 2) ? -sn : -cs;
      tab[i] = float2{c2, s2}; }
  }
}

DI void inproj_phase(const int TID_in, KP p, int l, int vid) {
  const int wv = __builtin_amdgcn_readfirstlane(TID_in >> 6);
  unsigned char* ws = p->ws;
  f32x4 acc[2][2][4][2];
  for (int tile = vid; tile < 64 * 28; tile += gridDim.x) {
    int pm, pn; tile_coords(tile, 64, 28, pm, pn);
    const int brow = pm * 256, bcol = pn * 256;
    gemm_kloop8(fresh_tid(wv), (const u16*)(ws + WS_XN) + (long)brow * 1024, 1024, (const u16*)(ws + WS_WIN) + (long)bcol * 1024, 1024, 16, acc);
    const int TID = fresh_tid(wv);
    GEMM_IDS
    const int oz = opaque_zero(); const int browz = brow + oz;
    u16* proj = (u16*)(ws + WS_PROJ) + oz;
#pragma unroll
    for (int ai = 0; ai < 2; ++ai) {
      ACC_TO_LDS(ai);
      __syncthreads();
      if (pn >= 16) {
        EPI_ROWS_BEGIN(ai) *(uint2*)(proj + (long)row * NPJ + col) = pk4(sigm(v.x), sigm(v.y), sigm(v.z), sigm(v.w)); EPI_ROWS_END
      } else if (pn == 4 || pn == 5) {
        EPI_ROWS_BEGIN(ai) *(uint2*)(proj + (long)row * NPJ + col) = pk4(v.x * QD_SCALE, v.y * QD_SCALE, v.z * QD_SCALE, v.w * QD_SCALE); EPI_ROWS_END
      } else if (pn == 6 || pn == 7) {
        u16* kds = (u16*)(ws + WS_KDS) + oz;
        EPI_ROWS_BEGIN(ai)
          const int hv = col - PC_KD; const uint2 pk = pk4(v.x, v.y, v.z, v.w);
          *(uint2*)(proj + (long)row * NPJ + col) = pk;
          if (row < MP) *(float4*)(p->out + O_PDK + (long)l * MP * 512 + (long)row * 512 + hv) = v;
          else if (row < M) { const int rs = row - MP; *(float4*)(p->out + O_SDK + (long)l * MS * 512 + rs * 512 + hv) = v;
            *(uint2*)(kds + ((long)(rs >> 4) * SKP + PAST + (rs & 15)) * 512 + hv) = pk; }
        EPI_ROWS_END
      } else if (pn == 8 || pn == 9) {
        EPI_ROWS_BEGIN(ai)
          const int hv = col - PC_VD;
          if (row < MP) *(float4*)(p->out + O_PDV + (long)l * MP * 512 + (long)row * 512 + hv) = v;
          else if (row < M) *(float4*)(p->out + O_SDV + (long)l * MS * 512 + (row - MP) * 512 + hv) = v;
        EPI_ROWS_END
        u16* vtp = (u16*)(ws + WS_VDTP) + oz; u16* vts = (u16*)(ws + WS_VDTS) + oz;
#pragma unroll 4
        for (int it = 0; it < 16; ++it) { const int idx = it * 512 + tid; const int cl = idx & 255, r4 = (idx >> 8) * 4;
          const float* e = (const float*)smem + r4 * EP_LD + cl;
          const uint2 pk = pk4(e[0], e[EP_LD], e[2 * EP_LD], e[3 * EP_LD]);
          const int row0 = browz + ai * 128 + r4, hv = bcol + cl - PC_VD;
          if (row0 < MP) *(uint2*)(vtp + ((long)(row0 >> 12) * 512 + hv) * TP + kperm(row0 & (TP - 1))) = pk;
          else if (row0 < M) { const int rs = row0 - MP; *(uint2*)(vts + ((long)(rs >> 4) * 512 + hv) * SKP + kperm(PAST + (rs & 15))) = pk; } }
      } else {
        EPI_ROWS_BEGIN(ai) *(uint2*)(proj + (long)row * NPJ + col) = pk4(v.x, v.y, v.z, v.w); EPI_ROWS_END
      }
      __syncthreads();
    }
  }
  const int TID = fresh_tid(wv);
  GEMM_IDS
  for (int it = (int)gridDim.x - 1 - vid; it < 8 * 28; it += gridDim.x) {
    const int rg = it & 7, pn = it >> 3; const int row0 = MP + rg * 16, bcol = pn * 256;
    f32x4 c0, c1;
    sgemm16(lane, (const u16*)(ws + WS_XN) + (long)row0 * 1024, 1024, (const u16*)(ws + WS_WIN) + (long)bcol * 1024, 1024, 1024, wid * 32, wid * 32 + 16, c0, c1);
#pragma unroll
    for (int j = 0; j < 4; ++j) { const int row = row0 + fq * 4 + j; inproj_store_s(p, l, row, bcol + wid * 32 + fr, c0[j]); inproj_store_s(p, l, row, bcol + wid * 32 + 16 + fr, c1[j]); }
  }
}

template <int NR> DI void mid_unit(const int TID, KP p, int l, const int r0) {
  const int tid = TID, lane = tid & 63, wid = tid >> 6;
  unsigned char* ws = p->ws;
  u16* proj = (u16*)(ws + WS_PROJ);
  u16* tl = (u16*)smem;
  const float* gq = p->in[10] + l * 256; const float* gkv = p->in[11] + l * 128;
  const float2* rope = (const float2*)(ws + WS_ROPE);
  const float* cw = p->in[20] + l * 4 * 512; const float* cb = p->in[21] + l * 512;
  u16* xc = (u16*)(ws + WS_XC);
  const int rw0 = r0 + wid * NR;
  const bool pr = rw0 < MP; const int rs0 = rw0 - MP;
  const int b = pr ? (rw0 >> 12) : (rs0 >> 4), t0 = pr ? (rw0 & (TP - 1)) : (rs0 & 15);
  u16* prow0 = proj + (long)rw0 * NPJ;
  {
    uint2 vq[NR]; u32 vk[NR]; float x1[NR], x2[NR];
#pragma unroll
    for (int i = 0; i < NR; ++i) { const u16* pw = prow0 + (long)i * NPJ; vq[i] = *(const uint2*)(pw + PC_CQ + lane * 4); vk[i] = *(const u32*)(pw + PC_CKV + lane * 2);
      x1[i] = bf2f(pw[PC_KR + (lane & 15)]); x2[i] = bf2f(pw[PC_KR + 16 + (lane & 15)]); }
    const float4 g4 = *(const float4*)(gq + lane * 4); const float2 g2 = *(const float2*)(gkv + lane * 2);
#pragma unroll
    for (int i = 0; i < NR; ++i) {
      const int row = rw0 + i, t = t0 + i, pos = pr ? t : PAST + t; const int rs = row - MP;
      u16* prow = prow0 + (long)i * NPJ;
      { float a0 = lo2f(vq[i].x), a1 = hi2f(vq[i].x), a2 = lo2f(vq[i].y), a3 = hi2f(vq[i].y);
        float ss = wsum(a0 * a0 + a1 * a1 + a2 * a2 + a3 * a3); float rsd = rsqrtf(ss * (1.f / 256) + EPS);
        *(uint2*)(prow + PC_CQ + lane * 4) = pk4(a0 * rsd * g4.x, a1 * rsd * g4.y, a2 * rsd * g4.z, a3 * rsd * g4.w); }
      { float a0 = lo2f(vk[i]), a1 = hi2f(vk[i]);
        float ss = wsum(a0 * a0 + a1 * a1); float rsd = rsqrtf(ss * (1.f / 128) + EPS);
        float y0 = a0 * rsd * g2.x, y1 = a1 * rsd * g2.y;
        float* so = pr ? p->out + O_PCKV + (long)l * MP * 128 + (long)row * 128 : p->out + O_SCKV + (long)l * MS * 128 + rs * 128;
        *(float2*)(so + lane * 2) = float2{y0, y1};
        u32 pk = pk2(y0, y1);
        u16* kb = pr ? (u16*)(ws + WS_CKVP) + (long)row * 128 : (u16*)(ws + WS_CKVS) + ((long)b * SKP + PAST + t) * 128;
        *(u32*)(kb + lane * 2) = pk;
        tl[(lane * 2) * 72 + wid * NR + i] = (u16)(pk & 0xffff); tl[(lane * 2 + 1) * 72 + wid * NR + i] = (u16)(pk >> 16); }
      if (lane < 16) {
        float2 cs = rope[pos * 16 + lane];
        float o1 = x1[i] * cs.x - x2[i] * cs.y, o2 = x2[i] * cs.x + x1[i] * cs.y;
        float* so = pr ? p->out + O_PKR + (long)l * MP * 32 + (long)row * 32 : p->out + O_SKR + (long)l * MS * 32 + rs * 32;
        so[lane] = o1; so[lane + 16] = o2;
        u16* kb = pr ? (u16*)(ws + WS_KRP) + (long)row * 32 : (u16*)(ws + WS_KRS) + ((long)b * SKP + PAST + t) * 32;
        kb[lane] = f2bf(o1); kb[lane + 16] = f2bf(o2); }
    }
  }
  {
    const int f = lane * 8;
    uint4 xin[NR + 3];
#pragma unroll
    for (int k = 0; k < NR + 3; ++k) {
      const int tt = t0 + k - 3;
      if (tt >= 0) xin[k] = *(const uint4*)(prow0 + (long)(k - 3) * NPJ + PC_XL + f);
      else if (!pr) { const float* c0 = p->in[7] + (((long)l * 8 + b) * 3 + (tt + 3)) * 512 + f; float4 u0 = *(const float4*)c0, u1 = *(const float4*)(c0 + 4);
        xin[k] = uint4{pk2(u0.x, u0.y), pk2(u0.z, u0.w), pk2(u1.x, u1.y), pk2(u1.z, u1.w)}; }
      else xin[k] = uint4{0u, 0u, 0u, 0u};
    }
    float4 w[4][2];
#pragma unroll
    for (int k = 0; k < 4; ++k) { w[k][0] = *(const float4*)(cw + k * 512 + f); w[k][1] = *(const float4*)(cw + k * 512 + f + 4); }
    const float4 b0 = *(const float4*)(cb + f), b1 = *(const float4*)(cb + f + 4);
    const int T = pr ? TP : TS;
#pragma unroll
    for (int i = 0; i < NR; ++i) {
      float a[8] = {b0.x, b0.y, b0.z, b0.w, b1.x, b1.y, b1.z, b1.w};
#pragma unroll
      for (int k = 0; k < 4; ++k) { const uint4 v = xin[i + k];
        a[0] += lo2f(v.x) * w[k][0].x; a[1] += hi2f(v.x) * w[k][0].y; a[2] += lo2f(v.y) * w[k][0].z; a[3] += hi2f(v.y) * w[k][0].w;
        a[4] += lo2f(v.z) * w[k][1].x; a[5] += hi2f(v.z) * w[k][1].y; a[6] += lo2f(v.w) * w[k][1].z; a[7] += hi2f(v.w) * w[k][1].w; }
      *(uint4*)(xc + (long)(rw0 + i) * 512 + f) = uint4{pk2(a[0], a[1]), pk2(a[2], a[3]), pk2(a[4], a[5]), pk2(a[6], a[7])};
      const int t = t0 + i;
      if (t >= T - 3) { const uint4 v = xin[i + 3];
        float* so = pr ? p->out + O_PCV + (((long)l * 4 + b) * 3 + (t - (T - 3))) * 512 + f : p->out + O_SCV + (((long)l * 8 + b) * 3 + (t - (T - 3))) * 512 + f;
        *(float4*)so = float4{lo2f(v.x), hi2f(v.x), lo2f(v.y), hi2f(v.y)}; *(float4*)(so + 4) = float4{lo2f(v.z), hi2f(v.z), lo2f(v.w), hi2f(v.w)}; }
    }
  }
  __syncthreads();
  for (int id = tid; id < 128 * NR; id += 512) { const int c = id / NR, rg = id % NR; const int row = r0 + rg * 8;
    uint4 v = *(const uint4*)(tl + c * 72 + rg * 8);
    u16* dbase = (row < MP) ? (u16*)(ws + WS_CKVTP) + ((long)(row >> 12) * 128 + c) * TP : (u16*)(ws + WS_CKVTS) + ((long)((row - MP) >> 4) * 128 + c) * SKP;
    const int key = (row < MP) ? (row & (TP - 1)) : PAST + ((row - MP) & 15);
    *(uint2*)(dbase + kperm(key)) = uint2{v.x, v.y}; *(uint2*)(dbase + kperm(key + 4)) = uint2{v.z, v.w}; }
  __syncthreads();
}
DI void mid_phase(const int TID, KP p, int l) {
  for (int u = blockIdx.x; u < 256 + 16; u += gridDim.x) {
    if (u < 256) mid_unit<8>(TID, p, l, u * 64);
    else mid_unit<1>(TID, p, l, MP + (u - 256) * 8);
  }
}

DI void qlru_phase(const int TID_in, KP p, int l, int vid) {
  const int wv = __builtin_amdgcn_readfirstlane(TID_in >> 6);
  unsigned char* ws = p->ws;
  f32x4 acc[2][2][4][2];
  for (int tile = vid; tile < 64 * 9; tile += gridDim.x) {
    if (tile < 64 * 5) {
      int pm, pn; tile_coords(tile, 64, 5, pm, pn);
      const int brow = pm * 256, bcol = pn * 256;
      gemm_kloop8(fresh_tid(wv), (const u16*)(ws + WS_PROJ) + (long)brow * NPJ + PC_CQ, NPJ, (const u16*)(ws + WS_WQ) + (long)bcol * 256, 256, 4, acc);
      const int TID = fresh_tid(wv);
      GEMM_IDS
      const int oz = opaque_zero(); const int browz = brow + oz;
      u16* qm = (u16*)(ws + WS_QMLA) + oz;
#pragma unroll
      for (int ai = 0; ai < 2; ++ai) {
        ACC_TO_LDS(ai);
        __syncthreads();
        if (pn < 4) {
          EPI_ROWS_BEGIN(ai) *(uint2*)(qm + (long)row * 1280 + col) = pk4(v.x * QM_SCALE, v.y * QM_SCALE, v.z * QM_SCALE, v.w * QM_SCALE); EPI_ROWS_END
        } else {
          const float2* rope = (const float2*)(ws + WS_ROPE) + oz;
#pragma unroll 2
          for (int it = 0; it < 8; ++it) { const int idx = it * 512 + tid; const int rl = idx >> 5, hd = (idx >> 2) & 7, j4 = (idx & 3) * 4;
            const int row = browz + ai * 128 + rl;
            if (row < M) {
              const float* e = (const float*)smem + rl * EP_LD + hd * 32 + j4;
              const float4 x1 = *(const float4*)e, x2 = *(const float4*)(e + 16);
              const float4 c01 = *(const float4*)(rope + row_pos(row) * 16 + j4), c23 = *(const float4*)(rope + row_pos(row) * 16 + j4 + 2);
              u16* q = qm + (long)row * 1280 + 1024 + hd * 32 + j4;
              *(uint2*)q = pk4((x1.x * c01.x - x2.x * c01.y) * QM_SCALE, (x1.y * c01.z - x2.y * c01.w) * QM_SCALE, (x1.z * c23.x - x2.z * c23.y) * QM_SCALE, (x1.w * c23.z - x2.w * c23.w) * QM_SCALE);
              *(uint2*)(q + 16) = pk4((x2.x * c01.x + x1.x * c01.y) * QM_SCALE, (x2.y * c01.z + x1.y * c01.w) * QM_SCALE, (x2.z * c23.x + x1.z * c23.y) * QM_SCALE, (x2.w * c23.z + x1.w * c23.w) * QM_SCALE); } }
        }
        __syncthreads();
      }
    } else {
      int pm, pn; tile_coords(tile - 64 * 5, 64, 4, pm, pn);
      const int brow = pm * 256;
      gemm_kloop8(fresh_tid(wv), (const u16*)(ws + WS_XC) + (long)brow * 512 + (pn >> 1) * 256, 512, (const u16*)(ws + WS_WLRU) + (long)pn * 256 * 256, 256, 4, acc);
      const int TID = fresh_tid(wv);
      GEMM_IDS
      const int oz = opaque_zero(); const int browz = brow + oz;
      const u16* xc = (const u16*)(ws + WS_XC) + oz;
      float* ab = (float*)(ws + WS_A) + oz; float* bb = (float*)(ws + WS_B) + oz;
      float spv[4], baa[4], bxa[4];
      { const int f = pn * 128 + (tid & 31) * 4;
        const float4 lb = *(const float4*)(p->in[26] + l * 512 + f), bav = *(const float4*)(p->in[23] + l * 512 + f), bxv = *(const float4*)(p->in[25] + l * 512 + f);
        spv[0] = softplus_f(-lb.x); spv[1] = softplus_f(-lb.y); spv[2] = softplus_f(-lb.z); spv[3] = softplus_f(-lb.w);
        baa[0] = bav.x; baa[1] = bav.y; baa[2] = bav.z; baa[3] = bav.w; bxa[0] = bxv.x; bxa[1] = bxv.y; bxa[2] = bxv.z; bxa[3] = bxv.w; }
#pragma unroll
      for (int ai = 0; ai < 2; ++ai) {
        ACC_TO_LDS(ai);
        __syncthreads();
#pragma unroll 2
        for (int it = 0; it < 8; ++it) { const int idx = it * 512 + tid; const int rl = idx >> 5, f4 = (idx & 31) * 4;
          const int row = browz + ai * 128 + rl;
          if (row < M) {
            const float* e = (const float*)smem + rl * EP_LD + f4;
            const float4 ra = *(const float4*)e, rx = *(const float4*)(e + 128);
            const int f = pn * 128 + f4;
            const uint2 xv = *(const uint2*)(xc + (long)row * 512 + f);
            const bool first = (row < MP) && ((row & (TP - 1)) == 0);
            float av[4], bv[4];
            const float raa[4] = {ra.x, ra.y, ra.z, ra.w}, rxa[4] = {rx.x, rx.y, rx.z, rx.w};
            const float xca[4] = {lo2f(xv.x), hi2f(xv.x), lo2f(xv.y), hi2f(xv.y)};
#pragma unroll
            for (int k = 0; k < 4; ++k) { const float sp = spv[k];
              const float r = sigm(raa[k] + baa[k]), ii = sigm(rxa[k] + bxa[k]); const float la = -8.f * r * sp;
              av[k] = __expf(la); const float mult = first ? 1.f : sqrtf(neg_expm1(2.f * la)); bv[k] = mult * ii * xca[k]; }
            *(float4*)(ab + (long)row * 512 + f) = float4{av[0], av[1], av[2], av[3]};
            *(float4*)(bb + (long)row * 512 + f) = float4{bv[0], bv[1], bv[2], bv[3]}; } }
        __syncthreads();
      }
    }
  }
  const int TID = fresh_tid(wv);
  GEMM_IDS
  for (int it = (int)gridDim.x - 1 - vid; it < 8 * 9; it += gridDim.x) {
    const int rg = it & 7, pn = it >> 3; const int row0 = MP + rg * 16;
    f32x4 c0, c1;
    if (pn < 5) {
      const int bcol = pn * 256;
      sgemm16(lane, (const u16*)(ws + WS_PROJ) + (long)row0 * NPJ + PC_CQ, NPJ, (const u16*)(ws + WS_WQ) + (long)bcol * 256, 256, 256, wid * 32, wid * 32 + 16, c0, c1);
      u16* qm = (u16*)(ws + WS_QMLA);
      if (pn < 4) {
#pragma unroll
        for (int j = 0; j < 4; ++j) { const long row = row0 + fq * 4 + j; qm[row * 1280 + bcol + wid * 32 + fr] = f2bf(c0[j] * QM_SCALE); qm[row * 1280 + bcol + wid * 32 + 16 + fr] = f2bf(c1[j] * QM_SCALE); }
      } else {
        const float2* rope = (const float2*)(ws + WS_ROPE);
#pragma unroll
        for (int j = 0; j < 4; ++j) { const int row = row0 + fq * 4 + j; const float2 cs = rope[row_pos(row) * 16 + fr];
          qm[(long)row * 1280 + 1024 + wid * 32 + fr] = f2bf((c0[j] * cs.x - c1[j] * cs.y) * QM_SCALE);
          qm[(long)row * 1280 + 1024 + wid * 32 + 16 + fr] = f2bf((c1[j] * cs.x + c0[j] * cs.y) * QM_SCALE); }
      }
    } else {
      const int pl = pn - 5;
      const u16* xc = (const u16*)(ws + WS_XC);
      sgemm16(lane, xc + (long)row0 * 512 + (pl >> 1) * 256, 512, (const u16*)(ws + WS_WLRU) + (long)pl * 256 * 256, 256, 256, wid * 16, 128 + wid * 16, c0, c1);
      const int f = pl * 128 + wid * 16 + fr;
      const float nl = -(p->in[26][l * 512 + f]); const float sp = softplus_f(nl);
      const float bav = p->in[23][l * 512 + f], bxv = p->in[25][l * 512 + f];
      float* ab = (float*)(ws + WS_A); float* bb = (float*)(ws + WS_B);
#pragma unroll
      for (int j = 0; j < 4; ++j) { const long row = row0 + fq * 4 + j;
        const float r = sigm(c0[j] + bav), ii = sigm(c1[j] + bxv); const float la = -8.f * r * sp;
        ab[row * 512 + f] = __expf(la); bb[row * 512 + f] = sqrtf(neg_expm1(2.f * la)) * ii * bf2f(xc[row * 512 + f]); }
    }
  }
}

DI void mla_task(const int TID, const u16* __restrict__ qbase, int nq, const u16* __restrict__ kck, const u16* __restrict__ kkr, const u16* __restrict__ vT, int ldv, int nkeys, u16* __restrict__ obase) {
  const int tid = TID, lane = tid & 63, hd = tid >> 6, r = lane & 31, h = lane >> 5;
  const u16* qp = qbase + (long)(r & (nq - 1)) * 1280;
  bf16x8 qf[10];
#pragma unroll
  for (int ks = 0; ks < 8; ++ks) qf[ks] = *(const bf16x8*)(qp + hd * 128 + ks * 16 + h * 8);
#pragma unroll
  for (int ks = 0; ks < 2; ++ks) qf[8 + ks] = *(const bf16x8*)(qp + 1024 + hd * 32 + ks * 16 + h * 8);
  f32x16 O[4];
#pragma unroll
  for (int i = 0; i < 4; ++i)
#pragma unroll
    for (int j = 0; j < 16; ++j) O[i][j] = 0.f;
  float m_run = -1e30f, l_run = 0.f;
  const int nt = (nkeys + 63) >> 6;
  const int wv = __builtin_amdgcn_readfirstlane(hd);
  if (wv >= 4) __builtin_amdgcn_s_setprio(1);
  const char* gp[5]; unsigned ginc[5];
#pragma unroll
  for (int i = 0; i < 5; ++i) {
    int g = wv + 8 * i; if (g > 38) g = 38;
    if (g < 21) { const int o = g * 1024 + lane * 16; const int row = o / 336, wi = o - row * 336;
      if (wi >= 256 && wi < 320) { gp[i] = (const char*)kkr + row * 64 + (wi - 256); ginc[i] = 64 * 64; }
      else { gp[i] = (const char*)kck + row * 256 + (wi < 256 ? wi : 0); ginc[i] = 64 * 256; } }
    else { const int o = (g - 21) * 1024 + lane * 16; const int row = o / 144, wi = o - row * 144;
      gp[i] = (const char*)vT + (long)row * ldv * 2 + (wi < 128 ? wi : 0); ginc[i] = 128; }
  }
#define MLA_ISSUE(buf) do { _Pragma("unroll") for (int i = 0; i < 5; ++i) { int g = wv + 8 * i; if (g > 38) g = 38; \
    __builtin_amdgcn_global_load_lds((const unsigned*)gp[i], (unsigned*)(smem + (buf) * 39936 + g * 1024), 16, 0, 0); gp[i] += ginc[i]; } } while (0)
#define MLA_QK(S, KT, KB) do { bf16x8 kfr[10]; \
    _Pragma("unroll") for (int ks = 0; ks < 10; ++ks) kfr[ks] = *(const bf16x8*)((KT) + ((KB) * 32 + r) * 336 + ks * 32 + h * 16); \
    _Pragma("unroll") for (int ks = 0; ks < 10; ++ks) { \
      if (ks == 0) S = __builtin_amdgcn_mfma_f32_32x32x16_bf16(kfr[ks], qf[ks], negm, 0, 0, 0); else S = __builtin_amdgcn_mfma_f32_32x32x16_bf16(kfr[ks], qf[ks], S, 0, 0, 0); } \
      \
    __builtin_amdgcn_sched_group_barrier(0x100, 5, 0); \
    _Pragma("unroll") for (int i = 0; i < 5; ++i) { __builtin_amdgcn_sched_group_barrier(0x008, 1, 0); __builtin_amdgcn_sched_group_barrier(0x100, 1, 0); } \
    __builtin_amdgcn_sched_group_barrier(0x008, 5, 0); } while (0)
#define MLA_SMPV(S, OTHER, VT, KB, T) do { \
    if (((T) == nt - 1) && (nkeys & 63)) { _Pragma("unroll") for (int j = 0; j < 16; ++j) if ((T) * 64 + (KB) * 32 + crow(j, h) >= nkeys) S[j] = -1e30f; } \
    float mx = S[0]; _Pragma("unroll") for (int j = 1; j < 16; ++j) mx = fmaxf(mx, S[j]); \
    if (first || __builtin_amdgcn_ballot_w64(mx > 8.f) != 0ull) { \
      mx = fmaxf(mx, __shfl_xor(mx, 32)); \
      const float d = first ? mx : fmaxf(mx, 0.f); \
      if (!first) { const float alpha = __builtin_amdgcn_exp2f(-d); l_run *= alpha; \
        _Pragma("unroll") for (int cb = 0; cb < 4; ++cb) _Pragma("unroll") for (int j = 0; j < 16; ++j) O[cb][j] *= alpha; } \
      _Pragma("unroll") for (int j = 0; j < 16; ++j) { S[j] -= d; negm[j] -= d; OTHER[j] -= d; } \
      first = false; } \
    float ls = 0.f; _Pragma("unroll") for (int j = 0; j < 16; ++j) { S[j] = __builtin_amdgcn_exp2f(S[j]); ls += S[j]; } \
    l_run += ls; \
    bf16x8 pk[2]; \
    _Pragma("unroll") for (int s2 = 0; s2 < 2; ++s2) { const uint4 w = uint4{pk2(S[8 * s2], S[8 * s2 + 1]), pk2(S[8 * s2 + 2], S[8 * s2 + 3]), pk2(S[8 * s2 + 4], S[8 * s2 + 5]), pk2(S[8 * s2 + 6], S[8 * s2 + 7])}; pk[s2] = __builtin_bit_cast(bf16x8, w); } \
    bf16x8 vfr[4][2]; \
    _Pragma("unroll") for (int cb = 0; cb < 4; ++cb) _Pragma("unroll") for (int s2 = 0; s2 < 2; ++s2) vfr[cb][s2] = *(const bf16x8*)((VT) + (cb * 32 + r) * 144 + ((KB) * 32 + 16 * s2) * 2 + h * 16); \
    _Pragma("unroll") for (int cb = 0; cb < 4; ++cb) _Pragma("unroll") for (int s2 = 0; s2 < 2; ++s2) O[cb] = __builtin_amdgcn_mfma_f32_32x32x16_bf16(vfr[cb][s2], pk[s2], O[cb], 0, 0, 0); \
    __builtin_amdgcn_sched_group_barrier(0x100, 4, 0); \
    _Pragma("unroll") for (int i = 0; i < 4; ++i) { __builtin_amdgcn_sched_group_barrier(0x008, 1, 0); __builtin_amdgcn_sched_group_barrier(0x100, 1, 0); } \
    __builtin_amdgcn_sched_group_barrier(0x008, 4, 0); } while (0)
  MLA_ISSUE(0);
  if (nt > 1) MLA_ISSUE(1);
  asm volatile("s_waitcnt vmcnt(0)" ::: "memory");
  __builtin_amdgcn_s_barrier();
  f32x16 sA, sB, negm;
#pragma unroll
  for (int j = 0; j < 16; ++j) { negm[j] = 0.f; sB[j] = 0.f; }
  bool first = true;
  MLA_QK(sA, smem, 0);
  int cur = 0;
#pragma unroll 1
  for (int t = 0; t < nt; ++t) {
    const int nx1 = (cur == 2) ? 0 : cur + 1, nx2 = (cur == 0) ? 2 : cur - 1;
    if (t + 2 < nt) MLA_ISSUE(nx2);
    const unsigned char* Kt = smem + cur * 39936; const unsigned char* Vt = Kt + 21504;
    MLA_QK(sB, Kt, 1);
    MLA_SMPV(sA, sB, Vt, 0, t);
    if (t + 1 < nt) MLA_QK(sA, smem + nx1 * 39936, 0);
    MLA_SMPV(sB, sA, Vt, 1, t);
    asm volatile("s_waitcnt vmcnt(0)" ::: "memory");
    asm volatile("s_waitcnt lgkmcnt(0)" ::: "memory");
    __builtin_amdgcn_s_barrier();
    cur = nx1;
  }
  __builtin_amdgcn_s_setprio(0);
  const float lt = l_run + __shfl_xor(l_run, 32); const float inv = 1.f / lt;
  if (r < nq) {
    u16* op = obase + (long)r * 1024 + hd * 128;
#pragma unroll
    for (int cb = 0; cb < 4; ++cb)
#pragma unroll
      for (int g = 0; g < 4; ++g) { uint2 o; o.x = pk2(O[cb][4 * g] * inv, O[cb][4 * g + 1] * inv); o.y = pk2(O[cb][4 * g + 2] * inv, O[cb][4 * g + 3] * inv);
        *(uint2*)(op + cb * 32 + 8 * g + 4 * h) = o; }
  }
}

DI void diff_task(const int TID, const u16* __restrict__ qbase, const u16* __restrict__ zbase, u16* __restrict__ obase, int nq, int qpos0,
                  const u16* __restrict__ kbase, long kstride, const u16* __restrict__ vT, int ldv, int nkeys_total,
                  float lam, float oml, float slope2, const float* __restrict__ subg) {
  const int tid = TID, lane = tid & 63, w = tid >> 6, r = lane & 31, h = lane >> 5;
  const int qw0 = w * 32;
  const bool wactive = qw0 < nq;
  const int qr = (qw0 + r < nq) ? qw0 + r : 0;
  const int wl = (nq - 1) >> 5;
  const int ntmax = (min(nkeys_total, ((qpos0 + wl * 32) / 64 + 1) * 64) + 63) >> 6;
  const int kvis = min(nkeys_total, ((qpos0 + qw0) / 64 + 1) * 64);
  const int ntw = wactive ? ((kvis + 63) >> 6) : 0;
  const u16* qp = qbase + (long)qr * NPJ;
  bf16x8 qf[2][2];
#pragma unroll
  for (int c = 0; c < 2; ++c)
#pragma unroll
    for (int ks = 0; ks < 2; ++ks) qf[c][ks] = *(const bf16x8*)(qp + c * 32 + ks * 16 + h * 8);
  f32x16 O[2][2];
#pragma unroll
  for (int c = 0; c < 2; ++c)
#pragma unroll
    for (int vb = 0; vb < 2; ++vb)
#pragma unroll
      for (int j = 0; j < 16; ++j) O[c][vb][j] = 0.f;
  float m_run[2] = {-1e30f, -1e30f}, l_run[2] = {0.f, 0.f};
  const float qposf = (float)(qpos0 + qw0 + r);
  const float b0q = slope2 * ((float)(4 * h) - qposf);
  const int sr = tid >> 3, sc = tid & 7;
  const unsigned oDK = (unsigned)(sr * (int)kstride * 2 + sc * 16), oDV = (unsigned)(sr * ldv * 2 + sc * 16);
  uint4 g0, g1;
#define DF_GLOAD(t) do { g0 = *(const uint4*)((const char*)(kbase + (long)(t) * 64 * kstride) + oDK); g1 = *(const uint4*)((const char*)(vT + (long)(t) * 64) + oDV); } while (0)
#define DF_LSTORE(s) do { unsigned char* Kt = smem + (s) * 18432; *(uint4*)(Kt + sr * 144 + sc * 16) = g0; *(uint4*)(Kt + 9216 + sr * 144 + sc * 16) = g1; } while (0)
  if (__builtin_amdgcn_readfirstlane(w) >= 4) __builtin_amdgcn_s_setprio(1);
  DF_GLOAD(ntmax - 1); DF_LSTORE((ntmax - 1) & 1);
  __syncthreads();
  for (int t = ntmax - 1; t >= 0; --t) {
    if (t > 0) DF_GLOAD(t - 1);
    if (t < ntw - 1) {
      const unsigned char* Kt = smem + (t & 1) * 18432; const unsigned char* Vt = Kt + 9216;
#pragma unroll 1
      for (int kb = 1; kb >= 0; --kb) {
        bf16x8 vf[2][2];
#pragma unroll
        for (int vb = 0; vb < 2; ++vb)
#pragma unroll
          for (int s2 = 0; s2 < 2; ++s2) vf[vb][s2] = *(const bf16x8*)(Vt + (vb * 32 + r) * 144 + (kb * 32 + 16 * s2) * 2 + h * 16);
        const float dl = slope2 * (float)(t * 64 + kb * 32);
        f32x16 sc[2];
#pragma unroll
        for (int c = 0; c < 2; ++c) { const float u = b0q + dl - m_run[c];
#pragma unroll
          for (int j = 0; j < 16; ++j) sc[c][j] = fmaf(slope2, (float)((j & 3) + 8 * (j >> 2)), u); }
        bf16x8 kfr[2][2];
#pragma unroll
        for (int ks = 0; ks < 2; ++ks)
#pragma unroll
          for (int c = 0; c < 2; ++c) kfr[ks][c] = *(const bf16x8*)(Kt + (kb * 32 + r) * 144 + (c * 32 + ks * 16 + h * 8) * 2);
#pragma unroll
        for (int ks = 0; ks < 2; ++ks)
#pragma unroll
          for (int c = 0; c < 2; ++c) sc[c] = __builtin_amdgcn_mfma_f32_32x32x16_bf16(kfr[ks][c], qf[c][ks], sc[c], 0, 0, 0);
        __builtin_amdgcn_sched_group_barrier(0x100, 8, 0);
        __builtin_amdgcn_sched_group_barrier(0x008, 4, 0);
#pragma unroll
        for (int c = 0; c < 2; ++c) {
          float mx = sc[c][0];
#pragma unroll
          for (int j = 1; j < 16; ++j) mx = fmaxf(mx, sc[c][j]);
          if (__builtin_amdgcn_ballot_w64(mx > 8.f) != 0ull) {
            mx = fmaxf(mx, __shfl_xor(mx, 32));
            const float d = fmaxf(mx, 0.f); const float alpha = __builtin_amdgcn_exp2f(-d); m_run[c] += d; l_run[c] *= alpha;
#pragma unroll
            for (int vb = 0; vb < 2; ++vb)
#pragma unroll
              for (int j = 0; j < 16; ++j) O[c][vb][j] *= alpha;
#pragma unroll
            for (int j = 0; j < 16; ++j) sc[c][j] -= d;
          }
          float ls = 0.f;
#pragma unroll
          for (int j = 0; j < 16; ++j) { sc[c][j] = __builtin_amdgcn_exp2f(sc[c][j]); ls += sc[c][j]; }
          l_run[c] += ls;
#pragma unroll
          for (int s2 = 0; s2 < 2; ++s2) { const uint4 wv = uint4{pk2(sc[c][8 * s2], sc[c][8 * s2 + 1]), pk2(sc[c][8 * s2 + 2], sc[c][8 * s2 + 3]), pk2(sc[c][8 * s2 + 4], sc[c][8 * s2 + 5]), pk2(sc[c][8 * s2 + 6], sc[c][8 * s2 + 7])};
            const bf16x8 pk = __builtin_bit_cast(bf16x8, wv);
#pragma unroll
            for (int vb = 0; vb < 2; ++vb) O[c][vb] = __builtin_amdgcn_mfma_f32_32x32x16_bf16(vf[vb][s2], pk, O[c][vb], 0, 0, 0); }
        }
      }
    } else if (t < ntw) {
      const unsigned char* Kt = smem + (t & 1) * 18432; const unsigned char* Vt = Kt + 9216;
      const bool partial = (t * 64 + 64 > kvis);
#pragma unroll 1
      for (int kb = 1; kb >= 0; --kb) {
        bf16x8 vf[2][2];
#pragma unroll
        for (int vb = 0; vb < 2; ++vb)
#pragma unroll
          for (int s2 = 0; s2 < 2; ++s2) vf[vb][s2] = *(const bf16x8*)(Vt + (vb * 32 + r) * 144 + (kb * 32 + 16 * s2) * 2 + h * 16);
        const float kb0 = (float)(t * 64 + kb * 32 + 4 * h) - qposf;
#pragma unroll
        for (int c = 0; c < 2; ++c) {
          f32x16 s;
#pragma unroll
          for (int j = 0; j < 16; ++j) s[j] = 0.f;
#pragma unroll
          for (int ks = 0; ks < 2; ++ks) { bf16x8 a = *(const bf16x8*)(Kt + (kb * 32 + r) * 144 + (c * 32 + ks * 16 + h * 8) * 2); s = __builtin_amdgcn_mfma_f32_32x32x16_bf16(a, qf[c][ks], s, 0, 0, 0); }
#pragma unroll
          for (int j = 0; j < 16; ++j) { const float dk = kb0 + (float)((j & 3) + 8 * (j >> 2)); s[j] = fmaf(-slope2, fabsf(dk), s[j]); }
          if (partial) {
#pragma unroll
            for (int j = 0; j < 16; ++j) if (t * 64 + kb * 32 + crow(j, h) >= kvis) s[j] = -1e30f; }
          float mx = s[0];
#pragma unroll
          for (int j = 1; j < 16; ++j) mx = fmaxf(mx, s[j]);
          if (__builtin_amdgcn_ballot_w64(mx > m_run[c] + 8.f) != 0ull) {
            mx = fmaxf(mx, __shfl_xor(mx, 32));
            const float m_new = fmaxf(m_run[c], mx); const float alpha = __builtin_amdgcn_exp2f(m_run[c] - m_new); m_run[c] = m_new;
            l_run[c] *= alpha;
#pragma unroll
            for (int vb = 0; vb < 2; ++vb)
#pragma unroll
              for (int j = 0; j < 16; ++j) O[c][vb][j] *= alpha;
          }
          float ls = 0.f;
#pragma unroll
          for (int j = 0; j < 16; ++j) { s[j] = __builtin_amdgcn_exp2f(s[j] - m_run[c]); ls += s[j]; }
          l_run[c] += ls;
#pragma unroll
          for (int s2 = 0; s2 < 2; ++s2) { u32 w0 = pk2(s[8 * s2], s[8 * s2 + 1]), w1 = pk2(s[8 * s2 + 2], s[8 * s2 + 3]), w2 = pk2(s[8 * s2 + 4], s[8 * s2 + 5]), w3 = pk2(s[8 * s2 + 6], s[8 * s2 + 7]);
            uint4 wv = uint4{w0, w1, w2, w3}; bf16x8 pk = __builtin_bit_cast(bf16x8, wv);
#pragma unroll
            for (int vb = 0; vb < 2; ++vb) O[c][vb] = __builtin_amdgcn_mfma_f32_32x32x16_bf16(vf[vb][s2], pk, O[c][vb], 0, 0, 0); }
          __builtin_amdgcn_sched_barrier(0);
        }
      }
    }
    if (t > 0) DF_LSTORE((t - 1) & 1);
    __syncthreads();
  }
  __builtin_amdgcn_s_setprio(0);
  if (wactive) {
    const float i0 = 1.f / (l_run[0] + __shfl_xor(l_run[0], 32)); const float i1 = lam / (l_run[1] + __shfl_xor(l_run[1], 32));
    float ss = 0.f;
#pragma unroll
    for (int vb = 0; vb < 2; ++vb)
#pragma unroll
      for (int j = 0; j < 16; ++j) { float o = O[0][vb][j] * i0 - O[1][vb][j] * i1; O[0][vb][j] = o; ss += o * o; }
    ss += __shfl_xor(ss, 32);
    const float rsd = rsqrtf(ss * (1.f / 64) + EPS) * oml;
    if (qw0 + r < nq) {
      const u16* zp = zbase + (long)(qw0 + r) * NPJ; u16* op = obase + (long)(qw0 + r) * NPJ;
#pragma unroll
      for (int vb = 0; vb < 2; ++vb)
#pragma unroll
        for (int g = 0; g < 4; ++g) { const int v0 = vb * 32 + 8 * g + 4 * h;
          uint2 z = *(const uint2*)(zp + v0); float4 gg = *(const float4*)(subg + v0);
          float y0 = O[0][vb][4 * g] * rsd * gg.x * silu(lo2f(z.x)), y1 = O[0][vb][4 * g + 1] * rsd * gg.y * silu(hi2f(z.x));
          float y2 = O[0][vb][4 * g + 2] * rsd * gg.z * silu(lo2f(z.y)), y3 = O[0][vb][4 * g + 3] * rsd * gg.w * silu(hi2f(z.y));
          uint2 o; o.x = pk2(y0, y1); o.y = pk2(y2, y3); *(uint2*)(op + v0) = o; }
    }
  }
}

DI void attn_phase(const int TID, KP p, int l, unsigned* ctr) {
  unsigned char* ws = p->ws;
  u16* proj = (u16*)(ws + WS_PROJ);
  const u16* qm = (const u16*)(ws + WS_QMLA);
  u16* olat = (u16*)(ws + WS_XN);
  const float* sc = (const float*)(ws + WS_CTL + 1024);
  const float* subg = p->in[19] + l * 64;
  volatile int* s_task = (volatile int*)(smem + TASK_OFF);
  for (;;) {
    int tid = TID; asm volatile("" : "+v"(tid));
    if (tid == 0) *s_task = (int)atomicAdd(ctr, 1u);
    __syncthreads();
    const int ti = __builtin_amdgcn_readfirstlane(*s_task);
    __syncthreads();
    if (ti >= g_tab.n) break;
    const u32 e = g_tab.t[ti]; const int ty = e >> 16, idx = e & 0xffff;
    if (ty == 0 || ty == 2) {
      const bool pr = (ty == 0);
      const int j = idx >> 5, b = pr ? ((idx >> 3) & 3) : (idx >> 3), hh = idx & 7;
      const long row0 = pr ? (long)b * TP + j * 256 : (long)MP + b * 16;
      const u16* kb = pr ? proj + (long)b * TP * NPJ + PC_KD + hh * 64 : (const u16*)(ws + WS_KDS) + (long)b * SKP * 512 + hh * 64;
      const u16* vt = pr ? (const u16*)(ws + WS_VDTP) + ((long)b * 512 + hh * 64) * TP : (const u16*)(ws + WS_VDTS) + ((long)b * 512 + hh * 64) * SKP;
      const float lam = sc[l * 2], oml = 1.f - sc[l * 2 + 1];
      for (int rep = 0; rep < REP_DIFF; ++rep) {
        diff_task(tid, proj + row0 * NPJ + PC_QD + hh * 64, proj + row0 * NPJ + PC_ZD + hh * 64, proj + row0 * NPJ + PC_VD + hh * 64, pr ? 256 : 16, pr ? j * 256 : PAST,
                kb, pr ? (long)NPJ : 512L, vt, pr ? TP : SKP, pr ? TP : SK, lam, oml, LOG2E * exp2f(-(float)(hh + 1)), subg);
        __syncthreads(); }
    } else if (ty == 1 || ty == 3) {
      const bool pr = (ty == 1);
      const int q32 = idx >> 2, b = pr ? (idx & 3) : idx;
      const long row0 = pr ? (long)b * TP + q32 * 32 : (long)MP + b * 16;
      const u16* kc = pr ? (const u16*)(ws + WS_CKVP) + (long)b * TP * 128 : (const u16*)(ws + WS_CKVS) + (long)b * SKP * 128;
      const u16* kr = pr ? (const u16*)(ws + WS_KRP) + (long)b * TP * 32 : (const u16*)(ws + WS_KRS) + (long)b * SKP * 32;
      const u16* vt = pr ? (const u16*)(ws + WS_CKVTP) + (long)b * 128 * TP : (const u16*)(ws + WS_CKVTS) + (long)b * 128 * SKP;
      for (int rep = 0; rep < REP_MLA; ++rep) {
        mla_task(tid, qm + row0 * 1280, pr ? 32 : 16, kc, kr, vt, pr ? TP : SKP, pr ? (q32 / 2 + 1) * 64 : SK, olat + row0 * 1024);
        __syncthreads(); }
    } else {
      const int b = idx >> 6, c = idx & 63; const long row0 = (long)b * TP + c * 64;
      const float* ab = (const float*)(ws + WS_A) + row0 * 512 + tid; const float* bb = (const float*)(ws + WS_B) + row0 * 512 + tid;
      float A = 1.f, B = 0.f;
#pragma unroll 16
      for (int i = 0; i < 64; ++i) { float a = ab[i * 512], x = bb[i * 512]; B = a * B + x; A *= a; }
      ((float2*)(ws + WS_SCAN))[(long)idx * 512 + tid] = float2{A, B};
    }
    __syncthreads();
  }
}

DI void uvscan_phase(const int TID_in, KP p, int l, int vid) {
  const int wv = __builtin_amdgcn_readfirstlane(TID_in >> 6);
  unsigned char* ws = p->ws;
  u16* proj = (u16*)(ws + WS_PROJ);
  f32x4 acc[2][2][4][2];
  for (int it = vid; it < 64 * 2 + 258 + 16; it += gridDim.x) {
    if (it < 64 * 2) {
      int pm, pn; tile_coords(it, 64, 2, pm, pn);
      const int brow = pm * 256, bcol = pn * 256;
      gemm_kloop8(fresh_tid(wv), (const u16*)(ws + WS_XN) + (long)brow * 1024 + pn * 512, 1024, (const u16*)(ws + WS_WUV) + (long)bcol * 512, 512, 8, acc);
      const int TID = fresh_tid(wv);
      GEMM_IDS
      const int oz = opaque_zero(); const int browz = brow + oz;
      u16* pz = proj + oz;
#pragma unroll
      for (int ai = 0; ai < 2; ++ai) {
        ACC_TO_LDS(ai);
        __syncthreads();
        EPI_ROWS_BEGIN(ai)
          u16* q = pz + (long)row * NPJ + PC_ZMLA + col; const uint2 z = *(const uint2*)q;
          *(uint2*)(q + (PC_QD - PC_ZMLA)) = pk4(v.x * silu(lo2f(z.x)), v.y * silu(hi2f(z.x)), v.z * silu(lo2f(z.y)), v.w * silu(hi2f(z.y)));
        EPI_ROWS_END
        __syncthreads();
      }
    } else {
      const int TID = fresh_tid(wv);
      GEMM_IDS
      const int s = it - 64 * 2;
      if (s >= 258) {
        const int q = s - 258; const int rg = q & 7, pn = q >> 3; const int row0 = MP + rg * 16, bcol = pn * 256;
        f32x4 c0, c1;
        sgemm16(lane, (const u16*)(ws + WS_XN) + (long)row0 * 1024 + pn * 512, 1024, (const u16*)(ws + WS_WUV) + (long)bcol * 512, 512, 512, wid * 32, wid * 32 + 16, c0, c1);
#pragma unroll
        for (int j = 0; j < 4; ++j) { const long row = row0 + fq * 4 + j; u16* q0 = proj + row * NPJ + PC_ZMLA + bcol + wid * 32 + fr;
          q0[PC_QD - PC_ZMLA] = f2bf(c0[j] * silu(bf2f(q0[0]))); q0[PC_QD - PC_ZMLA + 16] = f2bf(c1[j] * silu(bf2f(q0[16]))); }
        continue;
      }
      float hh; long row0; int nsteps; float* hout;
      if (s < 256) { const int b = s >> 6, c = s & 63; row0 = (long)b * TP + c * 64; nsteps = 64; hh = 0.f;
        const float2* sm = (const float2*)(ws + WS_SCAN) + (long)(b * 64) * 512 + tid;
        { int cc = 0;
          for (; cc + 16 <= c; cc += 16) { float2 t[16];
#pragma unroll
            for (int q = 0; q < 16; ++q) t[q] = sm[(long)(cc + q) * 512];
#pragma unroll
            for (int q = 0; q < 16; ++q) hh = t[q].x * hh + t[q].y; }
          for (; cc < c; ++cc) { float2 ab2 = sm[(long)cc * 512]; hh = ab2.x * hh + ab2.y; } }
        hout = (c == 63) ? p->out + O_PH + ((long)l * 4 + b) * 512 + tid : nullptr;
      } else { const int sb = (s - 256) * 4 + 0; (void)sb; row0 = 0; nsteps = 0; hh = 0.f; hout = nullptr; }
      if (s < 256) {
        const float* ab = (const float*)(ws + WS_A) + row0 * 512 + tid; const float* bb = (const float*)(ws + WS_B) + row0 * 512 + tid;
        u16* zp = proj + row0 * NPJ + PC_ZL + tid;
#pragma unroll 16
        for (int i = 0; i < nsteps; ++i) { float a = ab[(long)i * 512], x = bb[(long)i * 512]; float z = bf2f(zp[(long)i * NPJ]); hh = a * hh + x; zp[(long)i * NPJ + (PC_KD - PC_ZL)] = f2bf(hh * silu(z)); }
        if (hout) *hout = hh;
      } else {
        for (int q = 0; q < 4; ++q) { const int sb = (s - 256) * 4 + q; const long r0 = MP + sb * 16;
          float h2 = p->in[6][((long)l * 8 + sb) * 512 + tid];
          const float* ab = (const float*)(ws + WS_A) + r0 * 512 + tid; const float* bb = (const float*)(ws + WS_B) + r0 * 512 + tid;
          u16* zp = proj + r0 * NPJ + PC_ZL + tid;
#pragma unroll 16
          for (int i = 0; i < 16; ++i) { float a = ab[(long)i * 512], x = bb[(long)i * 512]; float z = bf2f(zp[(long)i * NPJ]); h2 = a * h2 + x; zp[(long)i * NPJ + (PC_KD - PC_ZL)] = f2bf(h2 * silu(z)); }
          p->out[O_SH + ((long)l * 8 + sb) * 512 + tid] = h2; }
      }
    }
  }
}

DI void oproj_phase(const int TID, KP p, int l, int vid) {
  GEMM_IDS
  unsigned char* ws = p->ws;
  f32x4 acc[1][2][4][2];
  for (int tile = vid; tile < 128 * 4; tile += gridDim.x) {
    int pm, pn; tile_coords(tile, 128, 4, pm, pn);
    const int brow = pm * 128, bcol = pn * 256;
    float4 mreg[16];
#pragma unroll
    for (int i = 0; i < 16; ++i) mreg[i] = float4{0.f, 0.f, 0.f, 0.f};
#pragma unroll 1
    for (int b = 0; b < 3; ++b) {
      const int acol = (b == 0) ? PC_QD : (b == 1) ? PC_VD : PC_KD;
      gemm_kloop_r3(TID, (const u16*)(ws + WS_PROJ) + (long)brow * NPJ + acol, NPJ, (const u16*)(ws + WS_WO) + ((long)b * 1024 + bcol) * 512, 512, 8, acc);
      const int oz = opaque_zero(); const int browz = brow + oz;
      const u16* gp = (const u16*)(ws + WS_PROJ) + oz + PC_G + b * 1024 + bcol;
      ACC_TO_LDS(0);
      __syncthreads();
#pragma unroll
      for (int it = 0; it < 16; ++it) { const int idx = it * 512 + tid; const int rl = idx >> 6, cl = (idx & 63) * 4;
        const float4 v = *(const float4*)((const float*)smem + rl * EP_LD + cl);
        const uint2 g = *(const uint2*)(gp + (long)(browz + rl) * NPJ + cl);
        mreg[it].x += lo2f(g.x) * v.x; mreg[it].y += hi2f(g.x) * v.y; mreg[it].z += lo2f(g.y) * v.z; mreg[it].w += hi2f(g.y) * v.w; }
      __syncthreads();
    }
    { const int oz = opaque_zero(); u16* mg = (u16*)(ws + WS_XN) + oz;
#pragma unroll
      for (int it = 0; it < 16; ++it) { const int idx = it * 512 + tid; const int rl = idx >> 6, cl = (idx & 63) * 4;
        *(uint2*)(mg + (long)(brow + rl) * 1024 + bcol + cl) = pk4(mreg[it].x, mreg[it].y, mreg[it].z, mreg[it].w); } }
  }
  for (int it = (int)gridDim.x - 1 - vid; it < 8 * 4; it += gridDim.x) {
    const int rg = it & 7, pn = it >> 3; const int row0 = MP + rg * 16, bcol = pn * 256;
    const u16* proj = (const u16*)(ws + WS_PROJ); u16* mg = (u16*)(ws + WS_XN);
    float m0[4] = {0.f, 0.f, 0.f, 0.f}, m1[4] = {0.f, 0.f, 0.f, 0.f};
#pragma unroll 1
    for (int b = 0; b < 3; ++b) {
      const int acol = (b == 0) ? PC_QD : (b == 1) ? PC_VD : PC_KD;
      f32x4 c0, c1;
      sgemm16(lane, proj + (long)row0 * NPJ + acol, NPJ, (const u16*)(ws + WS_WO) + ((long)b * 1024 + bcol) * 512, 512, 512, wid * 32, wid * 32 + 16, c0, c1);
#pragma unroll
      for (int j = 0; j < 4; ++j) { const long row = row0 + fq * 4 + j; const u16* g = proj + row * NPJ + PC_G + b * 1024 + bcol + wid * 32 + fr;
        m0[j] += bf2f(g[0]) * c0[j]; m1[j] += bf2f(g[16]) * c1[j]; }
    }
#pragma unroll
    for (int j = 0; j < 4; ++j) { const long row = row0 + fq * 4 + j; u16* q = mg + row * 1024 + bcol + wid * 32 + fr; q[0] = f2bf(m0[j]); q[16] = f2bf(m1[j]); }
  }
}

DI void wout_phase(const int TID_in, KP p, int l, int vid, float* outp) {
  const int wv = __builtin_amdgcn_readfirstlane(TID_in >> 6);
  unsigned char* ws = p->ws;
  f32x4 acc[2][2][4][2];
  for (int tile = vid; tile < 64 * 4; tile += gridDim.x) {
    int pm, pn; tile_coords(tile, 64, 4, pm, pn);
    const int brow = pm * 256, bcol = pn * 256;
    gemm_kloop8(fresh_tid(wv), (const u16*)(ws + WS_XN) + (long)brow * 1024, 1024, (const u16*)(ws + WS_WOUT) + (long)bcol * 1024, 1024, 16, acc);
    const int TID = fresh_tid(wv);
    GEMM_IDS
    const int oz = opaque_zero(); const int browz = brow + oz;
    float* out = outp + oz;
#pragma unroll
    for (int ai = 0; ai < 2; ++ai) {
      ACC_TO_LDS(ai);
      __syncthreads();
      EPI_ROWS_BEGIN(ai)
        if (row < M) { const float4 xo = (l == 0) ? (row < MP ? *(const float4*)(p->in[0] + (long)row * D + col) : *(const float4*)(p->in[1] + (long)(row - MP) * D + col)) : *(const float4*)(out + (long)row * D + col);
          *(float4*)(out + (long)row * D + col) = float4{xo.x + v.x, xo.y + v.y, xo.z + v.z, xo.w + v.w}; }
      EPI_ROWS_END
      __syncthreads();
    }
  }
  const int TID = fresh_tid(wv);
  GEMM_IDS
  for (int it = (int)gridDim.x - 1 - vid; it < 8 * 4; it += gridDim.x) {
    const int rg = it & 7, pn = it >> 3; const int row0 = MP + rg * 16, bcol = pn * 256;
    f32x4 c0, c1;
    sgemm16(lane, (const u16*)(ws + WS_XN) + (long)row0 * 1024, 1024, (const u16*)(ws + WS_WOUT) + (long)bcol * 1024, 1024, 1024, wid * 32, wid * 32 + 16, c0, c1);
#pragma unroll
    for (int j = 0; j < 4; ++j) { const int row = row0 + fq * 4 + j; const int col = bcol + wid * 32 + fr;
      const float* xo = (l == 0) ? p->in[1] + (long)(row - MP) * D + col : outp + (long)row * D + col;
      const float x0 = xo[0], x1 = xo[16];
      outp[(long)row * D + col] = x0 + c0[j]; outp[(long)row * D + col + 16] = x1 + c1[j]; }
  }
}

DI void final_phase(const int TID, KP p) {
  const int lane = TID & 63, wid = TID >> 6;
  const float* g = p->in[31];
  for (int row = blockIdx.x * 8 + wid; row < M; row += gridDim.x * 8) {
    float* src = p->out + (long)row * D;
    float4 v[4]; float ss = 0.f;
#pragma unroll
    for (int i = 0; i < 4; ++i) { v[i] = *(const float4*)(src + i * 256 + lane * 4); ss += v[i].x * v[i].x + v[i].y * v[i].y + v[i].z * v[i].z + v[i].w * v[i].w; }
    ss = wsum(ss); const float rs = rsqrtf(ss * (1.f / D) + EPS);
#pragma unroll
    for (int i = 0; i < 4; ++i) { float4 gg = *(const float4*)(g + i * 256 + lane * 4);
      *(float4*)(src + i * 256 + lane * 4) = float4{v[i].x * rs * gg.x, v[i].y * rs * gg.y, v[i].z * rs * gg.z, v[i].w * rs * gg.w}; }
  }
}


#define XB_TMO      128
#define XB_XCNT(j)  (256  + 64 * (j))
#define XB_XSUB(j)  (1280 + 64 * (j))
#define XB_XGEN(j)  (2304 + 64 * (j))
#define XB_TOP      3328
#define XB_TOPGEN   3392
#define XCD_BAR_WORDS 3456
#define XB_SPIN_CAP (1u << 22)
#define LAS __attribute__((address_space(3)))
DI unsigned xb_ld(unsigned* p) { return __hip_atomic_load(p, __ATOMIC_RELAXED, __HIP_MEMORY_SCOPE_AGENT); }
DI unsigned xb_add(unsigned* p, unsigned v) { return __hip_atomic_fetch_add(p, v, __ATOMIC_RELAXED, __HIP_MEMORY_SCOPE_AGENT); }
DI unsigned xb_xcc_id() { return (unsigned)__builtin_amdgcn_s_getreg((3 << 11) | 20) & 0xFu; }
#define XB_SPIN(cond, bar) do { unsigned _sp = 0; while (cond) { __builtin_amdgcn_s_sleep(1); \
    if ((++_sp & 255u) == 0u) { if (xb_ld(&(bar)[XB_TMO])) break; if (_sp > XB_SPIN_CAP) { atomicAdd(&(bar)[XB_TMO], 1u); break; } } } } while (0)
DI void xcd_barrier_complete(unsigned* bar, unsigned x, unsigned& nloc, unsigned& nx) {
  const unsigned G = gridDim.x;
  unsigned sum, cnt, mine, sp = 0u;
  for (;;) {
    sum = 0u; cnt = 0u; mine = 0u;
#pragma unroll
    for (unsigned j = 0; j < 16; ++j) { const unsigned c = xb_ld(&bar[XB_XCNT(j)]); sum += c; cnt += (c > 0u) ? 1u : 0u; mine = (j == x) ? c : mine; }
    if (sum == G) break;
    __builtin_amdgcn_s_sleep(1);
    if ((++sp & 255u) == 0u) { if (xb_ld(&bar[XB_TMO])) break; if (sp > XB_SPIN_CAP) { atomicAdd(&bar[XB_TMO], 1u); break; } }
  }
  nloc = mine > 0u ? mine : 1u; nx = cnt > 0u ? cnt : 1u;
}
DI void xcd_barrier(const int TID, unsigned* bar, unsigned x) {
  volatile LAS unsigned* st = (volatile LAS unsigned*)(smem + TASK_OFF + 16);
  asm volatile("s_waitcnt vmcnt(0)" ::: "memory");
  __syncthreads();
  if (TID == 0) {
    __builtin_amdgcn_s_waitcnt(0);
    unsigned nloc = st[0], nx = st[1];
    if (nloc == 0u) { xcd_barrier_complete(bar, x, nloc, nx); st[0] = nloc; st[1] = nx; }
    const unsigned old = xb_add(&bar[XB_XSUB(x)], 1u);
    const unsigned gen = old / nloc;
    if (old + 1u == (gen + 1u) * nloc) {
      __builtin_amdgcn_fence(__ATOMIC_RELEASE, "agent");
      asm volatile("s_waitcnt vmcnt(0)" ::: "memory");
      const unsigned og = xb_add(&bar[XB_TOP], 1u);
      const unsigned tg = og / nx;
      if (og + 1u == (tg + 1u) * nx) xb_add(&bar[XB_TOPGEN], 1u);
      else XB_SPIN(xb_ld(&bar[XB_TOPGEN]) == tg, bar);
      __builtin_amdgcn_fence(__ATOMIC_ACQUIRE, "agent");
      xb_add(&bar[XB_XGEN(x)], 1u);
      asm volatile("s_waitcnt vmcnt(0)" ::: "memory");
    } else {
      XB_SPIN(xb_ld(&bar[XB_XGEN(x)]) == gen, bar);
      __builtin_amdgcn_fence(__ATOMIC_ACQUIRE, "agent");
      asm volatile("s_waitcnt vmcnt(0)" ::: "memory");
    }
  }
  __syncthreads();
}

__global__ void __launch_bounds__(512, 2) mega(Params p_) {
  const int wave_s = __builtin_amdgcn_readfirstlane((int)(__builtin_amdgcn_workitem_id_x() >> 6));
  const int G = gridDim.x, bx = blockIdx.x;
  const int vid = (G % 8 == 0) ? (bx % 8) * (G / 8) + bx / 8 : bx;
  const int ph_lo = p_.ph_lo, ph_hi = p_.ph_hi;
  const unsigned xcc = xb_xcc_id();
  { const int t0 = __builtin_amdgcn_workitem_id_x(); if (t0 < 4) ((volatile LAS unsigned*)(smem + TASK_OFF))[4 + t0] = 0u; __syncthreads();
    if (t0 == 0) (void)xb_add((unsigned*)(p_.ws + WS_BAR) + XB_XCNT(xcc), 1u); }
  if (ph_hi - ph_lo > 1) cg::this_grid().sync();
  for (int ph = ph_lo; ph < ph_hi; ++ph) {
    int TID; asm volatile("v_mbcnt_lo_u32_b32 %0, -1, 0\n\tv_mbcnt_hi_u32_b32 %0, -1, %0" : "=v"(TID)); TID += wave_s * 64;
    KP p = (KP)__builtin_amdgcn_kernarg_segment_ptr(); asm volatile("" : "+s"(p));
    unsigned* ctrs = (unsigned*)(p->ws + WS_CTL);
    if (ph == NPH - 1) final_phase(TID, p);
    else {
      const int l = ph >> 3, s = ph & 7;
      switch (s) {
        case 0: for (int rep = 0; rep < REP_PREP; ++rep) { prep_phase(TID, p, l); __syncthreads(); } break;
        case 1: for (int rep = 0; rep < REP_INPROJ; ++rep) { inproj_phase(TID, p, l, vid); __syncthreads(); } break;
        case 2: mid_phase(TID, p, l); break;
        case 3: for (int rep = 0; rep < REP_QLRU; ++rep) { qlru_phase(TID, p, l, vid); __syncthreads(); } break;
        case 4: for (int rep = 0; rep < REP_ATTN; ++rep) { attn_phase(TID, p, l, ctrs + ph + 64 * rep); __syncthreads(); } break;
        case 5: for (int rep = 0; rep < REP_UVSCAN; ++rep) { uvscan_phase(TID, p, l, vid); __syncthreads(); } break;
        case 6: for (int rep = 0; rep < REP_OPROJ; ++rep) { oproj_phase(TID, p, l, vid); __syncthreads(); } break;
        default: wout_phase(TID, p, l, vid, p->out); break;
      }
    }
    if (TAIL_PHASE >= 0 && ph == NPH - 1) {
      for (int rep = 0; rep < TAIL_REPS; ++rep) {
        xcd_barrier(TID, (unsigned*)(p->ws + WS_BAR), xcc);
        if (TAIL_PHASE == 2) mid_phase(TID, p, 3);
        else if (TAIL_PHASE == 7) wout_phase(TID, p, 3, vid, (float*)(p->ws + WS_PROJ));
        else if (TAIL_PHASE == 1) inproj_phase(TID, p, 3, vid);
        else if (TAIL_PHASE == 6) oproj_phase(TID, p, 3, vid);
        else if (TAIL_PHASE == 8) final_phase(TID, p);
        __syncthreads();
      }
    }
    if (ph + 1 < ph_hi) {
      xcd_barrier(TID, (unsigned*)(p->ws + WS_BAR), xcc);
      for (int e = 0; e < EXTRA_SYNC; ++e) xcd_barrier(TID, (unsigned*)(p->ws + WS_BAR), xcc);
    }
  }
}

extern "C" void kernel_launch(void* const* d_in, const int* in_sizes, int n_in, void* d_out, int out_size, void* d_ws, size_t ws_size, hipStream_t stream) {
  static int grid = 0;
  if (grid == 0) {
    if (n_in != 32 || (long)out_size != O_END || ws_size < WS_END) { fprintf(stderr, "kernel_launch: unexpected shapes (n_in %d out %d ws %zu need %zu)\n", n_in, out_size, ws_size, (size_t)WS_END); grid = -1; return; }
    int dev = 0, cus = 0, per_cu = 0;
    (void)hipGetDevice(&dev); (void)hipDeviceGetAttribute(&cus, hipDeviceAttributeMultiprocessorCount, dev);
    if (hipFuncSetAttribute((const void*)mega, hipFuncAttributeMaxDynamicSharedMemorySize, LDS_BYTES) != hipSuccess) { fprintf(stderr, "hipFuncSetAttribute failed\n"); grid = -1; return; }
    if (hipOccupancyMaxActiveBlocksPerMultiprocessor(&per_cu, (const void*)mega, 512, LDS_BYTES) != hipSuccess || per_cu < 1) { fprintf(stderr, "occupancy query failed (%d)\n", per_cu); per_cu = 1; }
    (void)hipGetLastError();
    grid = cus;
  }
  if (grid < 0) return;
  (void)hipMemsetAsync((char*)d_ws + WS_CTL, 0, WS_ROPE, stream);
  Params p{};
  for (int i = 0; i < 32; ++i) p.in[i] = (const float*)d_in[i];
  p.out = (float*)d_out; p.ws = (unsigned char*)d_ws;
#if ONE_LAUNCH
  p.ph_lo = 0; p.ph_hi = NPH;
  void* args[] = {&p};
  hipError_t e = hipLaunchCooperativeKernel((const void*)mega, dim3(grid), dim3(512), args, LDS_BYTES, stream);
  if (e != hipSuccess) fprintf(stderr, "cooperative launch failed: %s\n", hipGetErrorString(e));
#else
  for (int ph = 0; ph < NPH; ++ph) { p.ph_lo = ph; p.ph_hi = ph + 1; hipLaunchKernelGGL(mega, dim3(grid), dim3(512), LDS_BYTES, stream, p); }
#endif
}
```
